# Optimizing an MI355X kernel written in HIP

```python
import jax
import jax.numpy as jnp
from jax import lax
import numpy as np

D_MODEL = 1024
BATCH = 32
SEQ = 2048
DEPTH = 1

RW_HEAD_DIM = 64
RW_WIDTH = D_MODEL // 2
RW_HEADS = RW_WIDTH // RW_HEAD_DIM
RW_DECAY_RANK = 64
RW_ICLR_RANK = 64
RW_GATE_RANK = 128
RW_GN_EPS = 64e-5
RET_QK_DIM = 64
RET_QK_WIDTH = D_MODEL // 2
RET_HEADS = RET_QK_WIDTH // RET_QK_DIM
RET_V_DIM = 2 * RET_QK_DIM
RET_V_WIDTH = RET_HEADS * RET_V_DIM
RET_CHUNK = 128
ROPE_BASE = 10000.0
RET_GN_EPS = 1e-5
D_FF = 2816
CONV_WIDTH = 3
RMS_EPS = 1e-6

RW_SIZES = (RW_WIDTH, RW_WIDTH, RW_WIDTH, RW_DECAY_RANK, RW_ICLR_RANK, RW_GATE_RANK)
RET_SIZES = (RET_QK_WIDTH, RET_QK_WIDTH, RET_V_WIDTH, RET_V_WIDTH)
RW_COLS = sum(RW_SIZES)
RET_COLS = sum(RET_SIZES)
IN_SIZES = (RW_COLS, RET_COLS, D_MODEL, D_MODEL)
IN_COLS = sum(IN_SIZES)

kernel_name = "hybrid_rwkv7_retention_convffn_block"


def _split(z, sizes):
    return jnp.split(z, [int(s) for s in np.cumsum(sizes)[:-1]], axis=-1)


def rms_norm(x, g):
    xf = x.astype(jnp.float32)
    y = xf * lax.rsqrt(jnp.mean(xf * xf, axis=-1, keepdims=True) + RMS_EPS)
    return (y * g.astype(jnp.float32)).astype(x.dtype)


def group_norm_heads(z, eps):
    mu = jnp.mean(z, axis=-1, keepdims=True)
    var = jnp.mean(jnp.square(z - mu), axis=-1, keepdims=True)
    return (z - mu) * lax.rsqrt(var + eps)


def token_shift(p):
    return jnp.pad(p, ((0, 0), (1, 0), (0, 0)))[:, :-1]


def rwkv7_mixer(p, mu, w0, w2, a0, a2, g2, k_k, k_a, r_k, lnx_w, lnx_b):
    B, T, _ = p.shape
    H, N = RW_HEADS, RW_HEAD_DIM
    p = p.astype(jnp.float32)
    p = p + (token_shift(p) - p) * mu.astype(jnp.float32)
    r, k, v, wd, ad, gd = _split(p, RW_SIZES)
    w = -jax.nn.softplus(-(w0 + jnp.tanh(wd) @ w2)) - 0.5
    decay = jnp.exp(-jnp.exp(w))
    a = jax.nn.sigmoid(a0 + ad @ a2)
    g = jax.nn.sigmoid(gd) @ g2
    heads = lambda z: z.reshape(B, T, H, N).astype(jnp.float32)
    kk = heads(k * k_k)
    kk = kk / jnp.maximum(jnp.sqrt(jnp.sum(kk * kk, axis=-1, keepdims=True)), 1e-12)
    k = k * (1.0 + (a - 1.0) * k_a)
    r, k, v, decay, a = heads(r), heads(k), heads(v), heads(decay), heads(a)

    def step(S, inp):
        r_t, k_t, v_t, w_t, kk_t, a_t = inp
        sa = jnp.einsum('bhvk,bhk->bhv', S, -kk_t)
        S = (S * w_t[:, :, None, :]
             + sa[..., None] * (kk_t * a_t)[:, :, None, :]
             + v_t[..., None] * k_t[:, :, None, :])
        y = jnp.einsum('bhvk,bhk->bhv', S, r_t)
        return S, y

    xs = tuple(jnp.moveaxis(z, 1, 0) for z in (r, k, v, decay, kk, a))
    S0 = jnp.zeros((B, H, N, N), jnp.float32)
    _, y = lax.scan(step, S0, xs)
    y = jnp.moveaxis(y, 0, 1)
    y = group_norm_heads(y, RW_GN_EPS) * lnx_w.reshape(H, N) + lnx_b.reshape(H, N)
    bonus = jnp.sum(r * k * r_k.reshape(H, N), axis=-1, keepdims=True) * v
    return (y + bonus).reshape(B, T, RW_WIDTH) * g


def rotary(z, pos):
    half = z.shape[-1] // 2
    inv = ROPE_BASE ** (-jnp.arange(half, dtype=jnp.float32) / half)
    ang = pos.astype(jnp.float32)[..., None] * inv
    cos = jnp.cos(ang)[:, :, None, :]
    sin = jnp.sin(ang)[:, :, None, :]
    z1, z2 = z[..., :half], z[..., half:]
    return jnp.concatenate([z1 * cos - z2 * sin, z1 * sin + z2 * cos], axis=-1)


def retention_mixer(p, positions):
    B, T, _ = p.shape
    H, dk, dv, C = RET_HEADS, RET_QK_DIM, RET_V_DIM, RET_CHUNK
    q, k, v, g = _split(p.astype(jnp.float32), RET_SIZES)
    q = rotary(q.reshape(B, T, H, dk), positions)
    k = rotary(k.reshape(B, T, H, dk), positions) * (dk ** -0.5)
    v = v.reshape(B, T, H, dv)
    log_gamma = jnp.log1p(-jnp.exp2(-5.0 - jnp.arange(H, dtype=jnp.float32)))
    idx = jnp.arange(C, dtype=jnp.float32)
    rel = idx[:, None] - idx[None, :]
    decay_mask = jnp.where(rel[None] >= 0,
                           jnp.exp(jnp.maximum(rel, 0.0)[None] * log_gamma[:, None, None]), 0.0)
    q_decay = jnp.exp((idx + 1.0)[:, None] * log_gamma[None, :])[None, :, :, None]
    k_decay = jnp.exp((C - 1.0 - idx)[:, None] * log_gamma[None, :])[None, :, :, None]
    chunk_decay = jnp.exp(C * log_gamma)[None, :, None, None]
    n_chunks = T // C
    chunks = lambda z: jnp.moveaxis(z.reshape(B, n_chunks, C, H, z.shape[-1]), 1, 0)

    def step(R, inp):
        qc, kc, vc = inp
        s = jnp.einsum('bihd,bjhd->bhij', qc, kc) * decay_mask
        inner = jnp.einsum('bhij,bjhe->bihe', s, vc)
        cross = jnp.einsum('bihd,bhde->bihe', qc * q_decay, R)
        R = R * chunk_decay + jnp.einsum('bjhd,bjhe->bhde', kc * k_decay, vc)
        return R, inner + cross

    R0 = jnp.zeros((B, H, dk, dv), jnp.float32)
    _, o = lax.scan(step, R0, (chunks(q), chunks(k), chunks(v)))
    o = jnp.moveaxis(o, 0, 1).reshape(B, T, H, dv)
    o = group_norm_heads(o, RET_GN_EPS).reshape(B, T, RET_V_WIDTH)
    return jax.nn.silu(g) * o


def conv_ffn(h, w_up, conv_w, conv_b, w_down):
    u = h @ w_up
    T = u.shape[1]
    up = jnp.pad(u, ((0, 0), (CONV_WIDTH - 1, 0), (0, 0)))
    u = sum(up[:, i:i + T] * conv_w[i] for i in range(CONV_WIDTH)) + conv_b
    gate, val = jnp.split(u, 2, axis=-1)
    return (jax.nn.gelu(gate, approximate=True) * val) @ w_down


def setup_inputs(seed: int = 0) -> dict:
    key = jax.random.key(seed)
    ks = jax.random.split(key, 26)
    f32 = jnp.float32
    L = DEPTH
    nrm = lambda k, shape, s: s * jax.random.normal(k, shape, f32)
    x = jax.random.normal(ks[0], (BATCH, SEQ, D_MODEL), f32)
    offsets = jax.random.randint(ks[1], (BATCH, 1), 0, 4096, dtype=jnp.int32)
    positions = offsets + jnp.arange(SEQ, dtype=jnp.int32)[None, :]
    return {
        "x": x,
        "positions": positions,
        "norm_mix_pre": 1.0 + nrm(ks[2], (L, D_MODEL), 0.1),
        "norm_mix_post": 1.0 + nrm(ks[3], (L, D_MODEL), 0.1),
        "norm_ffn_pre": 1.0 + nrm(ks[4], (L, D_MODEL), 0.1),
        "norm_ffn_post": 1.0 + nrm(ks[5], (L, D_MODEL), 0.1),
        "w_in": nrm(ks[6], (L, D_MODEL, IN_COLS), D_MODEL ** -0.5),
        "rw_mu": jax.random.uniform(ks[7], (L, RW_COLS), f32, 0.0, 1.0),
        "rw_w0": jax.random.uniform(ks[8], (L, RW_WIDTH), f32, -6.0, 1.0),
        "rw_w2": nrm(ks[9], (L, RW_DECAY_RANK, RW_WIDTH), 0.1 * RW_DECAY_RANK ** -0.5),
        "rw_a0": nrm(ks[10], (L, RW_WIDTH), 0.1),
        "rw_a2": nrm(ks[11], (L, RW_ICLR_RANK, RW_WIDTH), 0.5 * RW_ICLR_RANK ** -0.5),
        "rw_g2": nrm(ks[12], (L, RW_GATE_RANK, RW_WIDTH), RW_GATE_RANK ** -0.5),
        "rw_k_k": 0.85 + nrm(ks[13], (L, RW_WIDTH), 0.1),
        "rw_k_a": 1.0 + nrm(ks[14], (L, RW_WIDTH), 0.1),
        "rw_r_k": nrm(ks[15], (L, RW_WIDTH), 0.1),
        "rw_lnx_w": 1.0 + nrm(ks[16], (L, RW_WIDTH), 0.1),
        "rw_lnx_b": nrm(ks[17], (L, RW_WIDTH), 0.01),
        "w_branch_rw": nrm(ks[18], (L, RW_WIDTH, D_MODEL), RW_WIDTH ** -0.5),
        "w_branch_ret": nrm(ks[19], (L, RET_V_WIDTH, D_MODEL), RET_V_WIDTH ** -0.5),
        "w_out": nrm(ks[20], (L, D_MODEL, D_MODEL), D_MODEL ** -0.5),
        "ffn_w_up": nrm(ks[21], (L, D_MODEL, 2 * D_FF), D_MODEL ** -0.5),
        "ffn_conv_w": nrm(ks[22], (L, CONV_WIDTH, 2 * D_FF), CONV_WIDTH ** -0.5),
        "ffn_conv_b": nrm(ks[23], (L, 2 * D_FF), 0.01),
        "ffn_w_down": nrm(ks[24], (L, D_FF, D_MODEL), D_FF ** -0.5),
    }


def reference(x, positions, norm_mix_pre, norm_mix_post, norm_ffn_pre, norm_ffn_post, w_in,
              rw_mu, rw_w0, rw_w2, rw_a0, rw_a2, rw_g2, rw_k_k, rw_k_a, rw_r_k, rw_lnx_w, rw_lnx_b,
              w_branch_rw, w_branch_ret, w_out, ffn_w_up, ffn_conv_w, ffn_conv_b, ffn_w_down):
    h = x
    for l in range(DEPTH):
        hn = rms_norm(h, norm_mix_pre[l])
        p = hn @ w_in[l]
        p_rw, p_ret, g_rw, g_ret = _split(p, IN_SIZES)
        y_rw = rwkv7_mixer(p_rw, rw_mu[l], rw_w0[l], rw_w2[l], rw_a0[l], rw_a2[l], rw_g2[l],
                           rw_k_k[l], rw_k_a[l], rw_r_k[l], rw_lnx_w[l], rw_lnx_b[l])
        y_ret = retention_mixer(p_ret, positions)
        merged = (jax.nn.sigmoid(g_rw.astype(jnp.float32)) * (y_rw @ w_branch_rw[l])
                  + jax.nn.sigmoid(g_ret.astype(jnp.float32)) * (y_ret @ w_branch_ret[l]))
        h = h + rms_norm(merged @ w_out[l], norm_mix_post[l])
        f = conv_ffn(rms_norm(h, norm_ffn_pre[l]), ffn_w_up[l], ffn_conv_w[l], ffn_conv_b[l], ffn_w_down[l])
        h = h + rms_norm(f, norm_ffn_post[l])
    return h.astype(x.dtype)
```

```cpp
#include <hip/hip_runtime.h>
#include <cstdio>
#include <cstdint>

#ifndef MK_N_LAUNCHES
#define MK_N_LAUNCHES 10
#endif

namespace pg8 {
#define PG8_LAS __attribute__((address_space(3)))
typedef unsigned short bf16_t;
typedef short bf16x8 __attribute__((ext_vector_type(8)));
typedef float f32x4 __attribute__((ext_vector_type(4)));
typedef float f32x2 __attribute__((ext_vector_type(2)));
typedef unsigned u32x4 __attribute__((ext_vector_type(4)));
typedef unsigned u32x2 __attribute__((ext_vector_type(2)));
constexpr int BM = 256, BK = 64, HALF = 128, HTB = HALF * BK * 2, STAGE_BYTES = 8 * HTB, NXCD = 8, WGM = 8;

__host__ __device__ __forceinline__ int lds_byte(int r, int c) { const int st = (r >> 4) * 2 + (c >> 5), rr = r & 15, cc = c & 31, ob = rr * 64 + cc * 2; return st * 1024 + (ob ^ (((ob >> 9) & 1) << 5)); }
__host__ __device__ __forceinline__ void stage_rc(int b, int& R, int& C) { const int st = b / 1024, sb = b % 1024, swz = sb ^ (((sb >> 9) & 1) << 5); R = (st >> 1) * 16 + swz / 64; C = (st & 1) * 32 + (swz % 64) / 2; }
__host__ __device__ __forceinline__ int perm32(int rho) { const int n = rho >> 4, i = rho & 15; return 8 * (i >> 2) + 4 * n + (i & 3); }

struct Unit { int pm, pn; };
struct Gemm { const bf16_t* A; const bf16_t* Bt; int M, N, K; };

struct StaticOrder {
    int nM, nN, nwg, G, c;
    __host__ __device__ void init(int M, int N, int G_, int c_) { nM = M / BM; nN = N / BM; nwg = nM * nN; G = G_; c = c_; }
    __host__ __device__ bool next(int i, Unit& u) const {
        const long L = (long)i * G + c; if (L >= nwg) return false;
        int wgid = (int)L; { const int q = nwg / NXCD, r = nwg % NXCD, xcd = wgid % NXCD, off = wgid / NXCD; wgid = (xcd < r ? xcd * (q + 1) : r * (q + 1) + (xcd - r) * q) + off; }
        const int nig = WGM * nN, gid = wgid / nig, fm = gid * WGM, gsz = (nM - fm) < WGM ? (nM - fm) : WGM;
        u.pm = fm + ((wgid % nig) % gsz); u.pn = (wgid % nig) / gsz; return true;
    }
    __device__ __forceinline__ void a_ready(const Unit&) const {}
    __device__ __forceinline__ void done(const Unit&) const {}
};

__device__ __forceinline__ unsigned cvt_pk_bf16(float lo, float hi) { unsigned r; asm volatile("v_cvt_pk_bf16_f32 %0, %1, %2" : "=v"(r) : "v"(lo), "v"(hi)); return r; }
__device__ __forceinline__ float bf_lo(unsigned w) { return __uint_as_float(w << 16); }
__device__ __forceinline__ float bf_hi(unsigned w) { return __uint_as_float(w & 0xffff0000u); }
__device__ __forceinline__ float fsigmoid(float x) { return __builtin_amdgcn_rcpf(1.0f + __builtin_amdgcn_exp2f(-1.44269504089f * x)); }


struct EpiIn {
    static constexpr bool PERM = true, AFTER_DRAIN = false;
    bf16_t* prw; bf16_t* pret; bf16_t* gg;
    __device__ __forceinline__ void operator()(const f32x4 (&acc)[2][2][4][2], const Unit& u, int wr, int wc, int fr, int fq) const {
        const int pn = u.pn; bf16_t* base; int ldc, colt, actk;
        if (pn < 7) { base = prw; ldc = 1792; colt = pn * 256; actk = 0; }
        else if (pn < 19) { base = pret; ldc = 3072; colt = (pn - 7) * 256; actk = (pn - 7 >= 8) ? 2 : 0; }
        else { base = gg; ldc = 2048; colt = (pn - 19) * 256; actk = 1; }
        const int row0 = u.pm * BM + wr * 64 + fr; const int col0 = colt + wc * 32 + 8 * fq;
#pragma unroll
        for (int ai = 0; ai < 2; ++ai)
#pragma unroll
            for (int m = 0; m < 4; ++m) { bf16_t* rowp = base + (size_t)(row0 + ai * HALF + m * 16) * ldc + col0;
#pragma unroll
                for (int bj = 0; bj < 2; ++bj) { f32x4 v0 = acc[ai][bj][m][0], v1 = acc[ai][bj][m][1];
                    if (actk) {
#pragma unroll
                        for (int i = 0; i < 4; ++i) { const float s0 = fsigmoid(v0[i]), s1 = fsigmoid(v1[i]); v0[i] = (actk == 2) ? v0[i] * s0 : s0; v1[i] = (actk == 2) ? v1[i] * s1 : s1; }
                    }
                    u32x4 w; w.x = cvt_pk_bf16(v0[0], v0[1]); w.y = cvt_pk_bf16(v0[2], v0[3]); w.z = cvt_pk_bf16(v1[0], v1[1]); w.w = cvt_pk_bf16(v1[2], v1[3]);
                    *(u32x4*)(rowp + bj * HALF) = w; } }
    }
};

template <bool ADD> struct EpiGate {
    static constexpr bool PERM = true, AFTER_DRAIN = false;
    bf16_t* O; const bf16_t* G; int gcol0;
    __device__ __forceinline__ void operator()(const f32x4 (&acc)[2][2][4][2], const Unit& u, int wr, int wc, int fr, int fq) const {
        const int row0 = u.pm * BM + wr * 64 + fr; const int col0 = u.pn * BM + wc * 32 + 8 * fq;
#pragma unroll
        for (int ai = 0; ai < 2; ++ai)
#pragma unroll
            for (int m = 0; m < 4; ++m) { const size_t row = (size_t)(row0 + ai * HALF + m * 16);
#pragma unroll
                for (int bj = 0; bj < 2; ++bj) { const f32x4 v0 = acc[ai][bj][m][0], v1 = acc[ai][bj][m][1];
                    const u32x4 gw = *(const u32x4*)(G + row * 2048 + gcol0 + col0 + bj * HALF);
                    float o[8];
                    o[0] = v0[0] * bf_lo(gw.x); o[1] = v0[1] * bf_hi(gw.x); o[2] = v0[2] * bf_lo(gw.y); o[3] = v0[3] * bf_hi(gw.y);
                    o[4] = v1[0] * bf_lo(gw.z); o[5] = v1[1] * bf_hi(gw.z); o[6] = v1[2] * bf_lo(gw.w); o[7] = v1[3] * bf_hi(gw.w);
                    bf16_t* op = O + row * 1024 + col0 + bj * HALF;
                    if (ADD) { const u32x4 pw = *(const u32x4*)op;
                        o[0] += bf_lo(pw.x); o[1] += bf_hi(pw.x); o[2] += bf_lo(pw.y); o[3] += bf_hi(pw.y); o[4] += bf_lo(pw.z); o[5] += bf_hi(pw.z); o[6] += bf_lo(pw.w); o[7] += bf_hi(pw.w); }
                    u32x4 w; w.x = cvt_pk_bf16(o[0], o[1]); w.y = cvt_pk_bf16(o[2], o[3]); w.z = cvt_pk_bf16(o[4], o[5]); w.w = cvt_pk_bf16(o[6], o[7]);
                    *(u32x4*)op = w; } }
    }
};

struct EpiZ {
    static constexpr bool PERM = true, AFTER_DRAIN = false;
    bf16_t* O; float* part;
    __device__ __forceinline__ void operator()(const f32x4 (&acc)[2][2][4][2], const Unit& u, int wr, int wc, int fr, int fq) const {
        const int row0 = u.pm * BM + wr * 64 + fr; const int col0 = u.pn * BM + wc * 32 + 8 * fq;
#pragma unroll
        for (int ai = 0; ai < 2; ++ai)
#pragma unroll
            for (int m = 0; m < 4; ++m) { const size_t row = (size_t)(row0 + ai * HALF + m * 16); float ss = 0.f;
#pragma unroll
                for (int bj = 0; bj < 2; ++bj) { const f32x4 v0 = acc[ai][bj][m][0], v1 = acc[ai][bj][m][1];
                    ss += (v0[0] * v0[0] + v0[1] * v0[1]) + (v0[2] * v0[2] + v0[3] * v0[3]) + (v1[0] * v1[0] + v1[1] * v1[1]) + (v1[2] * v1[2] + v1[3] * v1[3]);
                    u32x4 w; w.x = cvt_pk_bf16(v0[0], v0[1]); w.y = cvt_pk_bf16(v0[2], v0[3]); w.z = cvt_pk_bf16(v1[0], v1[1]); w.w = cvt_pk_bf16(v1[2], v1[3]);
                    *(u32x4*)(O + row * 1024 + col0 + bj * HALF) = w; }
                ss += __shfl_xor(ss, 16); ss += __shfl_xor(ss, 32);
                if (fq == 0) part[row * 16 + u.pn * 4 + wc] = ss; }
    }
};

template <int CTRL> __device__ __forceinline__ float dpp0(float x) {
    return __builtin_bit_cast(float, __builtin_amdgcn_update_dpp(0, __builtin_bit_cast(int, x), CTRL, 0xf, 0xf, true));
}
__device__ __forceinline__ float gelu_tanh(float x) {
    const float in = x * (1.0f + 0.044715f * x * x);
    return x * __builtin_amdgcn_rcpf(1.0f + __builtin_amdgcn_exp2f(-2.302208198f * in));
}

struct EpiConv {
    static constexpr bool PERM = true, AFTER_DRAIN = false;
    bf16_t* act; const float* cw; const float* cb; float* halo; PG8_LAS float* xch;
    __device__ __forceinline__ void operator()(const f32x4 (&acc)[2][2][4][2], const Unit& u, int wr, int wc, int fr, int fq) const {
        PG8_LAS f32x4* X = (PG8_LAS f32x4*)xch;
        if (fr >= 14) {
#pragma unroll
            for (int ai = 0; ai < 2; ++ai)
#pragma unroll
                for (int bj = 0; bj < 2; ++bj)
#pragma unroll
                    for (int n = 0; n < 2; ++n) X[(((((ai * 2 + wr) * 4 + wc) * 2 + (fr - 14)) * 2 + bj) * 2 + n) * 4 + fq] = acc[ai][bj][3][n];
        }
        {
            const int tcol = u.pn * 256 + wc * 32 + 8 * fq;
            if (wr == 0 && fr < 2) {
#pragma unroll
                for (int bj = 0; bj < 2; ++bj)
#pragma unroll
                    for (int n = 0; n < 2; ++n) *(f32x4*)(halo + ((size_t)(u.pm * 4 + fr)) * 5632 + tcol + bj * HALF + 4 * n) = acc[0][bj][0][n];
            }
            if (wr == 1 && fr >= 14) {
#pragma unroll
                for (int bj = 0; bj < 2; ++bj)
#pragma unroll
                    for (int n = 0; n < 2; ++n) *(f32x4*)(halo + ((size_t)(u.pm * 4 + 2 + (fr - 14))) * 5632 + tcol + bj * HALF + 4 * n) = acc[1][bj][3][n];
            }
        }
        asm volatile("s_waitcnt lgkmcnt(0)" ::: "memory"); __builtin_amdgcn_s_barrier(); asm volatile("" ::: "memory");
        const int j0 = u.pn * 128 + wc * 32 + 8 * fq;
        const float m0 = (fr == 0) ? 1.f : 0.f, m01 = (fr < 2) ? 1.f : 0.f;
        const bool first_tile = (u.pm & 7) == 0; (void)first_tile;
#pragma unroll
        for (int ai = 0; ai < 2; ++ai) {
            f32x4 xb[2][2];
#pragma unroll
            for (int bj = 0; bj < 2; ++bj)
#pragma unroll
                for (int n = 0; n < 2; ++n) xb[bj][n] = (f32x4){0.f, 0.f, 0.f, 0.f};
            if (!(ai == 0 && wr == 0) && fr >= 14) {
                const int sai = (wr == 1) ? ai : ai - 1, swr = (wr == 1) ? 0 : 1;
#pragma unroll
                for (int bj = 0; bj < 2; ++bj)
#pragma unroll
                    for (int n = 0; n < 2; ++n) xb[bj][n] = X[(((((sai * 2 + swr) * 4 + wc) * 2 + (fr - 14)) * 2 + bj) * 2 + n) * 4 + fq];
            }
            unsigned pk[4][4];
#pragma unroll
            for (int n = 0; n < 2; ++n) {
                const int jc = j0 + 4 * n;
                const f32x4 g0 = *(const f32x4*)(cw + jc), g1 = *(const f32x4*)(cw + 5632 + jc), g2 = *(const f32x4*)(cw + 2 * 5632 + jc), gb = *(const f32x4*)(cb + jc);
                const f32x4 v0 = *(const f32x4*)(cw + 2816 + jc), v1 = *(const f32x4*)(cw + 5632 + 2816 + jc), v2 = *(const f32x4*)(cw + 2 * 5632 + 2816 + jc), vb = *(const f32x4*)(cb + 2816 + jc);
#pragma unroll
                for (int i = 0; i < 4; ++i) {
                    const float g1m = g1[i] * m0, g0m = g0[i] * m01, v1m = v1[i] * m0, v0m = v0[i] * m01;
                    float og[4], ov[4];
#pragma unroll
                    for (int m = 0; m < 4; ++m) {
                        const float xg = acc[ai][0][m][n][i], xv = acc[ai][1][m][n][i];
                        const float pg = (m == 0) ? xb[0][n][i] : acc[ai][0][m - 1][n][i], pv = (m == 0) ? xb[1][n][i] : acc[ai][1][m - 1][n][i];
                        float a = gb[i] + g2[i] * xg; a += g1[i] * dpp0<0x111>(xg); a += g0[i] * dpp0<0x112>(xg); a += g1m * dpp0<0x121>(pg); a += g0m * dpp0<0x122>(pg);
                        float b = vb[i] + v2[i] * xv; b += v1[i] * dpp0<0x111>(xv); b += v0[i] * dpp0<0x112>(xv); b += v1m * dpp0<0x121>(pv); b += v0m * dpp0<0x122>(pv);
                        og[m] = a; ov[m] = b;
                    }
#pragma unroll
                    for (int m = 0; m < 4; ++m) og[m] = gelu_tanh(og[m]) * ov[m];
                    if (i & 1) {
#pragma unroll
                        for (int m = 0; m < 4; ++m) pk[m][n * 2 + (i >> 1)] = cvt_pk_bf16(__uint_as_float(pk[m][n * 2 + (i >> 1)]), og[m]);
                    } else {
#pragma unroll
                        for (int m = 0; m < 4; ++m) pk[m][n * 2 + (i >> 1)] = __float_as_uint(og[m]);
                    }
                }
            }
#pragma unroll
            for (int m = 0; m < 4; ++m) {
                u32x4 w; w.x = pk[m][0]; w.y = pk[m][1]; w.z = pk[m][2]; w.w = pk[m][3];
                *(u32x4*)(act + (size_t)(u.pm * BM + ai * HALF + wr * 64 + m * 16 + fr) * 2816 + j0) = w;
            }
        }
    }
};

template <class Epi, class Sched, bool ALIGN_EPI = false, bool SP2 = false>
__device__ __forceinline__ void gemm_phase(PG8_LAS unsigned char* lds, const Gemm g, const Sched& S, const Epi& E) {
    const int tid = threadIdx.x, wid = __builtin_amdgcn_readfirstlane(tid >> 6), lane = tid & 63, wr = wid >> 2, wc = wid & 3, fr = lane & 15, fq = lane >> 4;
    const int K = g.K, nt = K / BK;
    unsigned voffA[2], voffB[2];
#pragma unroll
    for (int i = 0; i < 2; ++i) { int R, C; stage_rc(tid * 16 + i * 8192, R, C); const int Rb = Epi::PERM ? ((R & ~31) + perm32(R & 31)) : R;
        voffA[i] = (unsigned)(R * K + C) * 2u; voffB[i] = (unsigned)(Rb * K + C) * 2u; }
    const size_t kstep = (size_t)(BK * 2);
    const size_t hstep = (size_t)HALF * K * 2;
    const size_t tstep = 2 * hstep;
    const unsigned ldsw = (unsigned)wid * 1024u;
    const int aoff = lds_byte(wr * 64 + fr, fq * 8), boff = lds_byte(wc * 32 + fr, fq * 8);
#define PG8_SA(b, h) (((b) * 2 + (h)) * HTB)
#define PG8_SB(b, h) ((4 + (b) * 2 + (h)) * HTB)
#define PG8_STAGE(bufoff, gbase, voff) do { _Pragma("unroll") for (int _i = 0; _i < 2; ++_i) \
        __builtin_amdgcn_global_load_lds((const unsigned*)((const char*)(gbase) + (voff)[_i]), (PG8_LAS unsigned*)(lds + (bufoff) + ldsw + _i * 8192), 16, 0, 0); } while (0)
#define PG8_LDA(dst, b, h) do { _Pragma("unroll") for (int m = 0; m < 4; ++m) _Pragma("unroll") for (int k = 0; k < 2; ++k) dst[m][k] = *(const PG8_LAS bf16x8*)(lds + PG8_SA(b, h) + aoff + m * 2048 + k * 1024); } while (0)
#define PG8_LDB(dst, b, h) do { _Pragma("unroll") for (int n = 0; n < 2; ++n) _Pragma("unroll") for (int k = 0; k < 2; ++k) dst[n][k] = *(const PG8_LAS bf16x8*)(lds + PG8_SB(b, h) + boff + n * 2048 + k * 1024); } while (0)
#define PG8_MMA(ai, bj, At, Bt) do { __builtin_amdgcn_s_setprio(1); _Pragma("unroll") for (int m = 0; m < 4; ++m) _Pragma("unroll") for (int n = 0; n < 2; ++n) _Pragma("unroll") for (int k = 0; k < 2; ++k) \
        acc[ai][bj][m][n] = __builtin_amdgcn_mfma_f32_16x16x32_bf16(Bt[n][k], At[m][k], acc[ai][bj][m][n], 0, 0, 0); __builtin_amdgcn_s_setprio(0); } while (0)
#define PG8_WAIT_V(n) asm volatile("s_waitcnt vmcnt(" #n ")" ::: "memory")
#define PG8_WAIT_L(n) asm volatile("s_waitcnt lgkmcnt(" #n ")" ::: "memory")
#define PG8_BAR __builtin_amdgcn_s_barrier()
#define PG8_SCHED __builtin_amdgcn_sched_barrier(0)
    Unit cur, nxt; int ui = 0;
    if (!S.next(0, cur)) return;
    f32x4 acc[2][2][4][2];
#pragma unroll
    for (int a = 0; a < 2; ++a)
#pragma unroll
        for (int b = 0; b < 2; ++b)
#pragma unroll
            for (int m = 0; m < 4; ++m)
#pragma unroll
                for (int n = 0; n < 2; ++n) acc[a][b][m][n] = (f32x4){0.f, 0.f, 0.f, 0.f};
    bf16x8 At[4][2], B0[2][2], B1[2][2];
    const char* cA = (const char*)g.A + (size_t)cur.pm * tstep; const char* cB = (const char*)g.Bt + (size_t)cur.pn * tstep;
    S.a_ready(cur);
    if constexpr (SP2) {
        PG8_STAGE(PG8_SB(0, 0), cB, voffB); PG8_STAGE(PG8_SB(0, 1), cB + hstep, voffB); PG8_STAGE(PG8_SA(0, 0), cA, voffA); PG8_STAGE(PG8_SA(0, 1), cA + hstep, voffA);
        if (wr == 1) PG8_BAR;
        PG8_WAIT_V(2); PG8_BAR;
        PG8_STAGE(PG8_SB(1, 0), cB + kstep, voffB); PG8_STAGE(PG8_SA(1, 0), cA + kstep, voffA); PG8_STAGE(PG8_SB(1, 1), cB + hstep + kstep, voffB);
        PG8_WAIT_V(6); PG8_BAR;
    } else {
        PG8_STAGE(PG8_SB(0, 0), cB, voffB); PG8_STAGE(PG8_SA(0, 0), cA, voffA); PG8_STAGE(PG8_SB(0, 1), cB + hstep, voffB); PG8_STAGE(PG8_SA(0, 1), cA + hstep, voffA);
        if (wr == 1) PG8_BAR;
        PG8_WAIT_V(4); PG8_BAR;
        PG8_STAGE(PG8_SB(1, 0), cB + kstep, voffB); PG8_STAGE(PG8_SA(1, 0), cA + kstep, voffA); PG8_STAGE(PG8_SB(1, 1), cB + hstep + kstep, voffB);
        PG8_WAIT_V(6); PG8_BAR;
    }
    for (;;) {
        const bool has_next = S.next(ui + 1, nxt);
        const char* nA = has_next ? (const char*)g.A + (size_t)nxt.pm * tstep : cA; const char* nB = has_next ? (const char*)g.Bt + (size_t)nxt.pn * tstep : cB;
        for (int t = 0; t < nt; t += 2) {
            const bool last = (t == nt - 2);
            const char* a1 = cA + (size_t)(t + 1) * kstep;
            const char* a2 = last ? nA : cA + (size_t)(t + 2) * kstep; const char* b2 = last ? nB : cB + (size_t)(t + 2) * kstep;
            const char* a3 = a2 + kstep; const char* b3 = b2 + kstep;
            if (last && has_next) S.a_ready(nxt);
            if constexpr (SP2) {
            PG8_LDB(B0, 0, 0); PG8_LDB(B1, 0, 1); PG8_SCHED; PG8_LDA(At, 0, 0); PG8_STAGE(PG8_SA(1, 1), a1 + hstep, voffA);
            PG8_WAIT_V(8); PG8_WAIT_L(0); PG8_BAR; PG8_MMA(0, 0, At, B0); PG8_MMA(0, 1, At, B1); PG8_BAR; PG8_SCHED;
            PG8_LDA(At, 0, 1); PG8_STAGE(PG8_SB(0, 0), b2, voffB); PG8_STAGE(PG8_SB(0, 1), b2 + hstep, voffB); PG8_STAGE(PG8_SA(0, 0), a2, voffA);
            PG8_WAIT_V(8); PG8_WAIT_L(0); PG8_BAR; PG8_MMA(1, 0, At, B0); PG8_MMA(1, 1, At, B1); PG8_BAR; PG8_SCHED;
            PG8_LDB(B0, 1, 0); PG8_LDB(B1, 1, 1); PG8_SCHED; PG8_LDA(At, 1, 0); PG8_STAGE(PG8_SA(0, 1), a2 + hstep, voffA);
            PG8_WAIT_V(8); PG8_WAIT_L(0); PG8_BAR; PG8_MMA(0, 0, At, B0); PG8_MMA(0, 1, At, B1); PG8_BAR; PG8_SCHED;
            PG8_LDA(At, 1, 1); PG8_STAGE(PG8_SB(1, 0), b3, voffB); PG8_STAGE(PG8_SB(1, 1), b3 + hstep, voffB); PG8_STAGE(PG8_SA(1, 0), a3, voffA);
            PG8_WAIT_V(8); PG8_WAIT_L(0); PG8_BAR; PG8_MMA(1, 0, At, B0); PG8_MMA(1, 1, At, B1); PG8_BAR; PG8_SCHED;
            } else {
            PG8_LDB(B0, 0, 0); PG8_SCHED; PG8_LDA(At, 0, 0); PG8_STAGE(PG8_SA(1, 1), a1 + hstep, voffA);
            PG8_WAIT_L(8); PG8_BAR; PG8_WAIT_L(0); PG8_MMA(0, 0, At, B0); PG8_BAR; PG8_SCHED;
            PG8_LDB(B1, 0, 1); PG8_STAGE(PG8_SB(0, 0), b2, voffB);
            PG8_BAR; PG8_WAIT_L(0); PG8_MMA(0, 1, At, B1); PG8_BAR;
            PG8_LDA(At, 0, 1); PG8_STAGE(PG8_SA(0, 0), a2, voffA);
            PG8_BAR; PG8_WAIT_L(0); PG8_MMA(1, 0, At, B0); PG8_BAR; PG8_SCHED;
            PG8_STAGE(PG8_SB(0, 1), b2 + hstep, voffB);
            PG8_WAIT_V(6); PG8_BAR; PG8_MMA(1, 1, At, B1); PG8_BAR;
            PG8_LDB(B0, 1, 0); PG8_SCHED; PG8_LDA(At, 1, 0); PG8_STAGE(PG8_SA(0, 1), a2 + hstep, voffA);
            PG8_WAIT_L(8); PG8_BAR; PG8_WAIT_L(0); PG8_MMA(0, 0, At, B0); PG8_BAR; PG8_SCHED;
            PG8_LDB(B1, 1, 1); PG8_STAGE(PG8_SB(1, 0), b3, voffB);
            PG8_BAR; PG8_WAIT_L(0); PG8_MMA(0, 1, At, B1); PG8_BAR;
            PG8_LDA(At, 1, 1); PG8_STAGE(PG8_SA(1, 0), a3, voffA);
            PG8_BAR; PG8_WAIT_L(0); PG8_MMA(1, 0, At, B0); PG8_BAR; PG8_SCHED;
            PG8_STAGE(PG8_SB(1, 1), b3 + hstep, voffB);
            PG8_WAIT_V(6); PG8_BAR; PG8_MMA(1, 1, At, B1); PG8_BAR;
            }
        }
        if constexpr (ALIGN_EPI) { if (wr == 0) PG8_BAR; }
        if constexpr (!Epi::AFTER_DRAIN) { E(acc, cur, wr, wc, fr, fq); S.done(cur); }
        if (!has_next) break;
#pragma unroll
        for (int a = 0; a < 2; ++a)
#pragma unroll
            for (int b = 0; b < 2; ++b)
#pragma unroll
                for (int m = 0; m < 4; ++m)
#pragma unroll
                    for (int n = 0; n < 2; ++n) acc[a][b][m][n] = (f32x4){0.f, 0.f, 0.f, 0.f};
        cur = nxt; cA = nA; cB = nB; ++ui;
        if constexpr (ALIGN_EPI) { if (wr == 1) PG8_BAR; }
    }
    PG8_WAIT_V(0);
    if constexpr (!ALIGN_EPI) { if (wr == 0) PG8_BAR; }
    PG8_BAR;
#undef PG8_SA
#undef PG8_SB
#undef PG8_STAGE
#undef PG8_LDA
#undef PG8_LDB
#undef PG8_MMA
#undef PG8_WAIT_V
#undef PG8_WAIT_L
#undef PG8_BAR
#undef PG8_SCHED
}
}

constexpr int NWAVES = 8;
constexpr int BATCH = 32, T = 2048, D = 1024, M = BATCH * T;
constexpr int RWH = 8, RWN = 64, RWW = 512, RW_COLS = 1792;
constexpr int RTH = 8, RDK = 64, RDV = 128, RET_COLS = 3072, RCH = 128;
constexpr int IN_COLS = 6912, DFF = 2816;
constexpr float RMS_EPS = 1e-6f, RW_GN_EPS = 64e-5f, RET_GN_EPS = 1e-5f;
constexpr int N_PHASES = 10;

constexpr size_t MiB = 1u << 20;
constexpr size_t WS_CTL = 0, CTL_ZERO_BYTES = 1 * MiB;
constexpr size_t WS_WIN = 2 * MiB, WS_WRW = 16 * MiB, WS_WRET = 17 * MiB, WS_WOUT = 19 * MiB, WS_WUP = 21 * MiB, WS_WDN = 32 * MiB;
constexpr size_t WS_ROPE = 38 * MiB, WS_PART = 54 * MiB, WS_PART2 = 58 * MiB, WS_HALO = 62 * MiB, WS_RWW = 84 * MiB;
constexpr size_t WS_PRW = 88 * MiB, WS_PRET = 312 * MiB, WS_G = 696 * MiB, WS_END = 952 * MiB;
constexpr size_t WS_MERGED = WS_PRW, WS_Z = WS_PRET, WS_XN2 = WS_G, WS_ACT = WS_PRET, WS_F = WS_PRW;
static_assert(WS_WIN + (size_t)IN_COLS * D * 2 <= WS_WRW && WS_WUP + (size_t)2 * DFF * D * 2 <= WS_WDN && WS_WDN + (size_t)D * DFF * 2 <= WS_ROPE, "ws map: weights");
static_assert(WS_ROPE + (size_t)M * 32 * 8 <= WS_PART && WS_HALO + (size_t)256 * 4 * 5632 * 4 <= WS_RWW && WS_RWW + 4 * MiB <= WS_PRW, "ws map: tables");
static_assert(WS_PRW + (size_t)M * RW_COLS * 2 <= WS_PRET && WS_PRET + (size_t)M * RET_COLS * 2 <= WS_G && WS_G + (size_t)M * 2048 * 2 <= WS_END, "ws map: activations");
static_assert(WS_ACT + (size_t)M * DFF * 2 <= WS_G, "ws map: act");
constexpr int CW_BAR = 4096;
constexpr size_t OUT_XN = 0, OUT_YRET = 0, OUT_YRW = 128 * MiB;

constexpr int RING_OFF = 0, RING_BYTES = 131072;
constexpr int XCH_OFF = RING_BYTES, XCH_BYTES = 16384;
constexpr int LDSCTL_OFF = XCH_OFF + XCH_BYTES, MISC_OFF = LDSCTL_OFF + 320;
constexpr int LDS_BYTES = 160 * 1024;
static_assert(MISC_OFF + 128 <= LDS_BYTES, "LDS map");

#define GAS __attribute__((address_space(1)))
#define LAS __attribute__((address_space(3)))
typedef unsigned short bf16;
typedef unsigned v4u __attribute__((ext_vector_type(4)));
typedef unsigned v2u __attribute__((ext_vector_type(2)));
typedef float f32x4 __attribute__((ext_vector_type(4)));
typedef float f32x2 __attribute__((ext_vector_type(2)));
typedef short bf16x8 __attribute__((ext_vector_type(8)));
typedef GAS unsigned gu32;
#define RLX_AGENT __ATOMIC_RELAXED, __HIP_MEMORY_SCOPE_AGENT
#define LDS_WAIT() asm volatile("s_waitcnt lgkmcnt(0)" ::: "memory")
#define VM_WAIT() asm volatile("s_waitcnt vmcnt(0)" ::: "memory")
__device__ __forceinline__ unsigned f2bf(float f) { unsigned u = __builtin_bit_cast(unsigned, f); return (u + 0x7fffu + ((u >> 16) & 1u)) >> 16; }
__device__ __forceinline__ unsigned pk2(float lo, float hi) { return f2bf(lo) | (f2bf(hi) << 16); }
__device__ __forceinline__ float bflo(unsigned w) { return __uint_as_float(w << 16); }
__device__ __forceinline__ float bfhi(unsigned w) { return __uint_as_float(w & 0xffff0000u); }
__device__ __forceinline__ float bf1(bf16 v) { return __uint_as_float((unsigned)v << 16); }

#define XB_TMO      128
#define XB_XCNT(j)  (256  + 64 * (j))
#define XB_XSUB(j)  (1280 + 64 * (j))
#define XB_XGEN(j)  (2304 + 64 * (j))
#define XB_TOP      3328
#define XB_TOPGEN   3392
#define XCD_BAR_WORDS 3456
#define XB_SPIN_CAP (1u << 20)

__device__ __forceinline__ unsigned xb_ld(unsigned* p)              { return __hip_atomic_load(p, __ATOMIC_RELAXED, __HIP_MEMORY_SCOPE_AGENT); }
__device__ __forceinline__ unsigned xb_add(unsigned* p, unsigned v) { return __hip_atomic_fetch_add(p, v, __ATOMIC_RELAXED, __HIP_MEMORY_SCOPE_AGENT); }
__device__ __forceinline__ unsigned xb_xcc_id() { return (unsigned)__builtin_amdgcn_s_getreg((3 << 11) | 20) & 0xFu; }
#define XB_SPIN(cond, bar) do { unsigned _sp = 0; while (cond) { __builtin_amdgcn_s_sleep(1); \
    if ((++_sp & 255u) == 0u) { if (xb_ld(&(bar)[XB_TMO])) break; if (_sp > XB_SPIN_CAP) { atomicAdd(&(bar)[XB_TMO], 1u); break; } } } } while (0)

struct XcdBarrier { unsigned* bar; unsigned x; volatile LAS unsigned* st; };

__device__ __forceinline__ XcdBarrier xcd_barrier_post(unsigned* bar, volatile LAS unsigned* st) {
    XcdBarrier b; b.bar = bar; b.x = xb_xcc_id(); b.st = st;
    if (threadIdx.x == 0) (void)xb_add(&bar[XB_XCNT(b.x)], 1u);
    return b;
}
__device__ __forceinline__ void xcd_barrier_complete(unsigned* bar, unsigned x, unsigned& nloc, unsigned& nx) {
    const unsigned G = gridDim.x * gridDim.y * gridDim.z;
    unsigned sum, cnt, mine, sp = 0u;
    for (;;) {
        sum = 0u; cnt = 0u; mine = 0u;
#pragma unroll
        for (unsigned j = 0; j < 16; ++j) { const unsigned c = xb_ld(&bar[XB_XCNT(j)]); sum += c; cnt += (c > 0u) ? 1u : 0u; mine = (j == x) ? c : mine; }
        if (sum == G) break;
        __builtin_amdgcn_s_sleep(1);
        if ((++sp & 255u) == 0u) { if (xb_ld(&bar[XB_TMO])) break; if (sp > XB_SPIN_CAP) { atomicAdd(&bar[XB_TMO], 1u); break; } }
    }
    nloc = mine > 0u ? mine : 1u; nx = cnt > 0u ? cnt : 1u;
}
__device__ __forceinline__ void xcd_barrier(const XcdBarrier& b) {
    asm volatile("s_waitcnt vmcnt(0)" ::: "memory");
    __syncthreads();
    if (threadIdx.x == 0) {
        unsigned* bar = b.bar;
        __builtin_amdgcn_s_waitcnt(0);
        unsigned nloc = b.st[0], nx = b.st[1];
        if (nloc == 0u) { xcd_barrier_complete(bar, b.x, nloc, nx); b.st[0] = nloc; b.st[1] = nx; }
        const unsigned old = xb_add(&bar[XB_XSUB(b.x)], 1u);
        const unsigned gen = old / nloc;
        if (old + 1u == (gen + 1u) * nloc) {
            __builtin_amdgcn_fence(__ATOMIC_RELEASE, "agent");
            asm volatile("s_waitcnt vmcnt(0)" ::: "memory");
            const unsigned og = xb_add(&bar[XB_TOP], 1u);
            const unsigned tg = og / nx;
            if (og + 1u == (tg + 1u) * nx) xb_add(&bar[XB_TOPGEN], 1u);
            else XB_SPIN(xb_ld(&bar[XB_TOPGEN]) == tg, bar);
            __builtin_amdgcn_fence(__ATOMIC_ACQUIRE, "agent");
            xb_add(&bar[XB_XGEN(b.x)], 1u);
            asm volatile("s_waitcnt vmcnt(0)" ::: "memory");
        } else {
            XB_SPIN(xb_ld(&bar[XB_XGEN(b.x)]) == gen, bar);
            __builtin_amdgcn_fence(__ATOMIC_ACQUIRE, "agent");
            asm volatile("s_waitcnt vmcnt(0)" ::: "memory");
        }
    }
    __syncthreads();
}

struct Frame {
    LAS unsigned char* lds;
    volatile LAS unsigned* MISC;
    gu32* ctl;
    int tid, lane, wave;
    int vcu, G;
    const float* in[25]; float* out; unsigned char* ws;
};

__device__ __forceinline__ float wave_sum(float v) {
#pragma unroll
    for (int o = 1; o < 64; o <<= 1) v += __shfl_xor(v, o);
    return v;
}
template <int CTRL> __device__ __forceinline__ float dppx(float x) {
    return __builtin_bit_cast(float, __builtin_amdgcn_mov_dpp(__builtin_bit_cast(int, x), CTRL, 0xf, 0xf, true));
}
__device__ __forceinline__ float row16_sum(float v) {
    v += dppx<0xB1>(v); v += dppx<0x4E>(v); v += dppx<0x141>(v); v += dppx<0x128>(v); return v;
}

__device__ __forceinline__ void p0_transpose_item(const float* W, int N, bf16* WT, int ldw, int k0, int n0, int drow0, const float* kscale, LAS float* scr, int lane) {
#pragma unroll 8
    for (int i = 0; i < 32; ++i) { const int kk = 2 * i + (lane >> 5); float v = W[(size_t)(k0 + kk) * N + n0 + (lane & 31)]; if (kscale) v *= kscale[k0 + kk]; scr[kk * 33 + (lane & 31)] = v; }
    LDS_WAIT(); asm volatile("" ::: "memory");
    const int c = lane & 7;
#pragma unroll
    for (int j = 0; j < 4; ++j) { const int n = (lane >> 3) + 8 * j; const LAS float* s = scr + (8 * c) * 33 + n;
        v4u o; o.x = pk2(s[0 * 33], s[1 * 33]); o.y = pk2(s[2 * 33], s[3 * 33]); o.z = pk2(s[4 * 33], s[5 * 33]); o.w = pk2(s[6 * 33], s[7 * 33]);
        *(GAS v4u*)(WT + (size_t)(drow0 + n) * ldw + k0 + 8 * c) = o; }
    LDS_WAIT(); asm volatile("" ::: "memory");
}
__device__ __forceinline__ void p0_prologue(Frame& F) {
    LAS float* scr = (LAS float*)(F.lds + RING_OFF + F.wave * 16384);
    const int gw = F.vcu * NWAVES + F.wave, NGW = F.G * NWAVES;
    unsigned char* ws = F.ws;
    constexpr int I_IN = (D / 64) * (IN_COLS / 32), I_RW = (RWW / 64) * (D / 32), I_RET = (D / 64) * (D / 32), I_OUT = I_RET, I_UP = (D / 64) * (2 * DFF / 32), I_DN = (DFF / 64) * (D / 32);
    constexpr int I_W2 = (64 / 64) * (RWW / 32), I_G2 = (128 / 64) * (RWW / 32);
    constexpr int NITEMS = I_IN + I_RW + I_RET + I_OUT + I_UP + I_DN + 2 * I_W2 + I_G2;
    for (int it = gw; it < NITEMS; it += NGW) {
        int r = it;
        if (r < I_IN) { const int nb = IN_COLS / 32, kb = r / nb, n0 = 32 * (r % nb); p0_transpose_item(F.in[6], IN_COLS, (bf16*)(ws + WS_WIN), D, 64 * kb, n0, n0, F.in[2], scr, F.lane); continue; } r -= I_IN;
        if (r < I_RW) { const int nb = D / 32, kb = r / nb, n0 = 32 * (r % nb); p0_transpose_item(F.in[18], D, (bf16*)(ws + WS_WRW), RWW, 64 * kb, n0, n0, nullptr, scr, F.lane); continue; } r -= I_RW;
        if (r < I_RET) { const int nb = D / 32, kb = r / nb, n0 = 32 * (r % nb); p0_transpose_item(F.in[19], D, (bf16*)(ws + WS_WRET), D, 64 * kb, n0, n0, nullptr, scr, F.lane); continue; } r -= I_RET;
        if (r < I_OUT) { const int nb = D / 32, kb = r / nb, n0 = 32 * (r % nb); p0_transpose_item(F.in[20], D, (bf16*)(ws + WS_WOUT), D, 64 * kb, n0, n0, nullptr, scr, F.lane); continue; } r -= I_OUT;
        if (r < I_UP) { const int nb = 2 * DFF / 32, kb = r / nb, n0 = 32 * (r % nb);
            const int j = (n0 < DFF) ? n0 : n0 - DFF, drow = (j / 128) * 256 + (j % 128) + ((n0 < DFF) ? 0 : 128);
            p0_transpose_item(F.in[21], 2 * DFF, (bf16*)(ws + WS_WUP), D, 64 * kb, n0, drow, F.in[4], scr, F.lane); continue; } r -= I_UP;
        if (r < I_DN) { const int nb = D / 32, kb = r / nb, n0 = 32 * (r % nb); p0_transpose_item(F.in[24], D, (bf16*)(ws + WS_WDN), DFF, 64 * kb, n0, n0, nullptr, scr, F.lane); continue; } r -= I_DN;
        if (r < I_W2) { const int n0 = 32 * r; p0_transpose_item(F.in[9], RWW, (bf16*)(ws + WS_RWW), 64, 0, n0, n0, nullptr, scr, F.lane); continue; } r -= I_W2;
        if (r < I_W2) { const int n0 = 32 * r; p0_transpose_item(F.in[11], RWW, (bf16*)(ws + WS_RWW + 65536), 64, 0, n0, n0, nullptr, scr, F.lane); continue; } r -= I_W2;
        { const int nb = RWW / 32, kb = r / nb, n0 = 32 * (r % nb); p0_transpose_item(F.in[12], RWW, (bf16*)(ws + WS_RWW + 131072), 128, 64 * kb, n0, n0, nullptr, scr, F.lane); }
    }
    const float* x = F.in[0]; bf16* XN = (bf16*)((unsigned char*)F.out + OUT_XN);
    for (int m = gw; m < M; m += NGW) {
        const GAS f32x4* xr = (const GAS f32x4*)(x + (size_t)m * D) + F.lane;
        f32x4 v[4]; float s = 0.f;
#pragma unroll
        for (int j = 0; j < 4; ++j) { v[j] = xr[64 * j]; s += (v[j].x * v[j].x + v[j].y * v[j].y) + (v[j].z * v[j].z + v[j].w * v[j].w); }
        const float rstd = 1.0f / sqrtf(wave_sum(s) * (1.f / D) + RMS_EPS);
        GAS v2u* o8 = (GAS v2u*)(XN + (size_t)m * D) + F.lane;
#pragma unroll
        for (int j = 0; j < 4; ++j) { v2u o; o.x = pk2(v[j].x * rstd, v[j].y * rstd); o.y = pk2(v[j].z * rstd, v[j].w * rstd); o8[64 * j] = o; }
    }
    {
        const int* pos = (const int*)F.in[1]; f32x2* rope = (f32x2*)(ws + WS_ROPE);
        const int gt = (F.vcu * NWAVES + F.wave) * 64 + F.lane, NT = F.G * NWAVES * 64;
        const int j = gt & 31;
        const double inv = exp2(-(double)j * (13.287712379549449 / 32.0));
        for (int e = gt; e < M * 32; e += NT) {
            const int row = e >> 5;
            double a = (double)pos[row] * inv; a -= 6.283185307179586 * rint(a * 0.15915494309189535);
            float sn, cs; sincosf((float)a, &sn, &cs);
            rope[e] = (f32x2){cs, sn};
        }
    }
}

constexpr int RW_TC = 32;
constexpr int RWL_STEP = 0, RWL_YB = 49152, RWL_GATE = 57344, RWL_BONUS = 65536, RWL_AW = 65664, RWL_AA = 70272, RWL_AG = 74880, RWL_W2T = 83584, RWL_A2T = 92800, RWL_G2T = 102016, RWL_END = 119424;
static_assert(RWL_END <= RING_BYTES, "rwkv lds");
__device__ __forceinline__ float softplusf(float x) { return fmaxf(x, 0.f) + log1pf(expf(-fabsf(x))); }

__device__ __forceinline__ void rwkv_phase(Frame& F) {
    LAS unsigned char* L = F.lds;
    LAS float* STEP = (LAS float*)(L + RWL_STEP);
    LAS float* YB = (LAS float*)(L + RWL_YB);
    LAS float* GATE = (LAS float*)(L + RWL_GATE);
    LAS float* BONUS = (LAS float*)(L + RWL_BONUS);
    LAS bf16* AW = (LAS bf16*)(L + RWL_AW);
    LAS bf16* AA = (LAS bf16*)(L + RWL_AA);
    LAS bf16* AG = (LAS bf16*)(L + RWL_AG);
    LAS bf16* W2T = (LAS bf16*)(L + RWL_W2T);
    LAS bf16* A2T = (LAS bf16*)(L + RWL_A2T);
    LAS bf16* G2T = (LAS bf16*)(L + RWL_G2T);
    const int tid = F.tid, lane = F.lane, w = F.wave;
    const bf16* PRW = (const bf16*)(F.ws + WS_PRW);
    bf16* Yrw = (bf16*)((unsigned char*)F.out + OUT_YRW);
    const float* mu = F.in[7]; const float* w0 = F.in[8]; const float* a0 = F.in[10]; const float* k_k = F.in[13]; const float* k_a = F.in[14]; const float* r_k = F.in[15];
    const float* lnw = F.in[16]; const float* lnb = F.in[17];
    for (int unit = F.vcu; unit < BATCH * RWH; unit += F.G) {
        const int b = unit >> 3, h = unit & 7;
        __syncthreads();
        {
            const bf16* w2g = (const bf16*)(F.ws + WS_RWW) + (size_t)h * 64 * 64; const bf16* a2g = (const bf16*)(F.ws + WS_RWW + 65536) + (size_t)h * 64 * 64; const bf16* g2g = (const bf16*)(F.ws + WS_RWW + 131072) + (size_t)h * 64 * 128;
            { const int n = tid >> 3, c = tid & 7; *(LAS v4u*)(W2T + n * 72 + 8 * c) = *(const v4u*)(w2g + n * 64 + 8 * c); *(LAS v4u*)(A2T + n * 72 + 8 * c) = *(const v4u*)(a2g + n * 64 + 8 * c); }
#pragma unroll
            for (int q = 0; q < 2; ++q) { const int e = tid + 512 * q, n = e >> 4, c = e & 15; *(LAS v4u*)(G2T + n * 136 + 8 * c) = *(const v4u*)(g2g + n * 128 + 8 * c); }
        }
        const int kg = lane & 15, rg = lane >> 4, row0 = 8 * w + 2 * rg;
        f32x4 S0 = (f32x4){0.f, 0.f, 0.f, 0.f}, S1 = (f32x4){0.f, 0.f, 0.f, 0.f};
        for (int t0 = 0; t0 < T; t0 += RW_TC) {
            for (int it = tid; it < RW_TC * 56; it += 512) {
                const int tt = it / 56, cc = it % 56;
                int gc; if (cc < 8) gc = h * 64 + 8 * cc; else if (cc < 16) gc = 512 + h * 64 + 8 * (cc - 8); else if (cc < 24) gc = 1024 + h * 64 + 8 * (cc - 16); else gc = 1536 + 8 * (cc - 24);
                const size_t row = (size_t)b * T + t0 + tt;
                const v4u cw = *(const v4u*)(PRW + row * RW_COLS + gc);
                v4u pw = (v4u){0u, 0u, 0u, 0u}; if (t0 + tt > 0) pw = *(const v4u*)(PRW + (row - 1) * RW_COLS + gc);
                const f32x4 m0 = *(const f32x4*)(mu + gc), m1 = *(const f32x4*)(mu + gc + 4);
                float x[8];
                { const float c0 = bflo(cw.x), c1 = bfhi(cw.x), c2 = bflo(cw.y), c3 = bfhi(cw.y), c4 = bflo(cw.z), c5 = bfhi(cw.z), c6 = bflo(cw.w), c7 = bfhi(cw.w);
                  x[0] = c0 + (bflo(pw.x) - c0) * m0[0]; x[1] = c1 + (bfhi(pw.x) - c1) * m0[1]; x[2] = c2 + (bflo(pw.y) - c2) * m0[2]; x[3] = c3 + (bfhi(pw.y) - c3) * m0[3];
                  x[4] = c4 + (bflo(pw.z) - c4) * m1[0]; x[5] = c5 + (bfhi(pw.z) - c5) * m1[1]; x[6] = c6 + (bflo(pw.w) - c6) * m1[2]; x[7] = c7 + (bfhi(pw.w) - c7) * m1[3]; }
                if (cc < 24) {
                    const int a = (cc < 8) ? 4 : (cc < 16) ? 3 : 5; const int c8 = 8 * (cc & 7);
                    LAS f32x4* d = (LAS f32x4*)(STEP + (tt * 6 + a) * 64 + c8);
                    d[0] = (f32x4){x[0], x[1], x[2], x[3]}; d[1] = (f32x4){x[4], x[5], x[6], x[7]};
                } else if (cc < 32) {
                    v4u o; o.x = pk2(tanhf(x[0]), tanhf(x[1])); o.y = pk2(tanhf(x[2]), tanhf(x[3])); o.z = pk2(tanhf(x[4]), tanhf(x[5])); o.w = pk2(tanhf(x[6]), tanhf(x[7]));
                    *(LAS v4u*)(AW + tt * 72 + 8 * (cc - 24)) = o;
                } else if (cc < 40) {
                    v4u o; o.x = pk2(x[0], x[1]); o.y = pk2(x[2], x[3]); o.z = pk2(x[4], x[5]); o.w = pk2(x[6], x[7]);
                    *(LAS v4u*)(AA + tt * 72 + 8 * (cc - 32)) = o;
                } else {
                    float s[8];
#pragma unroll
                    for (int i = 0; i < 8; ++i) s[i] = 1.0f / (1.0f + expf(-x[i]));
                    v4u o; o.x = pk2(s[0], s[1]); o.y = pk2(s[2], s[3]); o.z = pk2(s[4], s[5]); o.w = pk2(s[6], s[7]);
                    *(LAS v4u*)(AG + tt * 136 + 8 * (cc - 40)) = o;
                }
            }
            __syncthreads();
            {
                const int fr = lane & 15, fq = lane >> 4;
                if (w < 4) {
                    const bool isw = (w < 2); const int mb = w & 1;
                    LAS bf16* Aop = isw ? AW : AA; LAS bf16* Bop = isw ? W2T : A2T;
                    f32x4 acc[4];
#pragma unroll
                    for (int nb = 0; nb < 4; ++nb) acc[nb] = (f32x4){0.f, 0.f, 0.f, 0.f};
#pragma unroll
                    for (int ks = 0; ks < 2; ++ks) { const bf16x8 af = *(const LAS bf16x8*)(Aop + (mb * 16 + fr) * 72 + ks * 32 + 8 * fq);
#pragma unroll
                        for (int nb = 0; nb < 4; ++nb) { const bf16x8 bfv = *(const LAS bf16x8*)(Bop + (nb * 16 + fr) * 72 + ks * 32 + 8 * fq);
                            acc[nb] = __builtin_amdgcn_mfma_f32_16x16x32_bf16(af, bfv, acc[nb], 0, 0, 0); } }
                    if (isw) {
#pragma unroll
                        for (int nb = 0; nb < 4; ++nb) { const int c = nb * 16 + fr; const float w0c = w0[h * 64 + c];
#pragma unroll
                            for (int rg4 = 0; rg4 < 4; ++rg4) { const int tt = mb * 16 + 4 * fq + rg4; const float wl = -softplusf(-(w0c + acc[nb][rg4])) - 0.5f;
                                STEP[(tt * 6 + 0) * 64 + c] = expf(-expf(wl)); } }
                    } else {
                        float a_[4][4], xk[4][4], kkr[4][4]; float n2[4] = {0.f, 0.f, 0.f, 0.f};
#pragma unroll
                        for (int nb = 0; nb < 4; ++nb) { const int c = nb * 16 + fr; const float a0c = a0[h * 64 + c], kkc = k_k[h * 64 + c];
#pragma unroll
                            for (int rg4 = 0; rg4 < 4; ++rg4) { const int tt = mb * 16 + 4 * fq + rg4; a_[nb][rg4] = 1.0f / (1.0f + expf(-(a0c + acc[nb][rg4])));
                                xk[nb][rg4] = STEP[(tt * 6 + 3) * 64 + c]; kkr[nb][rg4] = xk[nb][rg4] * kkc; n2[rg4] += kkr[nb][rg4] * kkr[nb][rg4]; } }
                        float bon[4] = {0.f, 0.f, 0.f, 0.f};
#pragma unroll
                        for (int rg4 = 0; rg4 < 4; ++rg4) n2[rg4] = 1.0f / fmaxf(sqrtf(row16_sum(n2[rg4])), 1e-12f);
#pragma unroll
                        for (int nb = 0; nb < 4; ++nb) { const int c = nb * 16 + fr; const float kac = k_a[h * 64 + c], rkc = r_k[h * 64 + c];
#pragma unroll
                            for (int rg4 = 0; rg4 < 4; ++rg4) { const int tt = mb * 16 + 4 * fq + rg4; const float kk = kkr[nb][rg4] * n2[rg4], a = a_[nb][rg4];
                                const float kx = xk[nb][rg4] * (1.0f + (a - 1.0f) * kac);
                                STEP[(tt * 6 + 1) * 64 + c] = -kk; STEP[(tt * 6 + 2) * 64 + c] = kk * a; STEP[(tt * 6 + 3) * 64 + c] = kx;
                                bon[rg4] += STEP[(tt * 6 + 4) * 64 + c] * kx * rkc; } }
#pragma unroll
                        for (int rg4 = 0; rg4 < 4; ++rg4) { const float bs = row16_sum(bon[rg4]); if (fr == 0) BONUS[mb * 16 + 4 * fq + rg4] = bs; }
                    }
                } else {
                    const int mb = (w - 4) & 1, nb0 = ((w - 4) >> 1) * 2;
                    f32x4 acc[2]; acc[0] = (f32x4){0.f, 0.f, 0.f, 0.f}; acc[1] = acc[0];
#pragma unroll
                    for (int ks = 0; ks < 4; ++ks) { const bf16x8 af = *(const LAS bf16x8*)(AG + (mb * 16 + fr) * 136 + ks * 32 + 8 * fq);
#pragma unroll
                        for (int q = 0; q < 2; ++q) { const bf16x8 bfv = *(const LAS bf16x8*)(G2T + ((nb0 + q) * 16 + fr) * 136 + ks * 32 + 8 * fq);
                            acc[q] = __builtin_amdgcn_mfma_f32_16x16x32_bf16(af, bfv, acc[q], 0, 0, 0); } }
#pragma unroll
                    for (int q = 0; q < 2; ++q)
#pragma unroll
                        for (int rg4 = 0; rg4 < 4; ++rg4) GATE[(mb * 16 + 4 * fq + rg4) * 64 + (nb0 + q) * 16 + fr] = acc[q][rg4];
                }
            }
            __syncthreads();
#pragma unroll 2
            for (int tt = 0; tt < RW_TC; ++tt) {
                const LAS float* sp = STEP + tt * 384;
                const f32x4 dec = *(const LAS f32x4*)(sp + 4 * kg), kkn = *(const LAS f32x4*)(sp + 64 + 4 * kg), bb = *(const LAS f32x4*)(sp + 128 + 4 * kg);
                const f32x4 kx = *(const LAS f32x4*)(sp + 192 + 4 * kg), rr = *(const LAS f32x4*)(sp + 256 + 4 * kg);
                const f32x2 vv = *(const LAS f32x2*)(sp + 320 + row0);
                float p0 = (S0[0] * kkn[0] + S0[1] * kkn[1]) + (S0[2] * kkn[2] + S0[3] * kkn[3]);
                float p1 = (S1[0] * kkn[0] + S1[1] * kkn[1]) + (S1[2] * kkn[2] + S1[3] * kkn[3]);
                const float sa0 = row16_sum(p0), sa1 = row16_sum(p1);
                S0 = S0 * dec + sa0 * bb + vv[0] * kx;
                S1 = S1 * dec + sa1 * bb + vv[1] * kx;
                float q0 = (S0[0] * rr[0] + S0[1] * rr[1]) + (S0[2] * rr[2] + S0[3] * rr[3]);
                float q1 = (S1[0] * rr[0] + S1[1] * rr[1]) + (S1[2] * rr[2] + S1[3] * rr[3]);
                q0 = row16_sum(q0); q1 = row16_sum(q1);
                if (kg == 0) *(LAS f32x2*)(YB + tt * 64 + row0) = (f32x2){q0, q1};
            }
            __syncthreads();
            {
                const int tt = tid >> 4, cq = tid & 15, c = 4 * cq;
                const f32x4 y = *(const LAS f32x4*)(YB + tt * 64 + c);
                const float mean = row16_sum((y[0] + y[1]) + (y[2] + y[3])) * (1.f / 64.f);
                const f32x4 dlt = y - mean;
                const float var = row16_sum((dlt[0] * dlt[0] + dlt[1] * dlt[1]) + (dlt[2] * dlt[2] + dlt[3] * dlt[3])) * (1.f / 64.f);
                const float rs = 1.0f / sqrtf(var + RW_GN_EPS);
                const f32x4 lw = *(const f32x4*)(lnw + h * 64 + c), lb = *(const f32x4*)(lnb + h * 64 + c);
                const f32x4 vv = *(const LAS f32x4*)(STEP + (tt * 6 + 5) * 64 + c), gt = *(const LAS f32x4*)(GATE + tt * 64 + c);
                const float bo = BONUS[tt];
                f32x4 o = (dlt * rs * lw + lb + bo * vv) * gt;
                v2u pw; pw.x = pk2(o[0], o[1]); pw.y = pk2(o[2], o[3]);
                *(v2u*)(Yrw + ((size_t)b * T + t0 + tt) * RWW + h * 64 + c) = pw;
            }
            __syncthreads();
        }
    }
}

constexpr int RTL_Q = 0, RTL_K1 = 18432, RTL_K1T = 36864, RTL_VT = 54272, RTL_SP = 89088, RTL_RT = 123904, RTL_END = 142336;
static_assert(RTL_END <= LDSCTL_OFF, "retention lds");
__device__ __forceinline__ void retention_phase(Frame& F) {
    LAS unsigned char* L = F.lds;
    LAS bf16* Q = (LAS bf16*)(L + RTL_Q);
    LAS bf16* K1 = (LAS bf16*)(L + RTL_K1);
    LAS bf16* K1T = (LAS bf16*)(L + RTL_K1T);
    LAS bf16* VT = (LAS bf16*)(L + RTL_VT);
    LAS bf16* SP = (LAS bf16*)(L + RTL_SP);
    LAS bf16* RT = (LAS bf16*)(L + RTL_RT);
    const int tid = F.tid, lane = F.lane, w = F.wave, fr = lane & 15, fq = lane >> 4;
    const bf16* PRET = (const bf16*)(F.ws + WS_PRET);
    const f32x2* rope = (const f32x2*)(F.ws + WS_ROPE);
    bf16* Yret = (bf16*)((unsigned char*)F.out + OUT_YRET);
    for (int unit = F.vcu; unit < BATCH * RTH; unit += F.G) {
        const int b = unit >> 3, h = unit & 7;
        const float lg = log1pf(-exp2f(-5.0f - (float)h));
        const float cdec = expf(128.0f * lg);
        __syncthreads();
        for (int e = tid; e < 128 * 72 / 8; e += 512) *(LAS v4u*)(RT + 8 * e) = (v4u){0u, 0u, 0u, 0u};
        f32x4 accR[4];
#pragma unroll
        for (int db = 0; db < 4; ++db) accR[db] = (f32x4){0.f, 0.f, 0.f, 0.f};
        for (int ch = 0; ch < T / RCH; ++ch) {
            const size_t rowbase = (size_t)b * T + (size_t)ch * RCH;
            {
                const int i = tid >> 2, jc = tid & 3; const size_t row = rowbase + i;
                const f32x4* rp = (const f32x4*)(rope + row * 32 + 8 * jc);
                const f32x4 r0 = rp[0], r1 = rp[1], r2 = rp[2], r3 = rp[3];
                const float cs[8] = {r0[0], r0[2], r1[0], r1[2], r2[0], r2[2], r3[0], r3[2]}, sn[8] = {r0[1], r0[3], r1[1], r1[3], r2[1], r2[3], r3[1], r3[3]};
                {
                    const v4u a = *(const v4u*)(PRET + row * RET_COLS + h * 64 + 8 * jc), c = *(const v4u*)(PRET + row * RET_COLS + h * 64 + 32 + 8 * jc);
                    const float z1[8] = {bflo(a.x), bfhi(a.x), bflo(a.y), bfhi(a.y), bflo(a.z), bfhi(a.z), bflo(a.w), bfhi(a.w)}, z2[8] = {bflo(c.x), bfhi(c.x), bflo(c.y), bfhi(c.y), bflo(c.z), bfhi(c.z), bflo(c.w), bfhi(c.w)};
                    float o1[8], o2[8];
#pragma unroll
                    for (int q = 0; q < 8; ++q) { o1[q] = z1[q] * cs[q] - z2[q] * sn[q]; o2[q] = z1[q] * sn[q] + z2[q] * cs[q]; }
                    v4u p1, p2; p1.x = pk2(o1[0], o1[1]); p1.y = pk2(o1[2], o1[3]); p1.z = pk2(o1[4], o1[5]); p1.w = pk2(o1[6], o1[7]); p2.x = pk2(o2[0], o2[1]); p2.y = pk2(o2[2], o2[3]); p2.z = pk2(o2[4], o2[5]); p2.w = pk2(o2[6], o2[7]);
                    *(LAS v4u*)(Q + i * 72 + 8 * jc) = p1; *(LAS v4u*)(Q + i * 72 + 32 + 8 * jc) = p2;
                }
                {
                    const float ksc = 0.125f * expf(-(float)(i + 1) * lg);
                    const v4u a = *(const v4u*)(PRET + row * RET_COLS + 512 + h * 64 + 8 * jc), c = *(const v4u*)(PRET + row * RET_COLS + 512 + h * 64 + 32 + 8 * jc);
                    const float z1[8] = {bflo(a.x), bfhi(a.x), bflo(a.y), bfhi(a.y), bflo(a.z), bfhi(a.z), bflo(a.w), bfhi(a.w)}, z2[8] = {bflo(c.x), bfhi(c.x), bflo(c.y), bfhi(c.y), bflo(c.z), bfhi(c.z), bflo(c.w), bfhi(c.w)};
                    unsigned short o1[8], o2[8];
#pragma unroll
                    for (int q = 0; q < 8; ++q) { o1[q] = (unsigned short)f2bf((z1[q] * cs[q] - z2[q] * sn[q]) * ksc); o2[q] = (unsigned short)f2bf((z1[q] * sn[q] + z2[q] * cs[q]) * ksc); }
                    v4u p1, p2; p1.x = o1[0] | (o1[1] << 16); p1.y = o1[2] | (o1[3] << 16); p1.z = o1[4] | (o1[5] << 16); p1.w = o1[6] | (o1[7] << 16);
                    p2.x = o2[0] | (o2[1] << 16); p2.y = o2[2] | (o2[3] << 16); p2.z = o2[4] | (o2[5] << 16); p2.w = o2[6] | (o2[7] << 16);
                    *(LAS v4u*)(K1 + i * 72 + 8 * jc) = p1; *(LAS v4u*)(K1 + i * 72 + 32 + 8 * jc) = p2;
#pragma unroll
                    for (int q = 0; q < 8; ++q) { K1T[(8 * jc + q) * 136 + i] = o1[q]; K1T[(32 + 8 * jc + q) * 136 + i] = o2[q]; }
                }
#pragma unroll
                for (int q4 = 0; q4 < 4; ++q4) { const int e = tid + 512 * q4, iv = e >> 4, vc = e & 15;
                    const v4u a = *(const v4u*)(PRET + (rowbase + iv) * RET_COLS + 1024 + h * 128 + 8 * vc);
                    VT[(8 * vc + 0) * 136 + iv] = (bf16)(a.x & 0xffffu); VT[(8 * vc + 1) * 136 + iv] = (bf16)(a.x >> 16); VT[(8 * vc + 2) * 136 + iv] = (bf16)(a.y & 0xffffu); VT[(8 * vc + 3) * 136 + iv] = (bf16)(a.y >> 16);
                    VT[(8 * vc + 4) * 136 + iv] = (bf16)(a.z & 0xffffu); VT[(8 * vc + 5) * 136 + iv] = (bf16)(a.z >> 16); VT[(8 * vc + 6) * 136 + iv] = (bf16)(a.w & 0xffffu); VT[(8 * vc + 7) * 136 + iv] = (bf16)(a.w >> 16); }
            }
            __syncthreads();
            const int i0 = 16 * w;
            bf16x8 qf[2];
#pragma unroll
            for (int ks = 0; ks < 2; ++ks) qf[ks] = *(const LAS bf16x8*)(Q + (i0 + fr) * 72 + ks * 32 + 8 * fq);
            LAS bf16* SPw = SP + w * 16 * 136;
#pragma unroll
            for (int nb = 0; nb < 8; ++nb) {
                f32x4 s = (f32x4){0.f, 0.f, 0.f, 0.f};
#pragma unroll
                for (int ks = 0; ks < 2; ++ks) { const bf16x8 kf = *(const LAS bf16x8*)(K1 + (nb * 16 + fr) * 72 + ks * 32 + 8 * fq); s = __builtin_amdgcn_mfma_f32_16x16x32_bf16(qf[ks], kf, s, 0, 0, 0); }
                const int key = nb * 16 + fr;
#pragma unroll
                for (int rg4 = 0; rg4 < 4; ++rg4) { const int qi = i0 + 4 * fq + rg4; SPw[(4 * fq + rg4) * 136 + key] = (bf16)f2bf(key <= qi ? s[rg4] : 0.f); }
            }
            LDS_WAIT();
            f32x4 o[8];
#pragma unroll
            for (int nb = 0; nb < 8; ++nb) o[nb] = (f32x4){0.f, 0.f, 0.f, 0.f};
#pragma unroll
            for (int ks = 0; ks < 4; ++ks) { const bf16x8 sf = *(const LAS bf16x8*)(SPw + fr * 136 + ks * 32 + 8 * fq);
#pragma unroll
                for (int nb = 0; nb < 8; ++nb) { const bf16x8 vf = *(const LAS bf16x8*)(VT + (nb * 16 + fr) * 136 + ks * 32 + 8 * fq); o[nb] = __builtin_amdgcn_mfma_f32_16x16x32_bf16(sf, vf, o[nb], 0, 0, 0); } }
#pragma unroll
            for (int ks = 0; ks < 2; ++ks)
#pragma unroll
                for (int nb = 0; nb < 8; ++nb) { const bf16x8 rf = *(const LAS bf16x8*)(RT + (nb * 16 + fr) * 72 + ks * 32 + 8 * fq); o[nb] = __builtin_amdgcn_mfma_f32_16x16x32_bf16(qf[ks], rf, o[nb], 0, 0, 0); }
#pragma unroll
            for (int ks = 0; ks < 4; ++ks) { const bf16x8 vf = *(const LAS bf16x8*)(VT + (w * 16 + fr) * 136 + ks * 32 + 8 * fq);
#pragma unroll
                for (int db = 0; db < 4; ++db) { const bf16x8 kf = *(const LAS bf16x8*)(K1T + (db * 16 + fr) * 136 + ks * 32 + 8 * fq); accR[db] = __builtin_amdgcn_mfma_f32_16x16x32_bf16(vf, kf, accR[db], 0, 0, 0); } }
#pragma unroll
            for (int db = 0; db < 4; ++db) accR[db] = accR[db] * cdec;
#pragma unroll
            for (int rg4 = 0; rg4 < 4; ++rg4) {
                const int il = i0 + 4 * fq + rg4; const float qd = expf((float)(il + 1) * lg);
                float s1 = 0.f;
#pragma unroll
                for (int nb = 0; nb < 8; ++nb) { o[nb][rg4] *= qd; s1 += o[nb][rg4]; }
                const float mean = row16_sum(s1) * (1.f / 128.f);
                float s2 = 0.f;
#pragma unroll
                for (int nb = 0; nb < 8; ++nb) { const float dl = o[nb][rg4] - mean; s2 += dl * dl; }
                const float rs = 1.0f / sqrtf(row16_sum(s2) * (1.f / 128.f) + RET_GN_EPS);
                const size_t row = rowbase + il;
#pragma unroll
                for (int nb = 0; nb < 8; ++nb) { const int e = nb * 16 + fr; const float gv = bf1(PRET[row * RET_COLS + 2048 + h * 128 + e]);
                    Yret[row * 1024 + h * 128 + e] = (bf16)f2bf((o[nb][rg4] - mean) * rs * gv); }
            }
            __syncthreads();
#pragma unroll
            for (int db = 0; db < 4; ++db)
#pragma unroll
                for (int rg4 = 0; rg4 < 4; ++rg4) RT[(w * 16 + 4 * fq + rg4) * 72 + db * 16 + fr] = (bf16)f2bf(accR[db][rg4]);
        }
    }
}

__device__ __forceinline__ void norm_mix_phase(Frame& F) {
    const int gw = F.vcu * NWAVES + F.wave, NGW = F.G * NWAVES;
    const bf16* Z = (const bf16*)(F.ws + WS_Z); const float* part = (const float*)(F.ws + WS_PART); const float* x = F.in[0]; const float* gpost = F.in[3];
    bf16* XN2 = (bf16*)(F.ws + WS_XN2);
    f32x4 g[4];
#pragma unroll
    for (int j = 0; j < 4; ++j) g[j] = ((const f32x4*)gpost)[F.lane + 64 * j];
    for (int m = gw; m < M; m += NGW) {
        const float pv = (F.lane < 16) ? part[(size_t)m * 16 + F.lane] : 0.f;
        const float rstd = 1.0f / sqrtf(wave_sum(pv) * (1.f / D) + RMS_EPS);
        const GAS f32x4* xr = (const GAS f32x4*)(x + (size_t)m * D) + F.lane; const GAS v2u* zr = (const GAS v2u*)(Z + (size_t)m * D) + F.lane;
        f32x4 hv[4]; float s = 0.f;
#pragma unroll
        for (int j = 0; j < 4; ++j) { const v2u zw = zr[64 * j]; const f32x4 z = (f32x4){bflo(zw.x), bfhi(zw.x), bflo(zw.y), bfhi(zw.y)};
            hv[j] = xr[64 * j] + z * rstd * g[j]; s += (hv[j].x * hv[j].x + hv[j].y * hv[j].y) + (hv[j].z * hv[j].z + hv[j].w * hv[j].w); }
        const float rstd2 = 1.0f / sqrtf(wave_sum(s) * (1.f / D) + RMS_EPS);
        GAS f32x4* orow = (GAS f32x4*)(F.out + (size_t)m * D) + F.lane; GAS v2u* o8 = (GAS v2u*)(XN2 + (size_t)m * D) + F.lane;
#pragma unroll
        for (int j = 0; j < 4; ++j) { orow[64 * j] = hv[j]; v2u o; o.x = pk2(hv[j].x * rstd2, hv[j].y * rstd2); o.y = pk2(hv[j].z * rstd2, hv[j].w * rstd2); o8[64 * j] = o; }
    }
}
__device__ __forceinline__ void norm_ffn_phase(Frame& F) {
    const int gw = F.vcu * NWAVES + F.wave, NGW = F.G * NWAVES;
    const bf16* Z = (const bf16*)(F.ws + WS_F); const float* part = (const float*)(F.ws + WS_PART2); const float* gpost = F.in[5];
    f32x4 g[4];
#pragma unroll
    for (int j = 0; j < 4; ++j) g[j] = ((const f32x4*)gpost)[F.lane + 64 * j];
    for (int m = gw; m < M; m += NGW) {
        const float pv = (F.lane < 16) ? part[(size_t)m * 16 + F.lane] : 0.f;
        const float rstd = 1.0f / sqrtf(wave_sum(pv) * (1.f / D) + RMS_EPS);
        GAS f32x4* orow = (GAS f32x4*)(F.out + (size_t)m * D) + F.lane; const GAS v2u* zr = (const GAS v2u*)(Z + (size_t)m * D) + F.lane;
#pragma unroll
        for (int j = 0; j < 4; ++j) { const v2u zw = zr[64 * j]; const f32x4 z = (f32x4){bflo(zw.x), bfhi(zw.x), bflo(zw.y), bfhi(zw.y)};
            orow[64 * j] = orow[64 * j] + z * rstd * g[j]; }
    }
}
__device__ __forceinline__ void conv_fixup_phase(Frame& F) {
    const float* halo = (const float*)(F.ws + WS_HALO); const float* cw = F.in[22]; const float* cb = F.in[23]; bf16* act = (bf16*)(F.ws + WS_ACT);
    const int gt = (F.vcu * NWAVES + F.wave) * 64 + F.lane, NT = F.G * NWAVES * 64;
    for (int e = gt; e < 256 * DFF; e += NT) {
        const int pm = e / DFF, j = e % DFF; if ((pm & 7) == 0) continue;
        const int tg = (j >> 7) * 256 + (j & 127), tv = tg + 128;
        const float* hc = halo + (size_t)pm * 4 * 5632; const float* hp = halo + (size_t)(pm - 1) * 4 * 5632;
        const float g254 = hp[2 * 5632 + tg], g255 = hp[3 * 5632 + tg], g0 = hc[tg], g1 = hc[5632 + tg];
        const float v254 = hp[2 * 5632 + tv], v255 = hp[3 * 5632 + tv], v0 = hc[tv], v1 = hc[5632 + tv];
        const float cg0 = cw[j], cg1 = cw[5632 + j], cg2 = cw[2 * 5632 + j], cgb = cb[j];
        const float cv0 = cw[DFF + j], cv1 = cw[5632 + DFF + j], cv2 = cw[2 * 5632 + DFF + j], cvb = cb[DFF + j];
        const float og0 = cgb + cg0 * g254 + cg1 * g255 + cg2 * g0, og1 = cgb + cg0 * g255 + cg1 * g0 + cg2 * g1;
        const float ov0 = cvb + cv0 * v254 + cv1 * v255 + cv2 * v0, ov1 = cvb + cv0 * v255 + cv1 * v0 + cv2 * v1;
        act[(size_t)(pm * 256) * DFF + j] = (bf16)f2bf(pg8::gelu_tanh(og0) * ov0);
        act[(size_t)(pm * 256 + 1) * DFF + j] = (bf16)f2bf(pg8::gelu_tanh(og1) * ov1);
    }
}

struct Args { const float* in[25]; float* out; unsigned char* ws; int ph_lo, ph_hi, li, pad; };
__global__ void __launch_bounds__(NWAVES * 64, 2) hyb_fwd(Args args) {
    extern __shared__ __attribute__((aligned(16))) unsigned char lds[];
    Frame F;
    F.lds = (LAS unsigned char*)lds;
    F.MISC = (volatile LAS unsigned*)(F.lds + MISC_OFF);
    F.tid = threadIdx.x; F.lane = F.tid & 63; F.wave = __builtin_amdgcn_readfirstlane(F.tid >> 6);
    F.G = gridDim.x; { const int bx = blockIdx.x; F.vcu = (F.G % 8 == 0) ? (bx % 8) * (F.G / 8) + bx / 8 : bx; }
    unsigned char* ws = args.ws; F.ws = ws; F.out = args.out;
#pragma unroll
    for (int i = 0; i < 25; ++i) F.in[i] = args.in[i];
    F.ctl = (gu32*)(ws + WS_CTL);
    for (int u = F.tid; u < (LDS_BYTES - LDSCTL_OFF) / 4; u += NWAVES * 64) ((LAS unsigned*)(F.lds + LDSCTL_OFF))[u] = 0u;
    __syncthreads();
    XcdBarrier bar; bar.bar = (unsigned*)(F.ctl + CW_BAR) + args.li * XCD_BAR_WORDS; bar.x = 0; bar.st = nullptr;
    if (MK_N_LAUNCHES == 1) bar = xcd_barrier_post((unsigned*)(F.ctl + CW_BAR) + args.li * XCD_BAR_WORDS, F.MISC + 8);
    const int lo = args.ph_lo, hi = args.ph_hi;
#define IN(k) (lo <= (k) && (k) < hi)
#define SEAM(k) do { if (IN(k) && IN((k) + 1)) xcd_barrier(bar); } while (0)
    using namespace pg8;
    bf16* XN = (bf16*)((unsigned char*)F.out + OUT_XN);

    if (IN(0)) { p0_prologue(F); } SEAM(0);
    if (IN(1)) {
        Gemm g{XN, (const bf16_t*)(ws + WS_WIN), M, IN_COLS, D}; StaticOrder S; S.init(M, IN_COLS, F.G, (int)blockIdx.x);
        EpiIn E{(bf16_t*)(ws + WS_PRW), (bf16_t*)(ws + WS_PRET), (bf16_t*)(ws + WS_G)};
        gemm_phase<EpiIn, StaticOrder, true, true>(F.lds + RING_OFF, g, S, E);
    } SEAM(1);
    if (IN(2)) { rwkv_phase(F); __syncthreads(); retention_phase(F); } SEAM(2);
    if (IN(3)) {
        { Gemm g{(const bf16_t*)((unsigned char*)F.out + OUT_YRW), (const bf16_t*)(ws + WS_WRW), M, D, RWW}; StaticOrder S; S.init(M, D, F.G, (int)blockIdx.x);
          EpiGate<false> E{(bf16_t*)(ws + WS_MERGED), (const bf16_t*)(ws + WS_G), 0};
          gemm_phase<EpiGate<false>, StaticOrder, true, true>(F.lds + RING_OFF, g, S, E); }
        VM_WAIT(); __syncthreads();
        { Gemm g{(const bf16_t*)((unsigned char*)F.out + OUT_YRET), (const bf16_t*)(ws + WS_WRET), M, D, D}; StaticOrder S; S.init(M, D, F.G, (int)blockIdx.x);
          EpiGate<true> E{(bf16_t*)(ws + WS_MERGED), (const bf16_t*)(ws + WS_G), 1024};
          gemm_phase<EpiGate<true>, StaticOrder, true, true>(F.lds + RING_OFF, g, S, E); }
    } SEAM(3);
    if (IN(4)) {
        Gemm g{(const bf16_t*)(ws + WS_MERGED), (const bf16_t*)(ws + WS_WOUT), M, D, D}; StaticOrder S; S.init(M, D, F.G, (int)blockIdx.x);
        EpiZ E{(bf16_t*)(ws + WS_Z), (float*)(ws + WS_PART)};
        gemm_phase<EpiZ, StaticOrder, true, true>(F.lds + RING_OFF, g, S, E);
    } SEAM(4);
    if (IN(5)) { norm_mix_phase(F); } SEAM(5);
    if (IN(6)) {
        Gemm g{(const bf16_t*)(ws + WS_XN2), (const bf16_t*)(ws + WS_WUP), M, 2 * DFF, D}; StaticOrder S; S.init(M, 2 * DFF, F.G, (int)blockIdx.x);
        EpiConv E{(bf16_t*)(ws + WS_ACT), F.in[22], F.in[23], (float*)(ws + WS_HALO), (PG8_LAS float*)(F.lds + XCH_OFF)};
        gemm_phase<EpiConv, StaticOrder, true, true>(F.lds + RING_OFF, g, S, E);
    } SEAM(6);
    if (IN(7)) { conv_fixup_phase(F); } SEAM(7);
    if (IN(8)) {
        Gemm g{(const bf16_t*)(ws + WS_ACT), (const bf16_t*)(ws + WS_WDN), M, D, DFF}; StaticOrder S; S.init(M, D, F.G, (int)blockIdx.x);
        EpiZ E{(bf16_t*)(ws + WS_F), (float*)(ws + WS_PART2)};
        gemm_phase<EpiZ, StaticOrder, true, true>(F.lds + RING_OFF, g, S, E);
    } SEAM(8);
    if (IN(9)) { norm_ffn_phase(F); }
#undef IN
#undef SEAM
}

extern "C" void kernel_launch(void* const* d_in, const int* in_sizes, int n_in, void* d_out, int out_size, void* d_ws, size_t ws_size, hipStream_t stream) {
    static int grid = 0;
    if (grid == 0) {
        if (n_in != 25 || in_sizes[0] != M * D || out_size != M * D || ws_size < WS_END) { fprintf(stderr, "kernel_launch: unexpected shapes (n_in %d, in0 %d, out %d, ws %zu); nothing launched\n", n_in, n_in > 0 ? in_sizes[0] : -1, out_size, ws_size); grid = -1; return; }
        int dev = 0, cus = 0, per_cu = 0;
        if (hipGetDevice(&dev) != hipSuccess || hipDeviceGetAttribute(&cus, hipDeviceAttributeMultiprocessorCount, dev) != hipSuccess) { grid = -1; return; }
        if (hipFuncSetAttribute((const void*)hyb_fwd, hipFuncAttributeMaxDynamicSharedMemorySize, LDS_BYTES) != hipSuccess) { fprintf(stderr, "kernel_launch: hipFuncSetAttribute failed\n"); grid = -1; return; }
        if (hipOccupancyMaxActiveBlocksPerMultiprocessor(&per_cu, (const void*)hyb_fwd, NWAVES * 64, LDS_BYTES) != hipSuccess || per_cu < 1) { fprintf(stderr, "kernel_launch: occupancy query reports %d workgroups per CU\n", per_cu); (void)hipGetLastError(); grid = -1; return; }
        (void)hipGetLastError();
        grid = cus;
    }
    if (grid < 0) return;
    if (hipMemsetAsync((char*)d_ws + WS_CTL, 0, CTL_ZERO_BYTES, stream) != hipSuccess) return;
    Args a{};
    for (int i = 0; i < 25; ++i) a.in[i] = (const float*)d_in[i];
    a.out = (float*)d_out; a.ws = (unsigned char*)d_ws;
#if MK_N_LAUNCHES == 1
    a.ph_lo = 0; a.ph_hi = N_PHASES; a.li = 0;
    hipLaunchKernelGGL(hyb_fwd, dim3(grid), dim3(NWAVES * 64), LDS_BYTES, stream, a);
#else
    for (int li = 0; li < N_PHASES; ++li) { a.ph_lo = li; a.ph_hi = li + 1; a.li = 0; hipLaunchKernelGGL(hyb_fwd, dim3(grid), dim3(NWAVES * 64), LDS_BYTES, stream, a); }
#endif
}
```

```cpp
#include <hip/hip_runtime.h>
#include <cstdio>
#include <cstdint>

#ifndef MK_N_LAUNCHES
#define MK_N_LAUNCHES 1
#endif

namespace pg8 {
#define PG8_LAS __attribute__((address_space(3)))
typedef unsigned short bf16_t;
typedef short bf16x8 __attribute__((ext_vector_type(8)));
typedef float f32x4 __attribute__((ext_vector_type(4)));
typedef float f32x2 __attribute__((ext_vector_type(2)));
typedef unsigned u32x4 __attribute__((ext_vector_type(4)));
typedef unsigned u32x2 __attribute__((ext_vector_type(2)));
constexpr int BM = 256, BK = 64, HALF = 128, HTB = HALF * BK * 2, STAGE_BYTES = 8 * HTB, NXCD = 8, WGM = 8;

__host__ __device__ __forceinline__ int lds_byte(int r, int c) { const int st = (r >> 4) * 2 + (c >> 5), rr = r & 15, cc = c & 31, ob = rr * 64 + cc * 2; return st * 1024 + (ob ^ (((ob >> 9) & 1) << 5)); }
__host__ __device__ __forceinline__ void stage_rc(int b, int& R, int& C) { const int st = b / 1024, sb = b % 1024, swz = sb ^ (((sb >> 9) & 1) << 5); R = (st >> 1) * 16 + swz / 64; C = (st & 1) * 32 + (swz % 64) / 2; }
__host__ __device__ __forceinline__ int perm32(int rho) { const int n = rho >> 4, i = rho & 15; return 8 * (i >> 2) + 4 * n + (i & 3); }

struct Unit { int pm, pn; };
struct Gemm { const bf16_t* A; const bf16_t* Bt; int M, N, K; };

struct StaticOrder {
    int nM, nN, nwg, G, c;
    __host__ __device__ void init(int M, int N, int G_, int c_) { nM = M / BM; nN = N / BM; nwg = nM * nN; G = G_; c = c_; }
    __host__ __device__ bool next(int i, Unit& u) const {
        const long L = (long)i * G + c; if (L >= nwg) return false;
        int wgid = (int)L; { const int q = nwg / NXCD, r = nwg % NXCD, xcd = wgid % NXCD, off = wgid / NXCD; wgid = (xcd < r ? xcd * (q + 1) : r * (q + 1) + (xcd - r) * q) + off; }
        const int nig = WGM * nN, gid = wgid / nig, fm = gid * WGM, gsz = (nM - fm) < WGM ? (nM - fm) : WGM;
        u.pm = fm + ((wgid % nig) % gsz); u.pn = (wgid % nig) / gsz; return true;
    }
    __device__ __forceinline__ void a_ready(const Unit&) const {}
    __device__ __forceinline__ void done(const Unit&) const {}
};

__device__ __forceinline__ unsigned cvt_pk_bf16(float lo, float hi) { unsigned r; asm volatile("v_cvt_pk_bf16_f32 %0, %1, %2" : "=v"(r) : "v"(lo), "v"(hi)); return r; }
__device__ __forceinline__ float bf_lo(unsigned w) { return __uint_as_float(w << 16); }
__device__ __forceinline__ float bf_hi(unsigned w) { return __uint_as_float(w & 0xffff0000u); }
__device__ __forceinline__ float fsigmoid(float x) { return __builtin_amdgcn_rcpf(1.0f + __builtin_amdgcn_exp2f(-1.44269504089f * x)); }


struct EpiIn {
    static constexpr bool PERM = true, AFTER_DRAIN = false;
    bf16_t* prw; bf16_t* pret; bf16_t* gg;
    __device__ __forceinline__ void operator()(const f32x4 (&acc)[2][2][4][2], const Unit& u, int wr, int wc, int fr, int fq) const {
        const int pn = u.pn; bf16_t* base; int ldc, colt, actk;
        if (pn < 7) { base = prw; ldc = 1792; colt = pn * 256; actk = 0; }
        else if (pn < 19) { base = pret; ldc = 3072; colt = (pn - 7) * 256; actk = (pn - 7 >= 8) ? 2 : 0; }
        else { base = gg; ldc = 2048; colt = (pn - 19) * 256; actk = 1; }
        const int row0 = u.pm * BM + wr * 64 + fr; const int col0 = colt + wc * 32 + 8 * fq;
#pragma unroll
        for (int ai = 0; ai < 2; ++ai)
#pragma unroll
            for (int m = 0; m < 4; ++m) { bf16_t* rowp = base + (size_t)(row0 + ai * HALF + m * 16) * ldc + col0;
#pragma unroll
                for (int bj = 0; bj < 2; ++bj) { f32x4 v0 = acc[ai][bj][m][0], v1 = acc[ai][bj][m][1];
                    if (actk) {
#pragma unroll
                        for (int i = 0; i < 4; ++i) { const float s0 = fsigmoid(v0[i]), s1 = fsigmoid(v1[i]); v0[i] = (actk == 2) ? v0[i] * s0 : s0; v1[i] = (actk == 2) ? v1[i] * s1 : s1; }
                    }
                    u32x4 w; w.x = cvt_pk_bf16(v0[0], v0[1]); w.y = cvt_pk_bf16(v0[2], v0[3]); w.z = cvt_pk_bf16(v1[0], v1[1]); w.w = cvt_pk_bf16(v1[2], v1[3]);
                    *(u32x4*)(rowp + bj * HALF) = w; } }
    }
};

template <bool ADD> struct EpiGate {
    static constexpr bool PERM = true, AFTER_DRAIN = false;
    bf16_t* O; const bf16_t* G; int gcol0;
    __device__ __forceinline__ void operator()(const f32x4 (&acc)[2][2][4][2], const Unit& u, int wr, int wc, int fr, int fq) const {
        const int row0 = u.pm * BM + wr * 64 + fr; const int col0 = u.pn * BM + wc * 32 + 8 * fq;
#pragma unroll
        for (int ai = 0; ai < 2; ++ai)
#pragma unroll
            for (int m = 0; m < 4; ++m) { const size_t row = (size_t)(row0 + ai * HALF + m * 16);
#pragma unroll
                for (int bj = 0; bj < 2; ++bj) { const f32x4 v0 = acc[ai][bj][m][0], v1 = acc[ai][bj][m][1];
                    const u32x4 gw = *(const u32x4*)(G + row * 2048 + gcol0 + col0 + bj * HALF);
                    float o[8];
                    o[0] = v0[0] * bf_lo(gw.x); o[1] = v0[1] * bf_hi(gw.x); o[2] = v0[2] * bf_lo(gw.y); o[3] = v0[3] * bf_hi(gw.y);
                    o[4] = v1[0] * bf_lo(gw.z); o[5] = v1[1] * bf_hi(gw.z); o[6] = v1[2] * bf_lo(gw.w); o[7] = v1[3] * bf_hi(gw.w);
                    bf16_t* op = O + row * 1024 + col0 + bj * HALF;
                    if (ADD) { const u32x4 pw = *(const u32x4*)op;
                        o[0] += bf_lo(pw.x); o[1] += bf_hi(pw.x); o[2] += bf_lo(pw.y); o[3] += bf_hi(pw.y); o[4] += bf_lo(pw.z); o[5] += bf_hi(pw.z); o[6] += bf_lo(pw.w); o[7] += bf_hi(pw.w); }
                    u32x4 w; w.x = cvt_pk_bf16(o[0], o[1]); w.y = cvt_pk_bf16(o[2], o[3]); w.z = cvt_pk_bf16(o[4], o[5]); w.w = cvt_pk_bf16(o[6], o[7]);
                    *(u32x4*)op = w; } }
    }
};

struct EpiZ {
    static constexpr bool PERM = true, AFTER_DRAIN = false;
    bf16_t* O; float* part;
    __device__ __forceinline__ void operator()(const f32x4 (&acc)[2][2][4][2], const Unit& u, int wr, int wc, int fr, int fq) const {
        const int row0 = u.pm * BM + wr * 64 + fr; const int col0 = u.pn * BM + wc * 32 + 8 * fq;
#pragma unroll
        for (int ai = 0; ai < 2; ++ai)
#pragma unroll
            for (int m = 0; m < 4; ++m) { const size_t row = (size_t)(row0 + ai * HALF + m * 16); float ss = 0.f;
#pragma unroll
                for (int bj = 0; bj < 2; ++bj) { const f32x4 v0 = acc[ai][bj][m][0], v1 = acc[ai][bj][m][1];
                    ss += (v0[0] * v0[0] + v0[1] * v0[1]) + (v0[2] * v0[2] + v0[3] * v0[3]) + (v1[0] * v1[0] + v1[1] * v1[1]) + (v1[2] * v1[2] + v1[3] * v1[3]);
                    u32x4 w; w.x = cvt_pk_bf16(v0[0], v0[1]); w.y = cvt_pk_bf16(v0[2], v0[3]); w.z = cvt_pk_bf16(v1[0], v1[1]); w.w = cvt_pk_bf16(v1[2], v1[3]);
                    *(u32x4*)(O + row * 1024 + col0 + bj * HALF) = w; }
                ss += __shfl_xor(ss, 16); ss += __shfl_xor(ss, 32);
                if (fq == 0) part[row * 16 + u.pn * 4 + wc] = ss; }
    }
};

template <int CTRL> __device__ __forceinline__ float dpp0(float x) {
    return __builtin_bit_cast(float, __builtin_amdgcn_update_dpp(0, __builtin_bit_cast(int, x), CTRL, 0xf, 0xf, true));
}
__device__ __forceinline__ float gelu_tanh(float x) {
    const float in = x * (1.0f + 0.044715f * x * x);
    return x * __builtin_amdgcn_rcpf(1.0f + __builtin_amdgcn_exp2f(-2.302208198f * in));
}

struct EpiConv {
    static constexpr bool PERM = true, AFTER_DRAIN = false;
    bf16_t* act; const float* cw; const float* cb; float* halo; PG8_LAS float* xch;
    __device__ __forceinline__ void operator()(const f32x4 (&acc)[2][2][4][2], const Unit& u, int wr, int wc, int fr, int fq) const {
        PG8_LAS f32x4* X = (PG8_LAS f32x4*)xch;
        if (fr >= 14) {
#pragma unroll
            for (int ai = 0; ai < 2; ++ai)
#pragma unroll
                for (int bj = 0; bj < 2; ++bj)
#pragma unroll
                    for (int n = 0; n < 2; ++n) X[(((((ai * 2 + wr) * 4 + wc) * 2 + (fr - 14)) * 2 + bj) * 2 + n) * 4 + fq] = acc[ai][bj][3][n];
        }
        {
            const int tcol = u.pn * 256 + wc * 32 + 8 * fq;
            if (wr == 0 && fr < 2) {
#pragma unroll
                for (int bj = 0; bj < 2; ++bj)
#pragma unroll
                    for (int n = 0; n < 2; ++n) *(f32x4*)(halo + ((size_t)(u.pm * 4 + fr)) * 5632 + tcol + bj * HALF + 4 * n) = acc[0][bj][0][n];
            }
            if (wr == 1 && fr >= 14) {
#pragma unroll
                for (int bj = 0; bj < 2; ++bj)
#pragma unroll
                    for (int n = 0; n < 2; ++n) *(f32x4*)(halo + ((size_t)(u.pm * 4 + 2 + (fr - 14))) * 5632 + tcol + bj * HALF + 4 * n) = acc[1][bj][3][n];
            }
        }
        asm volatile("s_waitcnt lgkmcnt(0)" ::: "memory"); __builtin_amdgcn_s_barrier(); asm volatile("" ::: "memory");
        const int j0 = u.pn * 128 + wc * 32 + 8 * fq;
        const float m0 = (fr == 0) ? 1.f : 0.f, m01 = (fr < 2) ? 1.f : 0.f;
        const bool first_tile = (u.pm & 7) == 0; (void)first_tile;
#pragma unroll
        for (int ai = 0; ai < 2; ++ai) {
            f32x4 xb[2][2];
#pragma unroll
            for (int bj = 0; bj < 2; ++bj)
#pragma unroll
                for (int n = 0; n < 2; ++n) xb[bj][n] = (f32x4){0.f, 0.f, 0.f, 0.f};
            if (!(ai == 0 && wr == 0) && fr >= 14) {
                const int sai = (wr == 1) ? ai : ai - 1, swr = (wr == 1) ? 0 : 1;
#pragma unroll
                for (int bj = 0; bj < 2; ++bj)
#pragma unroll
                    for (int n = 0; n < 2; ++n) xb[bj][n] = X[(((((sai * 2 + swr) * 4 + wc) * 2 + (fr - 14)) * 2 + bj) * 2 + n) * 4 + fq];
            }
            unsigned pk[4][4];
#pragma unroll
            for (int n = 0; n < 2; ++n) {
                const int jc = j0 + 4 * n;
                const f32x4 g0 = *(const f32x4*)(cw + jc), g1 = *(const f32x4*)(cw + 5632 + jc), g2 = *(const f32x4*)(cw + 2 * 5632 + jc), gb = *(const f32x4*)(cb + jc);
                const f32x4 v0 = *(const f32x4*)(cw + 2816 + jc), v1 = *(const f32x4*)(cw + 5632 + 2816 + jc), v2 = *(const f32x4*)(cw + 2 * 5632 + 2816 + jc), vb = *(const f32x4*)(cb + 2816 + jc);
#pragma unroll
                for (int i = 0; i < 4; ++i) {
                    const float g1m = g1[i] * m0, g0m = g0[i] * m01, v1m = v1[i] * m0, v0m = v0[i] * m01;
                    float og[4], ov[4];
#pragma unroll
                    for (int m = 0; m < 4; ++m) {
                        const float xg = acc[ai][0][m][n][i], xv = acc[ai][1][m][n][i];
                        const float pg = (m == 0) ? xb[0][n][i] : acc[ai][0][m - 1][n][i], pv = (m == 0) ? xb[1][n][i] : acc[ai][1][m - 1][n][i];
                        float a = gb[i] + g2[i] * xg; a += g1[i] * dpp0<0x111>(xg); a += g0[i] * dpp0<0x112>(xg); a += g1m * dpp0<0x121>(pg); a += g0m * dpp0<0x122>(pg);
                        float b = vb[i] + v2[i] * xv; b += v1[i] * dpp0<0x111>(xv); b += v0[i] * dpp0<0x112>(xv); b += v1m * dpp0<0x121>(pv); b += v0m * dpp0<0x122>(pv);
                        og[m] = a; ov[m] = b;
                    }
#pragma unroll
                    for (int m = 0; m < 4; ++m) og[m] = gelu_tanh(og[m]) * ov[m];
                    if (i & 1) {
#pragma unroll
                        for (int m = 0; m < 4; ++m) pk[m][n * 2 + (i >> 1)] = cvt_pk_bf16(__uint_as_float(pk[m][n * 2 + (i >> 1)]), og[m]);
                    } else {
#pragma unroll
                        for (int m = 0; m < 4; ++m) pk[m][n * 2 + (i >> 1)] = __float_as_uint(og[m]);
                    }
                }
            }
#pragma unroll
            for (int m = 0; m < 4; ++m) {
                u32x4 w; w.x = pk[m][0]; w.y = pk[m][1]; w.z = pk[m][2]; w.w = pk[m][3];
                *(u32x4*)(act + (size_t)(u.pm * BM + ai * HALF + wr * 64 + m * 16 + fr) * 2816 + j0) = w;
            }
        }
    }
};

template <class Epi, class Sched, bool ALIGN_EPI = false, bool SP2 = false>
__device__ __forceinline__ void gemm_phase(PG8_LAS unsigned char* lds, const Gemm g, const Sched& S, const Epi& E) {
    const int tid = threadIdx.x, wid = __builtin_amdgcn_readfirstlane(tid >> 6), lane = tid & 63, wr = wid >> 2, wc = wid & 3, fr = lane & 15, fq = lane >> 4;
    const int K = g.K, nt = K / BK;
    unsigned voffA[2], voffB[2];
#pragma unroll
    for (int i = 0; i < 2; ++i) { int R, C; stage_rc(tid * 16 + i * 8192, R, C); const int Rb = Epi::PERM ? ((R & ~31) + perm32(R & 31)) : R;
        voffA[i] = (unsigned)(R * K + C) * 2u; voffB[i] = (unsigned)(Rb * K + C) * 2u; }
    const size_t kstep = (size_t)(BK * 2);
    const size_t hstep = (size_t)HALF * K * 2;
    const size_t tstep = 2 * hstep;
    const unsigned ldsw = (unsigned)wid * 1024u;
    const int aoff = lds_byte(wr * 64 + fr, fq * 8), boff = lds_byte(wc * 32 + fr, fq * 8);
#define PG8_SA(b, h) (((b) * 2 + (h)) * HTB)
#define PG8_SB(b, h) ((4 + (b) * 2 + (h)) * HTB)
#define PG8_STAGE(bufoff, gbase, voff) do { _Pragma("unroll") for (int _i = 0; _i < 2; ++_i) \
        __builtin_amdgcn_global_load_lds((const unsigned*)((const char*)(gbase) + (voff)[_i]), (PG8_LAS unsigned*)(lds + (bufoff) + ldsw + _i * 8192), 16, 0, 0); } while (0)
#define PG8_LDA(dst, b, h) do { _Pragma("unroll") for (int m = 0; m < 4; ++m) _Pragma("unroll") for (int k = 0; k < 2; ++k) dst[m][k] = *(const PG8_LAS bf16x8*)(lds + PG8_SA(b, h) + aoff + m * 2048 + k * 1024); } while (0)
#define PG8_LDB(dst, b, h) do { _Pragma("unroll") for (int n = 0; n < 2; ++n) _Pragma("unroll") for (int k = 0; k < 2; ++k) dst[n][k] = *(const PG8_LAS bf16x8*)(lds + PG8_SB(b, h) + boff + n * 2048 + k * 1024); } while (0)
#define PG8_MMA(ai, bj, At, Bt) do { __builtin_amdgcn_s_setprio(1); _Pragma("unroll") for (int m = 0; m < 4; ++m) _Pragma("unroll") for (int n = 0; n < 2; ++n) _Pragma("unroll") for (int k = 0; k < 2; ++k) \
        acc[ai][bj][m][n] = __builtin_amdgcn_mfma_f32_16x16x32_bf16(Bt[n][k], At[m][k], acc[ai][bj][m][n], 0, 0, 0); __builtin_amdgcn_s_setprio(0); } while (0)
#define PG8_WAIT_V(n) asm volatile("s_waitcnt vmcnt(" #n ")" ::: "memory")
#define PG8_WAIT_L(n) asm volatile("s_waitcnt lgkmcnt(" #n ")" ::: "memory")
#define PG8_BAR __builtin_amdgcn_s_barrier()
#define PG8_SCHED __builtin_amdgcn_sched_barrier(0)
    Unit cur, nxt; int ui = 0;
    if (!S.next(0, cur)) return;
    f32x4 acc[2][2][4][2];
#pragma unroll
    for (int a = 0; a < 2; ++a)
#pragma unroll
        for (int b = 0; b < 2; ++b)
#pragma unroll
            for (int m = 0; m < 4; ++m)
#pragma unroll
                for (int n = 0; n < 2; ++n) acc[a][b][m][n] = (f32x4){0.f, 0.f, 0.f, 0.f};
    bf16x8 At[4][2], B0[2][2], B1[2][2];
    const char* cA = (const char*)g.A + (size_t)cur.pm * tstep; const char* cB = (const char*)g.Bt + (size_t)cur.pn * tstep;
    S.a_ready(cur);
    if constexpr (SP2) {
        PG8_STAGE(PG8_SB(0, 0), cB, voffB); PG8_STAGE(PG8_SB(0, 1), cB + hstep, voffB); PG8_STAGE(PG8_SA(0, 0), cA, voffA); PG8_STAGE(PG8_SA(0, 1), cA + hstep, voffA);
        if (wr == 1) PG8_BAR;
        PG8_WAIT_V(2); PG8_BAR;
        PG8_STAGE(PG8_SB(1, 0), cB + kstep, voffB); PG8_STAGE(PG8_SA(1, 0), cA + kstep, voffA); PG8_STAGE(PG8_SB(1, 1), cB + hstep + kstep, voffB);
        PG8_WAIT_V(6); PG8_BAR;
    } else {
        PG8_STAGE(PG8_SB(0, 0), cB, voffB); PG8_STAGE(PG8_SA(0, 0), cA, voffA); PG8_STAGE(PG8_SB(0, 1), cB + hstep, voffB); PG8_STAGE(PG8_SA(0, 1), cA + hstep, voffA);
        if (wr == 1) PG8_BAR;
        PG8_WAIT_V(4); PG8_BAR;
        PG8_STAGE(PG8_SB(1, 0), cB + kstep, voffB); PG8_STAGE(PG8_SA(1, 0), cA + kstep, voffA); PG8_STAGE(PG8_SB(1, 1), cB + hstep + kstep, voffB);
        PG8_WAIT_V(6); PG8_BAR;
    }
    for (;;) {
        const bool has_next = S.next(ui + 1, nxt);
        const char* nA = has_next ? (const char*)g.A + (size_t)nxt.pm * tstep : cA; const char* nB = has_next ? (const char*)g.Bt + (size_t)nxt.pn * tstep : cB;
        for (int t = 0; t < nt; t += 2) {
            const bool last = (t == nt - 2);
            const char* a1 = cA + (size_t)(t + 1) * kstep;
            const char* a2 = last ? nA : cA + (size_t)(t + 2) * kstep; const char* b2 = last ? nB : cB + (size_t)(t + 2) * kstep;
            const char* a3 = a2 + kstep; const char* b3 = b2 + kstep;
            if (last && has_next) S.a_ready(nxt);
            if constexpr (SP2) {
            PG8_LDB(B0, 0, 0); PG8_LDB(B1, 0, 1); PG8_SCHED; PG8_LDA(At, 0, 0); PG8_STAGE(PG8_SA(1, 1), a1 + hstep, voffA);
            PG8_WAIT_V(8); PG8_WAIT_L(0); PG8_BAR; PG8_MMA(0, 0, At, B0); PG8_MMA(0, 1, At, B1); PG8_BAR; PG8_SCHED;
            PG8_LDA(At, 0, 1); PG8_STAGE(PG8_SB(0, 0), b2, voffB); PG8_STAGE(PG8_SB(0, 1), b2 + hstep, voffB); PG8_STAGE(PG8_SA(0, 0), a2, voffA);
            PG8_WAIT_V(8); PG8_WAIT_L(0); PG8_BAR; PG8_MMA(1, 0, At, B0); PG8_MMA(1, 1, At, B1); PG8_BAR; PG8_SCHED;
            PG8_LDB(B0, 1, 0); PG8_LDB(B1, 1, 1); PG8_SCHED; PG8_LDA(At, 1, 0); PG8_STAGE(PG8_SA(0, 1), a2 + hstep, voffA);
            PG8_WAIT_V(8); PG8_WAIT_L(0); PG8_BAR; PG8_MMA(0, 0, At, B0); PG8_MMA(0, 1, At, B1); PG8_BAR; PG8_SCHED;
            PG8_LDA(At, 1, 1); PG8_STAGE(PG8_SB(1, 0), b3, voffB); PG8_STAGE(PG8_SB(1, 1), b3 + hstep, voffB); PG8_STAGE(PG8_SA(1, 0), a3, voffA);
            PG8_WAIT_V(8); PG8_WAIT_L(0); PG8_BAR; PG8_MMA(1, 0, At, B0); PG8_MMA(1, 1, At, B1); PG8_BAR; PG8_SCHED;
            } else {
            PG8_LDB(B0, 0, 0); PG8_SCHED; PG8_LDA(At, 0, 0); PG8_STAGE(PG8_SA(1, 1), a1 + hstep, voffA);
            PG8_WAIT_L(8); PG8_BAR; PG8_WAIT_L(0); PG8_MMA(0, 0, At, B0); PG8_BAR; PG8_SCHED;
            PG8_LDB(B1, 0, 1); PG8_STAGE(PG8_SB(0, 0), b2, voffB);
            PG8_BAR; PG8_WAIT_L(0); PG8_MMA(0, 1, At, B1); PG8_BAR;
            PG8_LDA(At, 0, 1); PG8_STAGE(PG8_SA(0, 0), a2, voffA);
            PG8_BAR; PG8_WAIT_L(0); PG8_MMA(1, 0, At, B0); PG8_BAR; PG8_SCHED;
            PG8_STAGE(PG8_SB(0, 1), b2 + hstep, voffB);
            PG8_WAIT_V(6); PG8_BAR; PG8_MMA(1, 1, At, B1); PG8_BAR;
            PG8_LDB(B0, 1, 0); PG8_SCHED; PG8_LDA(At, 1, 0); PG8_STAGE(PG8_SA(0, 1), a2 + hstep, voffA);
            PG8_WAIT_L(8); PG8_BAR; PG8_WAIT_L(0); PG8_MMA(0, 0, At, B0); PG8_BAR; PG8_SCHED;
            PG8_LDB(B1, 1, 1); PG8_STAGE(PG8_SB(1, 0), b3, voffB);
            PG8_BAR; PG8_WAIT_L(0); PG8_MMA(0, 1, At, B1); PG8_BAR;
            PG8_LDA(At, 1, 1); PG8_STAGE(PG8_SA(1, 0), a3, voffA);
            PG8_BAR; PG8_WAIT_L(0); PG8_MMA(1, 0, At, B0); PG8_BAR; PG8_SCHED;
            PG8_STAGE(PG8_SB(1, 1), b3 + hstep, voffB);
            PG8_WAIT_V(6); PG8_BAR; PG8_MMA(1, 1, At, B1); PG8_BAR;
            }
        }
        if constexpr (ALIGN_EPI) { if (wr == 0) PG8_BAR; }
        if constexpr (!Epi::AFTER_DRAIN) { E(acc, cur, wr, wc, fr, fq); S.done(cur); }
        if (!has_next) break;
#pragma unroll
        for (int a = 0; a < 2; ++a)
#pragma unroll
            for (int b = 0; b < 2; ++b)
#pragma unroll
                for (int m = 0; m < 4; ++m)
#pragma unroll
                    for (int n = 0; n < 2; ++n) acc[a][b][m][n] = (f32x4){0.f, 0.f, 0.f, 0.f};
        cur = nxt; cA = nA; cB = nB; ++ui;
        if constexpr (ALIGN_EPI) { if (wr == 1) PG8_BAR; }
    }
    PG8_WAIT_V(0);
    if constexpr (!ALIGN_EPI) { if (wr == 0) PG8_BAR; }
    PG8_BAR;
#undef PG8_SA
#undef PG8_SB
#undef PG8_STAGE
#undef PG8_LDA
#undef PG8_LDB
#undef PG8_MMA
#undef PG8_WAIT_V
#undef PG8_WAIT_L
#undef PG8_BAR
#undef PG8_SCHED
}
}

constexpr int NWAVES = 8;
constexpr int BATCH = 32, T = 2048, D = 1024, M = BATCH * T;
constexpr int RWH = 8, RWN = 64, RWW = 512, RW_COLS = 1792;
constexpr int RTH = 8, RDK = 64, RDV = 128, RET_COLS = 3072, RCH = 128;
constexpr int IN_COLS = 6912, DFF = 2816;
constexpr float RMS_EPS = 1e-6f, RW_GN_EPS = 64e-5f, RET_GN_EPS = 1e-5f;
constexpr int N_PHASES = 10;

constexpr size_t MiB = 1u << 20;
constexpr size_t WS_CTL = 0, CTL_ZERO_BYTES = 1 * MiB;
constexpr size_t WS_WIN = 2 * MiB, WS_WRW = 16 * MiB, WS_WRET = 17 * MiB, WS_WOUT = 19 * MiB, WS_WUP = 21 * MiB, WS_WDN = 32 * MiB;
constexpr size_t WS_ROPE = 38 * MiB, WS_PART = 54 * MiB, WS_PART2 = 58 * MiB, WS_HALO = 62 * MiB, WS_RWW = 84 * MiB;
constexpr size_t WS_PRW = 88 * MiB, WS_PRET = 312 * MiB, WS_G = 696 * MiB, WS_END = 952 * MiB;
constexpr size_t WS_MERGED = WS_PRW, WS_Z = WS_PRET, WS_XN2 = WS_G, WS_ACT = WS_PRET, WS_F = WS_PRW;
static_assert(WS_WIN + (size_t)IN_COLS * D * 2 <= WS_WRW && WS_WUP + (size_t)2 * DFF * D * 2 <= WS_WDN && WS_WDN + (size_t)D * DFF * 2 <= WS_ROPE, "ws map: weights");
static_assert(WS_ROPE + (size_t)M * 32 * 8 <= WS_PART && WS_HALO + (size_t)256 * 4 * 5632 * 4 <= WS_RWW && WS_RWW + 4 * MiB <= WS_PRW, "ws map: tables");
static_assert(WS_PRW + (size_t)M * RW_COLS * 2 <= WS_PRET && WS_PRET + (size_t)M * RET_COLS * 2 <= WS_G && WS_G + (size_t)M * 2048 * 2 <= WS_END, "ws map: activations");
static_assert(WS_ACT + (size_t)M * DFF * 2 <= WS_G, "ws map: act");
constexpr int CW_BAR = 4096;
constexpr size_t OUT_XN = 0, OUT_YRET = 0, OUT_YRW = 128 * MiB;

constexpr int RING_OFF = 0, RING_BYTES = 131072;
constexpr int XCH_OFF = RING_BYTES, XCH_BYTES = 16384;
constexpr int LDSCTL_OFF = XCH_OFF + XCH_BYTES, MISC_OFF = LDSCTL_OFF + 320;
constexpr int LDS_BYTES = 160 * 1024;
static_assert(MISC_OFF + 128 <= LDS_BYTES, "LDS map");

#define GAS __attribute__((address_space(1)))
#define LAS __attribute__((address_space(3)))
typedef unsigned short bf16;
typedef unsigned v4u __attribute__((ext_vector_type(4)));
typedef unsigned v2u __attribute__((ext_vector_type(2)));
typedef float f32x4 __attribute__((ext_vector_type(4)));
typedef float f32x2 __attribute__((ext_vector_type(2)));
typedef short bf16x8 __attribute__((ext_vector_type(8)));
typedef GAS unsigned gu32;
#define RLX_AGENT __ATOMIC_RELAXED, __HIP_MEMORY_SCOPE_AGENT
#define LDS_WAIT() asm volatile("s_waitcnt lgkmcnt(0)" ::: "memory")
#define VM_WAIT() asm volatile("s_waitcnt vmcnt(0)" ::: "memory")
__device__ __forceinline__ unsigned f2bf(float f) { unsigned u = __builtin_bit_cast(unsigned, f); return (u + 0x7fffu + ((u >> 16) & 1u)) >> 16; }
__device__ __forceinline__ unsigned pk2(float lo, float hi) { return f2bf(lo) | (f2bf(hi) << 16); }
__device__ __forceinline__ float bflo(unsigned w) { return __uint_as_float(w << 16); }
__device__ __forceinline__ float bfhi(unsigned w) { return __uint_as_float(w & 0xffff0000u); }
__device__ __forceinline__ float bf1(bf16 v) { return __uint_as_float((unsigned)v << 16); }

#define XB_TMO      128
#define XB_XCNT(j)  (256  + 64 * (j))
#define XB_XSUB(j)  (1280 + 64 * (j))
#define XB_XGEN(j)  (2304 + 64 * (j))
#define XB_TOP      3328
#define XB_TOPGEN   3392
#define XCD_BAR_WORDS 3456
#define XB_SPIN_CAP (1u << 20)

__device__ __forceinline__ unsigned xb_ld(unsigned* p)              { return __hip_atomic_load(p, __ATOMIC_RELAXED, __HIP_MEMORY_SCOPE_AGENT); }
__device__ __forceinline__ unsigned xb_add(unsigned* p, unsigned v) { return __hip_atomic_fetch_add(p, v, __ATOMIC_RELAXED, __HIP_MEMORY_SCOPE_AGENT); }
__device__ __forceinline__ unsigned xb_xcc_id() { return (unsigned)__builtin_amdgcn_s_getreg((3 << 11) | 20) & 0xFu; }
#define XB_SPIN(cond, bar) do { unsigned _sp = 0; while (cond) { __builtin_amdgcn_s_sleep(1); \
    if ((++_sp & 255u) == 0u) { if (xb_ld(&(bar)[XB_TMO])) break; if (_sp > XB_SPIN_CAP) { atomicAdd(&(bar)[XB_TMO], 1u); break; } } } } while (0)

struct XcdBarrier { unsigned* bar; unsigned x; volatile LAS unsigned* st; };

__device__ __forceinline__ XcdBarrier xcd_barrier_post(unsigned* bar, volatile LAS unsigned* st) {
    XcdBarrier b; b.bar = bar; b.x = xb_xcc_id(); b.st = st;
    if (threadIdx.x == 0) (void)xb_add(&bar[XB_XCNT(b.x)], 1u);
    return b;
}
__device__ __forceinline__ void xcd_barrier_complete(unsigned* bar, unsigned x, unsigned& nloc, unsigned& nx) {
    const unsigned G = gridDim.x * gridDim.y * gridDim.z;
    unsigned sum, cnt, mine, sp = 0u;
    for (;;) {
        sum = 0u; cnt = 0u; mine = 0u;
#pragma unroll
        for (unsigned j = 0; j < 16; ++j) { const unsigned c = xb_ld(&bar[XB_XCNT(j)]); sum += c; cnt += (c > 0u) ? 1u : 0u; mine = (j == x) ? c : mine; }
        if (sum == G) break;
        __builtin_amdgcn_s_sleep(1);
        if ((++sp & 255u) == 0u) { if (xb_ld(&bar[XB_TMO])) break; if (sp > XB_SPIN_CAP) { atomicAdd(&bar[XB_TMO], 1u); break; } }
    }
    nloc = mine > 0u ? mine : 1u; nx = cnt > 0u ? cnt : 1u;
}
__device__ __forceinline__ void xcd_barrier(const XcdBarrier& b) {
    asm volatile("s_waitcnt vmcnt(0)" ::: "memory");
    __syncthreads();
    if (threadIdx.x == 0) {
        unsigned* bar = b.bar;
        __builtin_amdgcn_s_waitcnt(0);
        unsigned nloc = b.st[0], nx = b.st[1];
        if (nloc == 0u) { xcd_barrier_complete(bar, b.x, nloc, nx); b.st[0] = nloc; b.st[1] = nx; }
        const unsigned old = xb_add(&bar[XB_XSUB(b.x)], 1u);
        const unsigned gen = old / nloc;
        if (old + 1u == (gen + 1u) * nloc) {
            __builtin_amdgcn_fence(__ATOMIC_RELEASE, "agent");
            asm volatile("s_waitcnt vmcnt(0)" ::: "memory");
            const unsigned og = xb_add(&bar[XB_TOP], 1u);
            const unsigned tg = og / nx;
            if (og + 1u == (tg + 1u) * nx) xb_add(&bar[XB_TOPGEN], 1u);
            else XB_SPIN(xb_ld(&bar[XB_TOPGEN]) == tg, bar);
            __builtin_amdgcn_fence(__ATOMIC_ACQUIRE, "agent");
            xb_add(&bar[XB_XGEN(b.x)], 1u);
            asm volatile("s_waitcnt vmcnt(0)" ::: "memory");
        } else {
            XB_SPIN(xb_ld(&bar[XB_XGEN(b.x)]) == gen, bar);
            __builtin_amdgcn_fence(__ATOMIC_ACQUIRE, "agent");
            asm volatile("s_waitcnt vmcnt(0)" ::: "memory");
        }
    }
    __syncthreads();
}

struct Frame {
    LAS unsigned char* lds;
    volatile LAS unsigned* MISC;
    gu32* ctl;
    int tid, lane, wave;
    int vcu, G;
    const float* in[25]; float* out; unsigned char* ws;
};

__device__ __forceinline__ float wave_sum(float v) {
#pragma unroll
    for (int o = 1; o < 64; o <<= 1) v += __shfl_xor(v, o);
    return v;
}
template <int CTRL> __device__ __forceinline__ float dppx(float x) {
    return __builtin_bit_cast(float, __builtin_amdgcn_mov_dpp(__builtin_bit_cast(int, x), CTRL, 0xf, 0xf, true));
}
__device__ __forceinline__ float row16_sum(float v) {
    v += dppx<0xB1>(v); v += dppx<0x4E>(v); v += dppx<0x141>(v); v += dppx<0x128>(v); return v;
}

__device__ __forceinline__ void p0_transpose_item(const float* W, int N, bf16* WT, int ldw, int k0, int n0, int drow0, const float* kscale, LAS float* scr, int lane) {
#pragma unroll 8
    for (int i = 0; i < 32; ++i) { const int kk = 2 * i + (lane >> 5); float v = W[(size_t)(k0 + kk) * N + n0 + (lane & 31)]; if (kscale) v *= kscale[k0 + kk]; scr[kk * 33 + (lane & 31)] = v; }
    LDS_WAIT(); asm volatile("" ::: "memory");
    const int c = lane & 7;
#pragma unroll
    for (int j = 0; j < 4; ++j) { const int n = (lane >> 3) + 8 * j; const LAS float* s = scr + (8 * c) * 33 + n;
        v4u o; o.x = pk2(s[0 * 33], s[1 * 33]); o.y = pk2(s[2 * 33], s[3 * 33]); o.z = pk2(s[4 * 33], s[5 * 33]); o.w = pk2(s[6 * 33], s[7 * 33]);
        *(GAS v4u*)(WT + (size_t)(drow0 + n) * ldw + k0 + 8 * c) = o; }
    LDS_WAIT(); asm volatile("" ::: "memory");
}
__device__ __forceinline__ void p0_prologue(Frame& F) {
    LAS float* scr = (LAS float*)(F.lds + RING_OFF + F.wave * 16384);
    const int gw = F.vcu * NWAVES + F.wave, NGW = F.G * NWAVES;
    unsigned char* ws = F.ws;
    constexpr int I_IN = (D / 64) * (IN_COLS / 32), I_RW = (RWW / 64) * (D / 32), I_RET = (D / 64) * (D / 32), I_OUT = I_RET, I_UP = (D / 64) * (2 * DFF / 32), I_DN = (DFF / 64) * (D / 32);
    constexpr int I_W2 = (64 / 64) * (RWW / 32), I_G2 = (128 / 64) * (RWW / 32);
    constexpr int NITEMS = I_IN + I_RW + I_RET + I_OUT + I_UP + I_DN + 2 * I_W2 + I_G2;
    for (int it = gw; it < NITEMS; it += NGW) {
        int r = it;
        if (r < I_IN) { const int nb = IN_COLS / 32, kb = r / nb, n0 = 32 * (r % nb); p0_transpose_item(F.in[6], IN_COLS, (bf16*)(ws + WS_WIN), D, 64 * kb, n0, n0, F.in[2], scr, F.lane); continue; } r -= I_IN;
        if (r < I_RW) { const int nb = D / 32, kb = r / nb, n0 = 32 * (r % nb); p0_transpose_item(F.in[18], D, (bf16*)(ws + WS_WRW), RWW, 64 * kb, n0, n0, nullptr, scr, F.lane); continue; } r -= I_RW;
        if (r < I_RET) { const int nb = D / 32, kb = r / nb, n0 = 32 * (r % nb); p0_transpose_item(F.in[19], D, (bf16*)(ws + WS_WRET), D, 64 * kb, n0, n0, nullptr, scr, F.lane); continue; } r -= I_RET;
        if (r < I_OUT) { const int nb = D / 32, kb = r / nb, n0 = 32 * (r % nb); p0_transpose_item(F.in[20], D, (bf16*)(ws + WS_WOUT), D, 64 * kb, n0, n0, nullptr, scr, F.lane); continue; } r -= I_OUT;
        if (r < I_UP) { const int nb = 2 * DFF / 32, kb = r / nb, n0 = 32 * (r % nb);
            const int j = (n0 < DFF) ? n0 : n0 - DFF, drow = (j / 128) * 256 + (j % 128) + ((n0 < DFF) ? 0 : 128);
            p0_transpose_item(F.in[21], 2 * DFF, (bf16*)(ws + WS_WUP), D, 64 * kb, n0, drow, F.in[4], scr, F.lane); continue; } r -= I_UP;
        if (r < I_DN) { const int nb = D / 32, kb = r / nb, n0 = 32 * (r % nb); p0_transpose_item(F.in[24], D, (bf16*)(ws + WS_WDN), DFF, 64 * kb, n0, n0, nullptr, scr, F.lane); continue; } r -= I_DN;
        if (r < I_W2) { const int n0 = 32 * r; p0_transpose_item(F.in[9], RWW, (bf16*)(ws + WS_RWW), 64, 0, n0, n0, nullptr, scr, F.lane); continue; } r -= I_W2;
        if (r < I_W2) { const int n0 = 32 * r; p0_transpose_item(F.in[11], RWW, (bf16*)(ws + WS_RWW + 65536), 64, 0, n0, n0, nullptr, scr, F.lane); continue; } r -= I_W2;
        { const int nb = RWW / 32, kb = r / nb, n0 = 32 * (r % nb); p0_transpose_item(F.in[12], RWW, (bf16*)(ws + WS_RWW + 131072), 128, 64 * kb, n0, n0, nullptr, scr, F.lane); }
    }
    const float* x = F.in[0]; bf16* XN = (bf16*)((unsigned char*)F.out + OUT_XN);
    for (int m = gw; m < M; m += NGW) {
        const GAS f32x4* xr = (const GAS f32x4*)(x + (size_t)m * D) + F.lane;
        f32x4 v[4]; float s = 0.f;
#pragma unroll
        for (int j = 0; j < 4; ++j) { v[j] = xr[64 * j]; s += (v[j].x * v[j].x + v[j].y * v[j].y) + (v[j].z * v[j].z + v[j].w * v[j].w); }
        const float rstd = 1.0f / sqrtf(wave_sum(s) * (1.f / D) + RMS_EPS);
        GAS v2u* o8 = (GAS v2u*)(XN + (size_t)m * D) + F.lane;
#pragma unroll
        for (int j = 0; j < 4; ++j) { v2u o; o.x = pk2(v[j].x * rstd, v[j].y * rstd); o.y = pk2(v[j].z * rstd, v[j].w * rstd); o8[64 * j] = o; }
    }
    {
        const int* pos = (const int*)F.in[1]; f32x2* rope = (f32x2*)(ws + WS_ROPE);
        const int gt = (F.vcu * NWAVES + F.wave) * 64 + F.lane, NT = F.G * NWAVES * 64;
        const int j = gt & 31;
        const double inv = exp2(-(double)j * (13.287712379549449 / 32.0));
        for (int e = gt; e < M * 32; e += NT) {
            const int row = e >> 5;
            double a = (double)pos[row] * inv; a -= 6.283185307179586 * rint(a * 0.15915494309189535);
            float sn, cs; sincosf((float)a, &sn, &cs);
            rope[e] = (f32x2){cs, sn};
        }
    }
}

constexpr int RW_TC = 32;
constexpr int RWL_STEP = 0, RWL_YB = 49152, RWL_GATE = 57344, RWL_BONUS = 65536, RWL_AW = 65664, RWL_AA = 70272, RWL_AG = 74880, RWL_W2T = 83584, RWL_A2T = 92800, RWL_G2T = 102016, RWL_END = 119424;
static_assert(RWL_END <= RING_BYTES, "rwkv lds");
__device__ __forceinline__ float softplusf(float x) { return fmaxf(x, 0.f) + log1pf(expf(-fabsf(x))); }

__device__ __forceinline__ void rwkv_phase(Frame& F) {
    LAS unsigned char* L = F.lds;
    LAS float* STEP = (LAS float*)(L + RWL_STEP);
    LAS float* YB = (LAS float*)(L + RWL_YB);
    LAS float* GATE = (LAS float*)(L + RWL_GATE);
    LAS float* BONUS = (LAS float*)(L + RWL_BONUS);
    LAS bf16* AW = (LAS bf16*)(L + RWL_AW);
    LAS bf16* AA = (LAS bf16*)(L + RWL_AA);
    LAS bf16* AG = (LAS bf16*)(L + RWL_AG);
    LAS bf16* W2T = (LAS bf16*)(L + RWL_W2T);
    LAS bf16* A2T = (LAS bf16*)(L + RWL_A2T);
    LAS bf16* G2T = (LAS bf16*)(L + RWL_G2T);
    const int tid = F.tid, lane = F.lane, w = F.wave;
    const bf16* PRW = (const bf16*)(F.ws + WS_PRW);
    bf16* Yrw = (bf16*)((unsigned char*)F.out + OUT_YRW);
    const float* mu = F.in[7]; const float* w0 = F.in[8]; const float* a0 = F.in[10]; const float* k_k = F.in[13]; const float* k_a = F.in[14]; const float* r_k = F.in[15];
    const float* lnw = F.in[16]; const float* lnb = F.in[17];
    for (int unit = F.vcu; unit < BATCH * RWH; unit += F.G) {
        const int b = unit >> 3, h = unit & 7;
        __syncthreads();
        {
            const bf16* w2g = (const bf16*)(F.ws + WS_RWW) + (size_t)h * 64 * 64; const bf16* a2g = (const bf16*)(F.ws + WS_RWW + 65536) + (size_t)h * 64 * 64; const bf16* g2g = (const bf16*)(F.ws + WS_RWW + 131072) + (size_t)h * 64 * 128;
            { const int n = tid >> 3, c = tid & 7; *(LAS v4u*)(W2T + n * 72 + 8 * c) = *(const v4u*)(w2g + n * 64 + 8 * c); *(LAS v4u*)(A2T + n * 72 + 8 * c) = *(const v4u*)(a2g + n * 64 + 8 * c); }
#pragma unroll
            for (int q = 0; q < 2; ++q) { const int e = tid + 512 * q, n = e >> 4, c = e & 15; *(LAS v4u*)(G2T + n * 136 + 8 * c) = *(const v4u*)(g2g + n * 128 + 8 * c); }
        }
        const int kg = lane & 15, rg = lane >> 4, row0 = 8 * w + 2 * rg;
        f32x4 S0 = (f32x4){0.f, 0.f, 0.f, 0.f}, S1 = (f32x4){0.f, 0.f, 0.f, 0.f};
        for (int t0 = 0; t0 < T; t0 += RW_TC) {
            for (int it = tid; it < RW_TC * 56; it += 512) {
                const int tt = it / 56, cc = it % 56;
                int gc; if (cc < 8) gc = h * 64 + 8 * cc; else if (cc < 16) gc = 512 + h * 64 + 8 * (cc - 8); else if (cc < 24) gc = 1024 + h * 64 + 8 * (cc - 16); else gc = 1536 + 8 * (cc - 24);
                const size_t row = (size_t)b * T + t0 + tt;
                const v4u cw = *(const v4u*)(PRW + row * RW_COLS + gc);
                v4u pw = (v4u){0u, 0u, 0u, 0u}; if (t0 + tt > 0) pw = *(const v4u*)(PRW + (row - 1) * RW_COLS + gc);
                const f32x4 m0 = *(const f32x4*)(mu + gc), m1 = *(const f32x4*)(mu + gc + 4);
                float x[8];
                { const float c0 = bflo(cw.x), c1 = bfhi(cw.x), c2 = bflo(cw.y), c3 = bfhi(cw.y), c4 = bflo(cw.z), c5 = bfhi(cw.z), c6 = bflo(cw.w), c7 = bfhi(cw.w);
                  x[0] = c0 + (bflo(pw.x) - c0) * m0[0]; x[1] = c1 + (bfhi(pw.x) - c1) * m0[1]; x[2] = c2 + (bflo(pw.y) - c2) * m0[2]; x[3] = c3 + (bfhi(pw.y) - c3) * m0[3];
                  x[4] = c4 + (bflo(pw.z) - c4) * m1[0]; x[5] = c5 + (bfhi(pw.z) - c5) * m1[1]; x[6] = c6 + (bflo(pw.w) - c6) * m1[2]; x[7] = c7 + (bfhi(pw.w) - c7) * m1[3]; }
                if (cc < 24) {
                    const int a = (cc < 8) ? 4 : (cc < 16) ? 3 : 5; const int c8 = 8 * (cc & 7);
                    LAS f32x4* d = (LAS f32x4*)(STEP + (tt * 6 + a) * 64 + c8);
                    d[0] = (f32x4){x[0], x[1], x[2], x[3]}; d[1] = (f32x4){x[4], x[5], x[6], x[7]};
                } else if (cc < 32) {
                    v4u o; o.x = pk2(tanhf(x[0]), tanhf(x[1])); o.y = pk2(tanhf(x[2]), tanhf(x[3])); o.z = pk2(tanhf(x[4]), tanhf(x[5])); o.w = pk2(tanhf(x[6]), tanhf(x[7]));
                    *(LAS v4u*)(AW + tt * 72 + 8 * (cc - 24)) = o;
                } else if (cc < 40) {
                    v4u o; o.x = pk2(x[0], x[1]); o.y = pk2(x[2], x[3]); o.z = pk2(x[4], x[5]); o.w = pk2(x[6], x[7]);
                    *(LAS v4u*)(AA + tt * 72 + 8 * (cc - 32)) = o;
                } else {
                    float s[8];
#pragma unroll
                    for (int i = 0; i < 8; ++i) s[i] = 1.0f / (1.0f + expf(-x[i]));
                    v4u o; o.x = pk2(s[0], s[1]); o.y = pk2(s[2], s[3]); o.z = pk2(s[4], s[5]); o.w = pk2(s[6], s[7]);
                    *(LAS v4u*)(AG + tt * 136 + 8 * (cc - 40)) = o;
                }
            }
            __syncthreads();
            {
                const int fr = lane & 15, fq = lane >> 4;
                if (w < 4) {
                    const bool isw = (w < 2); const int mb = w & 1;
                    LAS bf16* Aop = isw ? AW : AA; LAS bf16* Bop = isw ? W2T : A2T;
                    f32x4 acc[4];
#pragma unroll
                    for (int nb = 0; nb < 4; ++nb) acc[nb] = (f32x4){0.f, 0.f, 0.f, 0.f};
#pragma unroll
                    for (int ks = 0; ks < 2; ++ks) { const bf16x8 af = *(const LAS bf16x8*)(Aop + (mb * 16 + fr) * 72 + ks * 32 + 8 * fq);
#pragma unroll
                        for (int nb = 0; nb < 4; ++nb) { const bf16x8 bfv = *(const LAS bf16x8*)(Bop + (nb * 16 + fr) * 72 + ks * 32 + 8 * fq);
                            acc[nb] = __builtin_amdgcn_mfma_f32_16x16x32_bf16(af, bfv, acc[nb], 0, 0, 0); } }
                    if (isw) {
#pragma unroll
                        for (int nb = 0; nb < 4; ++nb) { const int c = nb * 16 + fr; const float w0c = w0[h * 64 + c];
#pragma unroll
                            for (int rg4 = 0; rg4 < 4; ++rg4) { const int tt = mb * 16 + 4 * fq + rg4; const float wl = -softplusf(-(w0c + acc[nb][rg4])) - 0.5f;
                                STEP[(tt * 6 + 0) * 64 + c] = expf(-expf(wl)); } }
                    } else {
                        float a_[4][4], xk[4][4], kkr[4][4]; float n2[4] = {0.f, 0.f, 0.f, 0.f};
#pragma unroll
                        for (int nb = 0; nb < 4; ++nb) { const int c = nb * 16 + fr; const float a0c = a0[h * 64 + c], kkc = k_k[h * 64 + c];
#pragma unroll
                            for (int rg4 = 0; rg4 < 4; ++rg4) { const int tt = mb * 16 + 4 * fq + rg4; a_[nb][rg4] = 1.0f / (1.0f + expf(-(a0c + acc[nb][rg4])));
                                xk[nb][rg4] = STEP[(tt * 6 + 3) * 64 + c]; kkr[nb][rg4] = xk[nb][rg4] * kkc; n2[rg4] += kkr[nb][rg4] * kkr[nb][rg4]; } }
                        float bon[4] = {0.f, 0.f, 0.f, 0.f};
#pragma unroll
                        for (int rg4 = 0; rg4 < 4; ++rg4) n2[rg4] = 1.0f / fmaxf(sqrtf(row16_sum(n2[rg4])), 1e-12f);
#pragma unroll
                        for (int nb = 0; nb < 4; ++nb) { const int c = nb * 16 + fr; const float kac = k_a[h * 64 + c], rkc = r_k[h * 64 + c];
#pragma unroll
                            for (int rg4 = 0; rg4 < 4; ++rg4) { const int tt = mb * 16 + 4 * fq + rg4; const float kk = kkr[nb][rg4] * n2[rg4], a = a_[nb][rg4];
                                const float kx = xk[nb][rg4] * (1.0f + (a - 1.0f) * kac);
                                STEP[(tt * 6 + 1) * 64 + c] = -kk; STEP[(tt * 6 + 2) * 64 + c] = kk * a; STEP[(tt * 6 + 3) * 64 + c] = kx;
                                bon[rg4] += STEP[(tt * 6 + 4) * 64 + c] * kx * rkc; } }
#pragma unroll
                        for (int rg4 = 0; rg4 < 4; ++rg4) { const float bs = row16_sum(bon[rg4]); if (fr == 0) BONUS[mb * 16 + 4 * fq + rg4] = bs; }
                    }
                } else {
                    const int mb = (w - 4) & 1, nb0 = ((w - 4) >> 1) * 2;
                    f32x4 acc[2]; acc[0] = (f32x4){0.f, 0.f, 0.f, 0.f}; acc[1] = acc[0];
#pragma unroll
                    for (int ks = 0; ks < 4; ++ks) { const bf16x8 af = *(const LAS bf16x8*)(AG + (mb * 16 + fr) * 136 + ks * 32 + 8 * fq);
#pragma unroll
                        for (int q = 0; q < 2; ++q) { const bf16x8 bfv = *(const LAS bf16x8*)(G2T + ((nb0 + q) * 16 + fr) * 136 + ks * 32 + 8 * fq);
                            acc[q] = __builtin_amdgcn_mfma_f32_16x16x32_bf16(af, bfv, acc[q], 0, 0, 0); } }
#pragma unroll
                    for (int q = 0; q < 2; ++q)
#pragma unroll
                        for (int rg4 = 0; rg4 < 4; ++rg4) GATE[(mb * 16 + 4 * fq + rg4) * 64 + (nb0 + q) * 16 + fr] = acc[q][rg4];
                }
            }
            __syncthreads();
#pragma unroll 2
            for (int tt = 0; tt < RW_TC; ++tt) {
                const LAS float* sp = STEP + tt * 384;
                const f32x4 dec = *(const LAS f32x4*)(sp + 4 * kg), kkn = *(const LAS f32x4*)(sp + 64 + 4 * kg), bb = *(const LAS f32x4*)(sp + 128 + 4 * kg);
                const f32x4 kx = *(const LAS f32x4*)(sp + 192 + 4 * kg), rr = *(const LAS f32x4*)(sp + 256 + 4 * kg);
                const f32x2 vv = *(const LAS f32x2*)(sp + 320 + row0);
                float p0 = (S0[0] * kkn[0] + S0[1] * kkn[1]) + (S0[2] * kkn[2] + S0[3] * kkn[3]);
                float p1 = (S1[0] * kkn[0] + S1[1] * kkn[1]) + (S1[2] * kkn[2] + S1[3] * kkn[3]);
                const float sa0 = row16_sum(p0), sa1 = row16_sum(p1);
                S0 = S0 * dec + sa0 * bb + vv[0] * kx;
                S1 = S1 * dec + sa1 * bb + vv[1] * kx;
                float q0 = (S0[0] * rr[0] + S0[1] * rr[1]) + (S0[2] * rr[2] + S0[3] * rr[3]);
                float q1 = (S1[0] * rr[0] + S1[1] * rr[1]) + (S1[2] * rr[2] + S1[3] * rr[3]);
                q0 = row16_sum(q0); q1 = row16_sum(q1);
                if (kg == 0) *(LAS f32x2*)(YB + tt * 64 + row0) = (f32x2){q0, q1};
            }
            __syncthreads();
            {
                const int tt = tid >> 4, cq = tid & 15, c = 4 * cq;
                const f32x4 y = *(const LAS f32x4*)(YB + tt * 64 + c);
                const float mean = row16_sum((y[0] + y[1]) + (y[2] + y[3])) * (1.f / 64.f);
                const f32x4 dlt = y - mean;
                const float var = row16_sum((dlt[0] * dlt[0] + dlt[1] * dlt[1]) + (dlt[2] * dlt[2] + dlt[3] * dlt[3])) * (1.f / 64.f);
                const float rs = 1.0f / sqrtf(var + RW_GN_EPS);
                const f32x4 lw = *(const f32x4*)(lnw + h * 64 + c), lb = *(const f32x4*)(lnb + h * 64 + c);
                const f32x4 vv = *(const LAS f32x4*)(STEP + (tt * 6 + 5) * 64 + c), gt = *(const LAS f32x4*)(GATE + tt * 64 + c);
                const float bo = BONUS[tt];
                f32x4 o = (dlt * rs * lw + lb + bo * vv) * gt;
                v2u pw; pw.x = pk2(o[0], o[1]); pw.y = pk2(o[2], o[3]);
                *(v2u*)(Yrw + ((size_t)b * T + t0 + tt) * RWW + h * 64 + c) = pw;
            }
            __syncthreads();
        }
    }
}

constexpr int RTL_Q = 0, RTL_K1 = 18432, RTL_K1T = 36864, RTL_VT = 54272, RTL_SP = 89088, RTL_RT = 123904, RTL_END = 142336;
static_assert(RTL_END <= LDSCTL_OFF, "retention lds");
__device__ __forceinline__ void retention_phase(Frame& F) {
    LAS unsigned char* L = F.lds;
    LAS bf16* Q = (LAS bf16*)(L + RTL_Q);
    LAS bf16* K1 = (LAS bf16*)(L + RTL_K1);
    LAS bf16* K1T = (LAS bf16*)(L + RTL_K1T);
    LAS bf16* VT = (LAS bf16*)(L + RTL_VT);
    LAS bf16* SP = (LAS bf16*)(L + RTL_SP);
    LAS bf16* RT = (LAS bf16*)(L + RTL_RT);
    const int tid = F.tid, lane = F.lane, w = F.wave, fr = lane & 15, fq = lane >> 4;
    const bf16* PRET = (const bf16*)(F.ws + WS_PRET);
    const f32x2* rope = (const f32x2*)(F.ws + WS_ROPE);
    bf16* Yret = (bf16*)((unsigned char*)F.out + OUT_YRET);
    for (int unit = F.vcu; unit < BATCH * RTH; unit += F.G) {
        const int b = unit >> 3, h = unit & 7;
        const float lg = log1pf(-exp2f(-5.0f - (float)h));
        const float cdec = expf(128.0f * lg);
        __syncthreads();
        for (int e = tid; e < 128 * 72 / 8; e += 512) *(LAS v4u*)(RT + 8 * e) = (v4u){0u, 0u, 0u, 0u};
        f32x4 accR[4];
#pragma unroll
        for (int db = 0; db < 4; ++db) accR[db] = (f32x4){0.f, 0.f, 0.f, 0.f};
        for (int ch = 0; ch < T / RCH; ++ch) {
            const size_t rowbase = (size_t)b * T + (size_t)ch * RCH;
            {
                const int i = tid >> 2, jc = tid & 3; const size_t row = rowbase + i;
                const f32x4* rp = (const f32x4*)(rope + row * 32 + 8 * jc);
                const f32x4 r0 = rp[0], r1 = rp[1], r2 = rp[2], r3 = rp[3];
                const float cs[8] = {r0[0], r0[2], r1[0], r1[2], r2[0], r2[2], r3[0], r3[2]}, sn[8] = {r0[1], r0[3], r1[1], r1[3], r2[1], r2[3], r3[1], r3[3]};
                {
                    const v4u a = *(const v4u*)(PRET + row * RET_COLS + h * 64 + 8 * jc), c = *(const v4u*)(PRET + row * RET_COLS + h * 64 + 32 + 8 * jc);
                    const float z1[8] = {bflo(a.x), bfhi(a.x), bflo(a.y), bfhi(a.y), bflo(a.z), bfhi(a.z), bflo(a.w), bfhi(a.w)}, z2[8] = {bflo(c.x), bfhi(c.x), bflo(c.y), bfhi(c.y), bflo(c.z), bfhi(c.z), bflo(c.w), bfhi(c.w)};
                    float o1[8], o2[8];
#pragma unroll
                    for (int q = 0; q < 8; ++q) { o1[q] = z1[q] * cs[q] - z2[q] * sn[q]; o2[q] = z1[q] * sn[q] + z2[q] * cs[q]; }
                    v4u p1, p2; p1.x = pk2(o1[0], o1[1]); p1.y = pk2(o1[2], o1[3]); p1.z = pk2(o1[4], o1[5]); p1.w = pk2(o1[6], o1[7]); p2.x = pk2(o2[0], o2[1]); p2.y = pk2(o2[2], o2[3]); p2.z = pk2(o2[4], o2[5]); p2.w = pk2(o2[6], o2[7]);
                    *(LAS v4u*)(Q + i * 72 + 8 * jc) = p1; *(LAS v4u*)(Q + i * 72 + 32 + 8 * jc) = p2;
                }
                {
                    const float ksc = 0.125f * expf(-(float)(i + 1) * lg);
                    const v4u a = *(const v4u*)(PRET + row * RET_COLS + 512 + h * 64 + 8 * jc), c = *(const v4u*)(PRET + row * RET_COLS + 512 + h * 64 + 32 + 8 * jc);
                    const float z1[8] = {bflo(a.x), bfhi(a.x), bflo(a.y), bfhi(a.y), bflo(a.z), bfhi(a.z), bflo(a.w), bfhi(a.w)}, z2[8] = {bflo(c.x), bfhi(c.x), bflo(c.y), bfhi(c.y), bflo(c.z), bfhi(c.z), bflo(c.w), bfhi(c.w)};
                    unsigned short o1[8], o2[8];
#pragma unroll
                    for (int q = 0; q < 8; ++q) { o1[q] = (unsigned short)f2bf((z1[q] * cs[q] - z2[q] * sn[q]) * ksc); o2[q] = (unsigned short)f2bf((z1[q] * sn[q] + z2[q] * cs[q]) * ksc); }
                    v4u p1, p2; p1.x = o1[0] | (o1[1] << 16); p1.y = o1[2] | (o1[3] << 16); p1.z = o1[4] | (o1[5] << 16); p1.w = o1[6] | (o1[7] << 16);
                    p2.x = o2[0] | (o2[1] << 16); p2.y = o2[2] | (o2[3] << 16); p2.z = o2[4] | (o2[5] << 16); p2.w = o2[6] | (o2[7] << 16);
                    *(LAS v4u*)(K1 + i * 72 + 8 * jc) = p1; *(LAS v4u*)(K1 + i * 72 + 32 + 8 * jc) = p2;
#pragma unroll
                    for (int q = 0; q < 8; ++q) { K1T[(8 * jc + q) * 136 + i] = o1[q]; K1T[(32 + 8 * jc + q) * 136 + i] = o2[q]; }
                }
#pragma unroll
                for (int q4 = 0; q4 < 4; ++q4) { const int e = tid + 512 * q4, iv = e >> 4, vc = e & 15;
                    const v4u a = *(const v4u*)(PRET + (rowbase + iv) * RET_COLS + 1024 + h * 128 + 8 * vc);
                    VT[(8 * vc + 0) * 136 + iv] = (bf16)(a.x & 0xffffu); VT[(8 * vc + 1) * 136 + iv] = (bf16)(a.x >> 16); VT[(8 * vc + 2) * 136 + iv] = (bf16)(a.y & 0xffffu); VT[(8 * vc + 3) * 136 + iv] = (bf16)(a.y >> 16);
                    VT[(8 * vc + 4) * 136 + iv] = (bf16)(a.z & 0xffffu); VT[(8 * vc + 5) * 136 + iv] = (bf16)(a.z >> 16); VT[(8 * vc + 6) * 136 + iv] = (bf16)(a.w & 0xffffu); VT[(8 * vc + 7) * 136 + iv] = (bf16)(a.w >> 16); }
            }
            __syncthreads();
            const int i0 = 16 * w;
            bf16x8 qf[2];
#pragma unroll
            for (int ks = 0; ks < 2; ++ks) qf[ks] = *(const LAS bf16x8*)(Q + (i0 + fr) * 72 + ks * 32 + 8 * fq);
            LAS bf16* SPw = SP + w * 16 * 136;
#pragma unroll
            for (int nb = 0; nb < 8; ++nb) {
                f32x4 s = (f32x4){0.f, 0.f, 0.f, 0.f};
#pragma unroll
                for (int ks = 0; ks < 2; ++ks) { const bf16x8 kf = *(const LAS bf16x8*)(K1 + (nb * 16 + fr) * 72 + ks * 32 + 8 * fq); s = __builtin_amdgcn_mfma_f32_16x16x32_bf16(qf[ks], kf, s, 0, 0, 0); }
                const int key = nb * 16 + fr;
#pragma unroll
                for (int rg4 = 0; rg4 < 4; ++rg4) { const int qi = i0 + 4 * fq + rg4; SPw[(4 * fq + rg4) * 136 + key] = (bf16)f2bf(key <= qi ? s[rg4] : 0.f); }
            }
            LDS_WAIT();
            f32x4 o[8];
#pragma unroll
            for (int nb = 0; nb < 8; ++nb) o[nb] = (f32x4){0.f, 0.f, 0.f, 0.f};
#pragma unroll
            for (int ks = 0; ks < 4; ++ks) { const bf16x8 sf = *(const LAS bf16x8*)(SPw + fr * 136 + ks * 32 + 8 * fq);
#pragma unroll
                for (int nb = 0; nb < 8; ++nb) { const bf16x8 vf = *(const LAS bf16x8*)(VT + (nb * 16 + fr) * 136 + ks * 32 + 8 * fq); o[nb] = __builtin_amdgcn_mfma_f32_16x16x32_bf16(sf, vf, o[nb], 0, 0, 0); } }
#pragma unroll
            for (int ks = 0; ks < 2; ++ks)
#pragma unroll
                for (int nb = 0; nb < 8; ++nb) { const bf16x8 rf = *(const LAS bf16x8*)(RT + (nb * 16 + fr) * 72 + ks * 32 + 8 * fq); o[nb] = __builtin_amdgcn_mfma_f32_16x16x32_bf16(qf[ks], rf, o[nb], 0, 0, 0); }
#pragma unroll
            for (int ks = 0; ks < 4; ++ks) { const bf16x8 vf = *(const LAS bf16x8*)(VT + (w * 16 + fr) * 136 + ks * 32 + 8 * fq);
#pragma unroll
                for (int db = 0; db < 4; ++db) { const bf16x8 kf = *(const LAS bf16x8*)(K1T + (db * 16 + fr) * 136 + ks * 32 + 8 * fq); accR[db] = __builtin_amdgcn_mfma_f32_16x16x32_bf16(vf, kf, accR[db], 0, 0, 0); } }
#pragma unroll
            for (int db = 0; db < 4; ++db) accR[db] = accR[db] * cdec;
#pragma unroll
            for (int rg4 = 0; rg4 < 4; ++rg4) {
                const int il = i0 + 4 * fq + rg4; const float qd = expf((float)(il + 1) * lg);
                float s1 = 0.f;
#pragma unroll
                for (int nb = 0; nb < 8; ++nb) { o[nb][rg4] *= qd; s1 += o[nb][rg4]; }
                const float mean = row16_sum(s1) * (1.f / 128.f);
                float s2 = 0.f;
#pragma unroll
                for (int nb = 0; nb < 8; ++nb) { const float dl = o[nb][rg4] - mean; s2 += dl * dl; }
                const float rs = 1.0f / sqrtf(row16_sum(s2) * (1.f / 128.f) + RET_GN_EPS);
                const size_t row = rowbase + il;
#pragma unroll
                for (int nb = 0; nb < 8; ++nb) { const int e = nb * 16 + fr; const float gv = bf1(PRET[row * RET_COLS + 2048 + h * 128 + e]);
                    Yret[row * 1024 + h * 128 + e] = (bf16)f2bf((o[nb][rg4] - mean) * rs * gv); }
            }
            __syncthreads();
#pragma unroll
            for (int db = 0; db < 4; ++db)
#pragma unroll
                for (int rg4 = 0; rg4 < 4; ++rg4) RT[(w * 16 + 4 * fq + rg4) * 72 + db * 16 + fr] = (bf16)f2bf(accR[db][rg4]);
        }
    }
}

__device__ __forceinline__ void norm_mix_phase(Frame& F) {
    const int gw = F.vcu * NWAVES + F.wave, NGW = F.G * NWAVES;
    const bf16* Z = (const bf16*)(F.ws + WS_Z); const float* part = (const float*)(F.ws + WS_PART); const float* x = F.in[0]; const float* gpost = F.in[3];
    bf16* XN2 = (bf16*)(F.ws + WS_XN2);
    f32x4 g[4];
#pragma unroll
    for (int j = 0; j < 4; ++j) g[j] = ((const f32x4*)gpost)[F.lane + 64 * j];
    for (int m = gw; m < M; m += NGW) {
        const float pv = (F.lane < 16) ? part[(size_t)m * 16 + F.lane] : 0.f;
        const float rstd = 1.0f / sqrtf(wave_sum(pv) * (1.f / D) + RMS_EPS);
        const GAS f32x4* xr = (const GAS f32x4*)(x + (size_t)m * D) + F.lane; const GAS v2u* zr = (const GAS v2u*)(Z + (size_t)m * D) + F.lane;
        f32x4 hv[4]; float s = 0.f;
#pragma unroll
        for (int j = 0; j < 4; ++j) { const v2u zw = zr[64 * j]; const f32x4 z = (f32x4){bflo(zw.x), bfhi(zw.x), bflo(zw.y), bfhi(zw.y)};
            hv[j] = xr[64 * j] + z * rstd * g[j]; s += (hv[j].x * hv[j].x + hv[j].y * hv[j].y) + (hv[j].z * hv[j].z + hv[j].w * hv[j].w); }
        const float rstd2 = 1.0f / sqrtf(wave_sum(s) * (1.f / D) + RMS_EPS);
        GAS f32x4* orow = (GAS f32x4*)(F.out + (size_t)m * D) + F.lane; GAS v2u* o8 = (GAS v2u*)(XN2 + (size_t)m * D) + F.lane;
#pragma unroll
        for (int j = 0; j < 4; ++j) { orow[64 * j] = hv[j]; v2u o; o.x = pk2(hv[j].x * rstd2, hv[j].y * rstd2); o.y = pk2(hv[j].z * rstd2, hv[j].w * rstd2); o8[64 * j] = o; }
    }
}
__device__ __forceinline__ void norm_ffn_phase(Frame& F) {
    const int gw = F.vcu * NWAVES + F.wave, NGW = F.G * NWAVES;
    const bf16* Z = (const bf16*)(F.ws + WS_F); const float* part = (const float*)(F.ws + WS_PART2); const float* gpost = F.in[5];
    f32x4 g[4];
#pragma unroll
    for (int j = 0; j < 4; ++j) g[j] = ((const f32x4*)gpost)[F.lane + 64 * j];
    for (int m = gw; m < M; m += NGW) {
        const float pv = (F.lane < 16) ? part[(size_t)m * 16 + F.lane] : 0.f;
        const float rstd = 1.0f / sqrtf(wave_sum(pv) * (1.f / D) + RMS_EPS);
        GAS f32x4* orow = (GAS f32x4*)(F.out + (size_t)m * D) + F.lane; const GAS v2u* zr = (const GAS v2u*)(Z + (size_t)m * D) + F.lane;
#pragma unroll
        for (int j = 0; j < 4; ++j) { const v2u zw = zr[64 * j]; const f32x4 z = (f32x4){bflo(zw.x), bfhi(zw.x), bflo(zw.y), bfhi(zw.y)};
            orow[64 * j] = orow[64 * j] + z * rstd * g[j]; }
    }
}
__device__ __forceinline__ void conv_fixup_phase(Frame& F) {
    const float* halo = (const float*)(F.ws + WS_HALO); const float* cw = F.in[22]; const float* cb = F.in[23]; bf16* act = (bf16*)(F.ws + WS_ACT);
    const int gt = (F.vcu * NWAVES + F.wave) * 64 + F.lane, NT = F.G * NWAVES * 64;
    for (int e = gt; e < 256 * DFF; e += NT) {
        const int pm = e / DFF, j = e % DFF; if ((pm & 7) == 0) continue;
        const int tg = (j >> 7) * 256 + (j & 127), tv = tg + 128;
        const float* hc = halo + (size_t)pm * 4 * 5632; const float* hp = halo + (size_t)(pm - 1) * 4 * 5632;
        const float g254 = hp[2 * 5632 + tg], g255 = hp[3 * 5632 + tg], g0 = hc[tg], g1 = hc[5632 + tg];
        const float v254 = hp[2 * 5632 + tv], v255 = hp[3 * 5632 + tv], v0 = hc[tv], v1 = hc[5632 + tv];
        const float cg0 = cw[j], cg1 = cw[5632 + j], cg2 = cw[2 * 5632 + j], cgb = cb[j];
        const float cv0 = cw[DFF + j], cv1 = cw[5632 + DFF + j], cv2 = cw[2 * 5632 + DFF + j], cvb = cb[DFF + j];
        const float og0 = cgb + cg0 * g254 + cg1 * g255 + cg2 * g0, og1 = cgb + cg0 * g255 + cg1 * g0 + cg2 * g1;
        const float ov0 = cvb + cv0 * v254 + cv1 * v255 + cv2 * v0, ov1 = cvb + cv0 * v255 + cv1 * v0 + cv2 * v1;
        act[(size_t)(pm * 256) * DFF + j] = (bf16)f2bf(pg8::gelu_tanh(og0) * ov0);
        act[(size_t)(pm * 256 + 1) * DFF + j] = (bf16)f2bf(pg8::gelu_tanh(og1) * ov1);
    }
}

struct Args { const float* in[25]; float* out; unsigned char* ws; int ph_lo, ph_hi, li, pad; };
__global__ void __launch_bounds__(NWAVES * 64, 2) hyb_fwd(Args args) {
    extern __shared__ __attribute__((aligned(16))) unsigned char lds[];
    Frame F;
    F.lds = (LAS unsigned char*)lds;
    F.MISC = (volatile LAS unsigned*)(F.lds + MISC_OFF);
    F.tid = threadIdx.x; F.lane = F.tid & 63; F.wave = __builtin_amdgcn_readfirstlane(F.tid >> 6);
    F.G = gridDim.x; { const int bx = blockIdx.x; F.vcu = (F.G % 8 == 0) ? (bx % 8) * (F.G / 8) + bx / 8 : bx; }
    unsigned char* ws = args.ws; F.ws = ws; F.out = args.out;
#pragma unroll
    for (int i = 0; i < 25; ++i) F.in[i] = args.in[i];
    F.ctl = (gu32*)(ws + WS_CTL);
    for (int u = F.tid; u < (LDS_BYTES - LDSCTL_OFF) / 4; u += NWAVES * 64) ((LAS unsigned*)(F.lds + LDSCTL_OFF))[u] = 0u;
    __syncthreads();
    XcdBarrier bar; bar.bar = (unsigned*)(F.ctl + CW_BAR) + args.li * XCD_BAR_WORDS; bar.x = 0; bar.st = nullptr;
    if (MK_N_LAUNCHES == 1) bar = xcd_barrier_post((unsigned*)(F.ctl + CW_BAR) + args.li * XCD_BAR_WORDS, F.MISC + 8);
    const int lo = args.ph_lo, hi = args.ph_hi;
#define IN(k) (lo <= (k) && (k) < hi)
#define SEAM(k) do { if (IN(k) && IN((k) + 1)) xcd_barrier(bar); } while (0)
    using namespace pg8;
    bf16* XN = (bf16*)((unsigned char*)F.out + OUT_XN);

    if (IN(0)) { p0_prologue(F); } SEAM(0);
    if (IN(1)) {
        Gemm g{XN, (const bf16_t*)(ws + WS_WIN), M, IN_COLS, D}; StaticOrder S; S.init(M, IN_COLS, F.G, (int)blockIdx.x);
        EpiIn E{(bf16_t*)(ws + WS_PRW), (bf16_t*)(ws + WS_PRET), (bf16_t*)(ws + WS_G)};
        gemm_phase<EpiIn, StaticOrder, true, true>(F.lds + RING_OFF, g, S, E);
    } SEAM(1);
    if (IN(2)) { rwkv_phase(F); __syncthreads(); retention_phase(F); } SEAM(2);
    if (IN(3)) {
        { Gemm g{(const bf16_t*)((unsigned char*)F.out + OUT_YRW), (const bf16_t*)(ws + WS_WRW), M, D, RWW}; StaticOrder S; S.init(M, D, F.G, (int)blockIdx.x);
          EpiGate<false> E{(bf16_t*)(ws + WS_MERGED), (const bf16_t*)(ws + WS_G), 0};
          gemm_phase<EpiGate<false>, StaticOrder, true, true>(F.lds + RING_OFF, g, S, E); }
        VM_WAIT(); __syncthreads();
        { Gemm g{(const bf16_t*)((unsigned char*)F.out + OUT_YRET), (const bf16_t*)(ws + WS_WRET), M, D, D}; StaticOrder S; S.init(M, D, F.G, (int)blockIdx.x);
          EpiGate<true> E{(bf16_t*)(ws + WS_MERGED), (const bf16_t*)(ws + WS_G), 1024};
          gemm_phase<EpiGate<true>, StaticOrder, true, true>(F.lds + RING_OFF, g, S, E); }
    } SEAM(3);
    if (IN(4)) {
        Gemm g{(const bf16_t*)(ws + WS_MERGED), (const bf16_t*)(ws + WS_WOUT), M, D, D}; StaticOrder S; S.init(M, D, F.G, (int)blockIdx.x);
        EpiZ E{(bf16_t*)(ws + WS_Z), (float*)(ws + WS_PART)};
        gemm_phase<EpiZ, StaticOrder, true, true>(F.lds + RING_OFF, g, S, E);
    } SEAM(4);
    if (IN(5)) { norm_mix_phase(F); } SEAM(5);
    if (IN(6)) {
        Gemm g{(const bf16_t*)(ws + WS_XN2), (const bf16_t*)(ws + WS_WUP), M, 2 * DFF, D}; StaticOrder S; S.init(M, 2 * DFF, F.G, (int)blockIdx.x);
        EpiConv E{(bf16_t*)(ws + WS_ACT), F.in[22], F.in[23], (float*)(ws + WS_HALO), (PG8_LAS float*)(F.lds + XCH_OFF)};
        gemm_phase<EpiConv, StaticOrder, true, true>(F.lds + RING_OFF, g, S, E);
    } SEAM(6);
    if (IN(7)) { conv_fixup_phase(F); } SEAM(7);
    if (IN(8)) {
        Gemm g{(const bf16_t*)(ws + WS_ACT), (const bf16_t*)(ws + WS_WDN), M, D, DFF}; StaticOrder S; S.init(M, D, F.G, (int)blockIdx.x);
        EpiZ E{(bf16_t*)(ws + WS_F), (float*)(ws + WS_PART2)};
        gemm_phase<EpiZ, StaticOrder, true, true>(F.lds + RING_OFF, g, S, E);
    } SEAM(8);
    if (IN(9)) { norm_ffn_phase(F); }
#undef IN
#undef SEAM
}

extern "C" void kernel_launch(void* const* d_in, const int* in_sizes, int n_in, void* d_out, int out_size, void* d_ws, size_t ws_size, hipStream_t stream) {
    static int grid = 0;
    if (grid == 0) {
        if (n_in != 25 || in_sizes[0] != M * D || out_size != M * D || ws_size < WS_END) { fprintf(stderr, "kernel_launch: unexpected shapes (n_in %d, in0 %d, out %d, ws %zu); nothing launched\n", n_in, n_in > 0 ? in_sizes[0] : -1, out_size, ws_size); grid = -1; return; }
        int dev = 0, cus = 0, per_cu = 0;
        if (hipGetDevice(&dev) != hipSuccess || hipDeviceGetAttribute(&cus, hipDeviceAttributeMultiprocessorCount, dev) != hipSuccess) { grid = -1; return; }
        if (hipFuncSetAttribute((const void*)hyb_fwd, hipFuncAttributeMaxDynamicSharedMemorySize, LDS_BYTES) != hipSuccess) { fprintf(stderr, "kernel_launch: hipFuncSetAttribute failed\n"); grid = -1; return; }
        if (hipOccupancyMaxActiveBlocksPerMultiprocessor(&per_cu, (const void*)hyb_fwd, NWAVES * 64, LDS_BYTES) != hipSuccess || per_cu < 1) { fprintf(stderr, "kernel_launch: occupancy query reports %d workgroups per CU\n", per_cu); (void)hipGetLastError(); grid = -1; return; }
        (void)hipGetLastError();
        grid = cus;
    }
    if (grid < 0) return;
    if (hipMemsetAsync((char*)d_ws + WS_CTL, 0, CTL_ZERO_BYTES, stream) != hipSuccess) return;
    Args a{};
    for (int i = 0; i < 25; ++i) a.in[i] = (const float*)d_in[i];
    a.out = (float*)d_out; a.ws = (unsigned char*)d_ws;
#if MK_N_LAUNCHES == 1
    a.ph_lo = 0; a.ph_hi = N_PHASES; a.li = 0;
    hipLaunchKernelGGL(hyb_fwd, dim3(grid), dim3(NWAVES * 64), LDS_BYTES, stream, a);
#else
    for (int li = 0; li < N_PHASES; ++li) { a.ph_lo = li; a.ph_hi = li + 1; a.li = 0; hipLaunchKernelGGL(hyb_fwd, dim3(grid), dim3(NWAVES * 64), LDS_BYTES, stream, a); }
#endif
}
```

```cpp
#include <hip/hip_runtime.h>
#include <cstdio>
#include <cstdint>

#ifndef MK_N_LAUNCHES
#define MK_N_LAUNCHES 1
#endif
#ifndef PROBE_PH
#define PROBE_PH (-1)
#endif
#ifndef PROBE_NOSTORE
#define PROBE_NOSTORE 0
#endif
#ifndef PROBE_SPLIT
#define PROBE_SPLIT (-1)
#endif
#define REP(k) for (int _r = 0; _r < ((PROBE_PH == (k) || (PROBE_PH == 95 && ((k) == 0 || (k) == 5 || (k) == 9))) ? 2 : 1); ++_r)

namespace pg8 {
#define PG8_LAS __attribute__((address_space(3)))
typedef unsigned short bf16_t;
typedef short bf16x8 __attribute__((ext_vector_type(8)));
typedef float f32x4 __attribute__((ext_vector_type(4)));
typedef float f32x2 __attribute__((ext_vector_type(2)));
typedef unsigned u32x4 __attribute__((ext_vector_type(4)));
typedef unsigned u32x2 __attribute__((ext_vector_type(2)));
constexpr int BM = 256, BK = 64, HALF = 128, HTB = HALF * BK * 2, STAGE_BYTES = 8 * HTB, NXCD = 8, WGM = 4;

__host__ __device__ __forceinline__ int lds_byte(int r, int c) { const int st = (r >> 4) * 2 + (c >> 5), rr = r & 15, cc = c & 31, ob = rr * 64 + cc * 2; return st * 1024 + (ob ^ (((ob >> 9) & 1) << 5)); }
__host__ __device__ __forceinline__ void stage_rc(int b, int& R, int& C) { const int st = b / 1024, sb = b % 1024, swz = sb ^ (((sb >> 9) & 1) << 5); R = (st >> 1) * 16 + swz / 64; C = (st & 1) * 32 + (swz % 64) / 2; }
__host__ __device__ __forceinline__ int perm32(int rho) { const int n = rho >> 4, i = rho & 15; return 8 * (i >> 2) + 4 * n + (i & 3); }

struct Unit { int pm, pn; };
struct Gemm { const bf16_t* A; const bf16_t* Bt; int M, N, K; };

struct StaticOrder {
    int nM, nN, nwg, G, c;
    __host__ __device__ void init(int M, int N, int G_, int c_) { nM = M / BM; nN = N / BM; nwg = nM * nN; G = G_; c = c_; }
    __host__ __device__ bool next(int i, Unit& u) const {
        const long L = (long)i * G + c; if (L >= nwg) return false;
        int wgid = (int)L; { const int q = nwg / NXCD, r = nwg % NXCD, xcd = wgid % NXCD, off = wgid / NXCD; wgid = (xcd < r ? xcd * (q + 1) : r * (q + 1) + (xcd - r) * q) + off; }
        const int nig = WGM * nN, gid = wgid / nig, fm = gid * WGM, gsz = (nM - fm) < WGM ? (nM - fm) : WGM;
        u.pm = fm + ((wgid % nig) % gsz); u.pn = (wgid % nig) / gsz; return true;
    }
    __device__ __forceinline__ void a_ready(const Unit&) const {}
    __device__ __forceinline__ void done(const Unit&) const {}
};

typedef __bf16 nbf16x2 __attribute__((ext_vector_type(2)));
__device__ __forceinline__ unsigned cvt_pk_native(float lo, float hi) { const f32x2 v = {lo, hi}; return __builtin_bit_cast(unsigned, __builtin_convertvector(v, nbf16x2)); }
__device__ __forceinline__ unsigned cvt_pk_bf16(float lo, float hi) { unsigned r; asm volatile("s_nop 0\n\tv_cvt_pk_bf16_f32 %0, %1, %2" : "=v"(r) : "v"(lo), "v"(hi)); return r; }
__device__ __forceinline__ float bf_lo(unsigned w) { return __uint_as_float(w << 16); }
__device__ __forceinline__ float bf_hi(unsigned w) { return __uint_as_float(w & 0xffff0000u); }
__device__ __forceinline__ float fsigmoid(float x) { return __builtin_amdgcn_rcpf(1.0f + __builtin_amdgcn_exp2f(-1.44269504089f * x)); }


#ifndef NT_FROM
#define NT_FROM 7
#endif
struct EpiIn {
    static constexpr bool PERM = true, AFTER_DRAIN = false, IDEM = true; static constexpr int HOOK_T = 0;
    bf16_t* prw; bf16_t* pret; bf16_t* gg;
    __device__ __forceinline__ void operator()(const f32x4 (&acc)[2][2][4][2], const Unit& u, int wr, int wc, int fr, int fq) const {
        const int pn = u.pn; bf16_t* base; int ldc, colt, actk;
        if (pn < 7) { base = prw; ldc = 1792; colt = pn * 256; actk = 0; }
        else if (pn < 19) { base = pret; ldc = 3072; colt = (pn - 7) * 256; actk = (pn - 7 >= 8) ? 2 : 0; }
        else { base = gg; ldc = 2048; colt = (pn - 19) * 256; actk = 1; }
        const int row0 = u.pm * BM + wr * 64 + fr; const int col0 = colt + wc * 32 + 8 * fq;
#pragma unroll
        for (int ai = 0; ai < 2; ++ai)
#pragma unroll
            for (int m = 0; m < 4; ++m) { bf16_t* rowp = base + (size_t)(row0 + ai * HALF + m * 16) * ldc + col0;
#pragma unroll
                for (int bj = 0; bj < 2; ++bj) { f32x4 v0 = acc[ai][bj][m][0], v1 = acc[ai][bj][m][1];
                    if (actk) {
#pragma unroll
                        for (int i = 0; i < 4; ++i) { const float s0 = fsigmoid(v0[i]), s1 = fsigmoid(v1[i]); v0[i] = (actk == 2) ? v0[i] * s0 : s0; v1[i] = (actk == 2) ? v1[i] * s1 : s1; }
                    }
                    u32x4 w; w.x = cvt_pk_bf16(v0[0], v0[1]); w.y = cvt_pk_bf16(v0[2], v0[3]); w.z = cvt_pk_bf16(v1[0], v1[1]); w.w = cvt_pk_bf16(v1[2], v1[3]);
                    if (pn >= NT_FROM) __builtin_nontemporal_store(w, (u32x4*)(rowp + bj * HALF)); else *(u32x4*)(rowp + bj * HALF) = w; } }
    }
};

template <bool ADD> struct EpiGate {
    static constexpr bool PERM = true, AFTER_DRAIN = false, IDEM = false; static constexpr int HOOK_T = 0;
    bf16_t* O; const bf16_t* G; int gcol0;
    __device__ __forceinline__ void operator()(const f32x4 (&acc)[2][2][4][2], const Unit& u, int wr, int wc, int fr, int fq) const {
        const int row0 = u.pm * BM + wr * 64 + fr; const int col0 = u.pn * BM + wc * 32 + 8 * fq;
#pragma unroll
        for (int ai = 0; ai < 2; ++ai)
#pragma unroll
            for (int m = 0; m < 4; ++m) { const size_t row = (size_t)(row0 + ai * HALF + m * 16);
#pragma unroll
                for (int bj = 0; bj < 2; ++bj) { const f32x4 v0 = acc[ai][bj][m][0], v1 = acc[ai][bj][m][1];
                    const u32x4 gw = *(const u32x4*)(G + row * 2048 + gcol0 + col0 + bj * HALF);
                    float o[8];
                    o[0] = v0[0] * bf_lo(gw.x); o[1] = v0[1] * bf_hi(gw.x); o[2] = v0[2] * bf_lo(gw.y); o[3] = v0[3] * bf_hi(gw.y);
                    o[4] = v1[0] * bf_lo(gw.z); o[5] = v1[1] * bf_hi(gw.z); o[6] = v1[2] * bf_lo(gw.w); o[7] = v1[3] * bf_hi(gw.w);
                    bf16_t* op = O + row * 1024 + col0 + bj * HALF;
                    if (ADD) { const u32x4 pw = *(const u32x4*)op;
                        o[0] += bf_lo(pw.x); o[1] += bf_hi(pw.x); o[2] += bf_lo(pw.y); o[3] += bf_hi(pw.y); o[4] += bf_lo(pw.z); o[5] += bf_hi(pw.z); o[6] += bf_lo(pw.w); o[7] += bf_hi(pw.w); }
                    u32x4 w; w.x = cvt_pk_bf16(o[0], o[1]); w.y = cvt_pk_bf16(o[2], o[3]); w.z = cvt_pk_bf16(o[4], o[5]); w.w = cvt_pk_bf16(o[6], o[7]);
                    *(u32x4*)op = w; } }
    }
};

struct EpiMerge {
    static constexpr bool PERM = true, AFTER_DRAIN = false, IDEM = false; static constexpr int HOOK_T = 8;
    bf16_t* O; const bf16_t* G;
    __device__ __forceinline__ void hook(f32x4 (&acc)[2][2][4][2], const Unit& u, int wr, int wc, int fr, int fq) const {
        unsigned goff = (unsigned)((u.pm * BM + wr * 64 + fr) * 2048 + u.pn * BM + wc * 32 + 8 * fq) * 2u;
        asm volatile("" : "+v"(goff));
        const char* gp = (const char*)G;
#pragma unroll
        for (int ai = 0; ai < 2; ++ai)
#pragma unroll
            for (int m = 0; m < 4; ++m) {
#pragma unroll
                for (int bj = 0; bj < 2; ++bj) { const unsigned o = goff + (unsigned)(((ai * HALF + m * 16) * 2048 + bj * HALF) * 2);
                    const u32x4 ga = *(const u32x4*)(gp + o), gb = *(const u32x4*)(gp + o + 2048);
                    float r[8];
                    r[0] = bf_lo(ga.x) * __builtin_amdgcn_rcpf(fmaxf(bf_lo(gb.x), 1e-30f)); r[1] = bf_hi(ga.x) * __builtin_amdgcn_rcpf(fmaxf(bf_hi(gb.x), 1e-30f));
                    r[2] = bf_lo(ga.y) * __builtin_amdgcn_rcpf(fmaxf(bf_lo(gb.y), 1e-30f)); r[3] = bf_hi(ga.y) * __builtin_amdgcn_rcpf(fmaxf(bf_hi(gb.y), 1e-30f));
                    r[4] = bf_lo(ga.z) * __builtin_amdgcn_rcpf(fmaxf(bf_lo(gb.z), 1e-30f)); r[5] = bf_hi(ga.z) * __builtin_amdgcn_rcpf(fmaxf(bf_hi(gb.z), 1e-30f));
                    r[6] = bf_lo(ga.w) * __builtin_amdgcn_rcpf(fmaxf(bf_lo(gb.w), 1e-30f)); r[7] = bf_hi(ga.w) * __builtin_amdgcn_rcpf(fmaxf(bf_hi(gb.w), 1e-30f));
                    acc[ai][bj][m][0] = acc[ai][bj][m][0] * (f32x4){r[0], r[1], r[2], r[3]}; acc[ai][bj][m][1] = acc[ai][bj][m][1] * (f32x4){r[4], r[5], r[6], r[7]}; }
                asm volatile("" ::: "memory"); }
    }
    __device__ __forceinline__ void operator()(const f32x4 (&acc)[2][2][4][2], const Unit& u, int wr, int wc, int fr, int fq) const {
        const int row0 = u.pm * BM + wr * 64 + fr; const int col0 = u.pn * BM + wc * 32 + 8 * fq;
#pragma unroll
        for (int ai = 0; ai < 2; ++ai)
#pragma unroll
            for (int m = 0; m < 4; ++m) { const size_t row = (size_t)(row0 + ai * HALF + m * 16);
#pragma unroll
                for (int bj = 0; bj < 2; ++bj) { const f32x4 v0 = acc[ai][bj][m][0], v1 = acc[ai][bj][m][1];
                    const u32x4 gw = *(const u32x4*)(G + row * 2048 + 1024 + col0 + bj * HALF);
                    u32x4 w; w.x = cvt_pk_bf16(v0[0] * bf_lo(gw.x), v0[1] * bf_hi(gw.x)); w.y = cvt_pk_bf16(v0[2] * bf_lo(gw.y), v0[3] * bf_hi(gw.y));
                    w.z = cvt_pk_bf16(v1[0] * bf_lo(gw.z), v1[1] * bf_hi(gw.z)); w.w = cvt_pk_bf16(v1[2] * bf_lo(gw.w), v1[3] * bf_hi(gw.w));
                    *(u32x4*)(O + row * 1024 + col0 + bj * HALF) = w; } }
    }
};

struct EpiZ {
    static constexpr bool PERM = true, AFTER_DRAIN = false, IDEM = false; static constexpr int HOOK_T = 0;
    bf16_t* O; float* part; bool skip = false;
    __device__ __forceinline__ void operator()(const f32x4 (&acc)[2][2][4][2], const Unit& u, int wr, int wc, int fr, int fq) const {
        const int row0 = u.pm * BM + wr * 64 + fr; const int col0 = u.pn * BM + wc * 32 + 8 * fq;
#pragma unroll
        for (int ai = 0; ai < 2; ++ai)
#pragma unroll
            for (int m = 0; m < 4; ++m) { const size_t row = (size_t)(row0 + ai * HALF + m * 16); float ss = 0.f;
#pragma unroll
                for (int bj = 0; bj < 2; ++bj) { const f32x4 v0 = acc[ai][bj][m][0], v1 = acc[ai][bj][m][1];
                    ss += (v0[0] * v0[0] + v0[1] * v0[1]) + (v0[2] * v0[2] + v0[3] * v0[3]) + (v1[0] * v1[0] + v1[1] * v1[1]) + (v1[2] * v1[2] + v1[3] * v1[3]);
                    u32x4 w; w.x = cvt_pk_bf16(v0[0], v0[1]); w.y = cvt_pk_bf16(v0[2], v0[3]); w.z = cvt_pk_bf16(v1[0], v1[1]); w.w = cvt_pk_bf16(v1[2], v1[3]);
                    if (!skip) *(u32x4*)(O + row * 1024 + col0 + bj * HALF) = w; else asm volatile("" :: "v"(w)); }
                ss += __shfl_xor(ss, 16); ss += __shfl_xor(ss, 32);
                if (fq == 0 && !skip) part[row * 16 + u.pn * 4 + wc] = ss; }
    }
};

template <int CTRL> __device__ __forceinline__ float dpp0(float x) {
    return __builtin_bit_cast(float, __builtin_amdgcn_update_dpp(0, __builtin_bit_cast(int, x), CTRL, 0xf, 0xf, true));
}
__device__ __forceinline__ float gelu_tanh(float x) {
    const float in = x * (1.0f + 0.044715f * x * x);
    return x * __builtin_amdgcn_rcpf(1.0f + __builtin_amdgcn_exp2f(-2.302208198f * in));
}

struct EpiConv {
    static constexpr bool PERM = true, AFTER_DRAIN = false, IDEM = false; static constexpr int HOOK_T = 0;
    bf16_t* act; const float* cw; const float* cb; float* halo; PG8_LAS float* xch;
    __device__ __forceinline__ void operator()(const f32x4 (&acc)[2][2][4][2], const Unit& u, int wr, int wc, int fr, int fq) const {
        PG8_LAS f32x4* X = (PG8_LAS f32x4*)xch;
        if (fr >= 14) {
#pragma unroll
            for (int ai = 0; ai < 2; ++ai)
#pragma unroll
                for (int bj = 0; bj < 2; ++bj)
#pragma unroll
                    for (int n = 0; n < 2; ++n) X[(((((ai * 2 + wr) * 4 + wc) * 2 + (fr - 14)) * 2 + bj) * 2 + n) * 4 + fq] = acc[ai][bj][3][n];
        }
        {
            const int tcol = u.pn * 256 + wc * 32 + 8 * fq;
            if (wr == 0 && fr < 2) {
#pragma unroll
                for (int bj = 0; bj < 2; ++bj)
#pragma unroll
                    for (int n = 0; n < 2; ++n) *(f32x4*)(halo + ((size_t)(u.pm * 4 + fr)) * 5632 + tcol + bj * HALF + 4 * n) = acc[0][bj][0][n];
            }
            if (wr == 1 && fr >= 14) {
#pragma unroll
                for (int bj = 0; bj < 2; ++bj)
#pragma unroll
                    for (int n = 0; n < 2; ++n) *(f32x4*)(halo + ((size_t)(u.pm * 4 + 2 + (fr - 14))) * 5632 + tcol + bj * HALF + 4 * n) = acc[1][bj][3][n];
            }
        }
        asm volatile("s_waitcnt lgkmcnt(0)" ::: "memory"); __builtin_amdgcn_s_barrier(); asm volatile("" ::: "memory");
        const int j0 = u.pn * 128 + wc * 32 + 8 * fq;
        const float m0 = (fr == 0) ? 1.f : 0.f, m01 = (fr < 2) ? 1.f : 0.f;
        const bool first_tile = (u.pm & 7) == 0; (void)first_tile;
#pragma unroll
        for (int ai = 0; ai < 2; ++ai) {
            f32x4 xb[2][2];
#pragma unroll
            for (int bj = 0; bj < 2; ++bj)
#pragma unroll
                for (int n = 0; n < 2; ++n) xb[bj][n] = (f32x4){0.f, 0.f, 0.f, 0.f};
            if (!(ai == 0 && wr == 0) && fr >= 14) {
                const int sai = (wr == 1) ? ai : ai - 1, swr = (wr == 1) ? 0 : 1;
#pragma unroll
                for (int bj = 0; bj < 2; ++bj)
#pragma unroll
                    for (int n = 0; n < 2; ++n) xb[bj][n] = X[(((((sai * 2 + swr) * 4 + wc) * 2 + (fr - 14)) * 2 + bj) * 2 + n) * 4 + fq];
            }
            unsigned pk[4][4];
#pragma unroll
            for (int n = 0; n < 2; ++n) {
                const int jc = j0 + 4 * n;
                const f32x4 g0 = *(const f32x4*)(cw + jc), g1 = *(const f32x4*)(cw + 5632 + jc), g2 = *(const f32x4*)(cw + 2 * 5632 + jc), gb = *(const f32x4*)(cb + jc);
                const f32x4 v0 = *(const f32x4*)(cw + 2816 + jc), v1 = *(const f32x4*)(cw + 5632 + 2816 + jc), v2 = *(const f32x4*)(cw + 2 * 5632 + 2816 + jc), vb = *(const f32x4*)(cb + 2816 + jc);
#pragma unroll
                for (int i = 0; i < 4; ++i) {
                    const float g1m = g1[i] * m0, g0m = g0[i] * m01, v1m = v1[i] * m0, v0m = v0[i] * m01;
                    float og[4], ov[4];
#pragma unroll
                    for (int m = 0; m < 4; ++m) {
                        const float xg = acc[ai][0][m][n][i], xv = acc[ai][1][m][n][i];
                        const float pg = (m == 0) ? xb[0][n][i] : acc[ai][0][m - 1][n][i], pv = (m == 0) ? xb[1][n][i] : acc[ai][1][m - 1][n][i];
                        float a = gb[i] + g2[i] * xg; a += g1[i] * dpp0<0x111>(xg); a += g0[i] * dpp0<0x112>(xg); a += g1m * dpp0<0x121>(pg); a += g0m * dpp0<0x122>(pg);
                        float b = vb[i] + v2[i] * xv; b += v1[i] * dpp0<0x111>(xv); b += v0[i] * dpp0<0x112>(xv); b += v1m * dpp0<0x121>(pv); b += v0m * dpp0<0x122>(pv);
                        og[m] = a; ov[m] = b;
                    }
#pragma unroll
                    for (int m = 0; m < 4; ++m) og[m] = gelu_tanh(og[m]) * ov[m];
                    if (i & 1) {
#pragma unroll
                        for (int m = 0; m < 4; ++m) pk[m][n * 2 + (i >> 1)] = cvt_pk_bf16(__uint_as_float(pk[m][n * 2 + (i >> 1)]), og[m]);
                    } else {
#pragma unroll
                        for (int m = 0; m < 4; ++m) pk[m][n * 2 + (i >> 1)] = __float_as_uint(og[m]);
                    }
                }
            }
#pragma unroll
            for (int m = 0; m < 4; ++m) {
                u32x4 w; w.x = pk[m][0]; w.y = pk[m][1]; w.z = pk[m][2]; w.w = pk[m][3];
                *(u32x4*)(act + (size_t)(u.pm * BM + ai * HALF + wr * 64 + m * 16 + fr) * 2816 + j0) = w;
            }
        }
    }
};

#ifndef STAGGER_PCT
#define STAGGER_PCT 100
#endif
template <class Epi, class Sched, bool ALIGN_EPI = false, bool SP2 = false>
__device__ __forceinline__ void gemm_phase(PG8_LAS unsigned char* lds, const Gemm g, const Sched& S, const Epi& E, const int stagger_ticks = 0) {
    if (stagger_ticks > 0) {
        const unsigned long long target = __builtin_amdgcn_s_memrealtime() + (unsigned long long)((stagger_ticks * STAGGER_PCT / 100) * (int)((blockIdx.x >> 3) & 7));
        while (__builtin_amdgcn_s_memrealtime() < target) __builtin_amdgcn_s_sleep(8);
    }
    const int tid = threadIdx.x, wid = __builtin_amdgcn_readfirstlane(tid >> 6), lane = tid & 63, wr = wid >> 2, wc = wid & 3, fr = lane & 15, fq = lane >> 4;
    const int K = g.K, nt = K / BK;
    unsigned voffA[2], voffB[2];
#pragma unroll
    for (int i = 0; i < 2; ++i) { int R, C; stage_rc(tid * 16 + i * 8192, R, C); const int Rb = Epi::PERM ? ((R & ~31) + perm32(R & 31)) : R;
        voffA[i] = (unsigned)(R * K + C) * 2u; voffB[i] = (unsigned)(Rb * K + C) * 2u; }
    const size_t kstep = (size_t)(BK * 2);
    const size_t hstep = (size_t)HALF * K * 2;
    const size_t tstep = 2 * hstep;
    const unsigned ldsw = (unsigned)wid * 1024u;
    const int aoff = lds_byte(wr * 64 + fr, fq * 8), boff = lds_byte(wc * 32 + fr, fq * 8);
#define PG8_SA(b, h) (((b) * 2 + (h)) * HTB)
#define PG8_SB(b, h) ((4 + (b) * 2 + (h)) * HTB)
#define PG8_STAGE(bufoff, gbase, voff) do { _Pragma("unroll") for (int _i = 0; _i < 2; ++_i) \
        __builtin_amdgcn_global_load_lds((const unsigned*)((const char*)(gbase) + (voff)[_i]), (PG8_LAS unsigned*)(lds + (bufoff) + ldsw + _i * 8192), 16, 0, 0); } while (0)
#define PG8_LDA(dst, b, h) do { _Pragma("unroll") for (int m = 0; m < 4; ++m) _Pragma("unroll") for (int k = 0; k < 2; ++k) dst[m][k] = *(const PG8_LAS bf16x8*)(lds + PG8_SA(b, h) + aoff + m * 2048 + k * 1024); } while (0)
#define PG8_LDB(dst, b, h) do { _Pragma("unroll") for (int n = 0; n < 2; ++n) _Pragma("unroll") for (int k = 0; k < 2; ++k) dst[n][k] = *(const PG8_LAS bf16x8*)(lds + PG8_SB(b, h) + boff + n * 2048 + k * 1024); } while (0)
#define PG8_MMA(ai, bj, At, Bt) do { __builtin_amdgcn_s_setprio(1); _Pragma("unroll") for (int m = 0; m < 4; ++m) _Pragma("unroll") for (int n = 0; n < 2; ++n) _Pragma("unroll") for (int k = 0; k < 2; ++k) \
        acc[ai][bj][m][n] = __builtin_amdgcn_mfma_f32_16x16x32_bf16(Bt[n][k], At[m][k], acc[ai][bj][m][n], 0, 0, 0); __builtin_amdgcn_s_setprio(0); } while (0)
#define PG8_WAIT_V(n) asm volatile("s_waitcnt vmcnt(" #n ")" ::: "memory")
#define PG8_WAIT_L(n) asm volatile("s_waitcnt lgkmcnt(" #n ")" ::: "memory")
#define PG8_BAR __builtin_amdgcn_s_barrier()
#define PG8_SCHED __builtin_amdgcn_sched_barrier(0)
    Unit cur, nxt; int ui = 0;
    if (!S.next(0, cur)) return;
    f32x4 acc[2][2][4][2];
#pragma unroll
    for (int a = 0; a < 2; ++a)
#pragma unroll
        for (int b = 0; b < 2; ++b)
#pragma unroll
            for (int m = 0; m < 4; ++m)
#pragma unroll
                for (int n = 0; n < 2; ++n) acc[a][b][m][n] = (f32x4){0.f, 0.f, 0.f, 0.f};
    bf16x8 At[4][2], B0[2][2], B1[2][2];
    const char* cA = (const char*)g.A + (size_t)cur.pm * tstep; const char* cB = (const char*)g.Bt + (size_t)cur.pn * tstep;
    S.a_ready(cur);
    if constexpr (SP2) {
        PG8_STAGE(PG8_SB(0, 0), cB, voffB); PG8_STAGE(PG8_SB(0, 1), cB + hstep, voffB); PG8_STAGE(PG8_SA(0, 0), cA, voffA); PG8_STAGE(PG8_SA(0, 1), cA + hstep, voffA);
        if (wr == 1) PG8_BAR;
        PG8_WAIT_V(2); PG8_BAR;
        PG8_STAGE(PG8_SB(1, 0), cB + kstep, voffB); PG8_STAGE(PG8_SA(1, 0), cA + kstep, voffA); PG8_STAGE(PG8_SB(1, 1), cB + hstep + kstep, voffB);
        PG8_WAIT_V(6); PG8_BAR;
    } else {
        PG8_STAGE(PG8_SB(0, 0), cB, voffB); PG8_STAGE(PG8_SA(0, 0), cA, voffA); PG8_STAGE(PG8_SB(0, 1), cB + hstep, voffB); PG8_STAGE(PG8_SA(0, 1), cA + hstep, voffA);
        if (wr == 1) PG8_BAR;
        PG8_WAIT_V(4); PG8_BAR;
        PG8_STAGE(PG8_SB(1, 0), cB + kstep, voffB); PG8_STAGE(PG8_SA(1, 0), cA + kstep, voffA); PG8_STAGE(PG8_SB(1, 1), cB + hstep + kstep, voffB);
        PG8_WAIT_V(6); PG8_BAR;
    }
    for (;;) {
        const bool has_next = S.next(ui + 1, nxt);
        const char* nA = has_next ? (const char*)g.A + (size_t)nxt.pm * tstep : cA; const char* nB = has_next ? (const char*)g.Bt + (size_t)nxt.pn * tstep : cB;
        for (int t = 0; t < nt; t += 2) {
            const bool last = (t == nt - 2);
            const char* a1 = cA + (size_t)(t + 1) * kstep;
            const char* a2 = last ? nA : cA + (size_t)(t + 2) * kstep; const char* b2 = last ? nB : cB + (size_t)(t + 2) * kstep;
            const char* a3 = a2 + kstep; const char* b3 = b2 + kstep;
            if (last && has_next) S.a_ready(nxt);
            if constexpr (Epi::HOOK_T > 0) { if (t == Epi::HOOK_T) E.hook(acc, cur, wr, wc, fr, fq); }
            if constexpr (SP2) {
            PG8_LDB(B0, 0, 0); PG8_LDB(B1, 0, 1); PG8_SCHED; PG8_LDA(At, 0, 0); PG8_STAGE(PG8_SA(1, 1), a1 + hstep, voffA);
            PG8_WAIT_V(8); PG8_WAIT_L(0); PG8_BAR; PG8_MMA(0, 0, At, B0); PG8_MMA(0, 1, At, B1); PG8_BAR; PG8_SCHED;
            PG8_LDA(At, 0, 1); PG8_STAGE(PG8_SB(0, 0), b2, voffB); PG8_STAGE(PG8_SB(0, 1), b2 + hstep, voffB); PG8_STAGE(PG8_SA(0, 0), a2, voffA);
            PG8_WAIT_V(8); PG8_WAIT_L(0); PG8_BAR; PG8_MMA(1, 0, At, B0); PG8_MMA(1, 1, At, B1); PG8_BAR; PG8_SCHED;
            PG8_LDB(B0, 1, 0); PG8_LDB(B1, 1, 1); PG8_SCHED; PG8_LDA(At, 1, 0); PG8_STAGE(PG8_SA(0, 1), a2 + hstep, voffA);
            PG8_WAIT_V(8); PG8_WAIT_L(0); PG8_BAR; PG8_MMA(0, 0, At, B0); PG8_MMA(0, 1, At, B1); PG8_BAR; PG8_SCHED;
            PG8_LDA(At, 1, 1); PG8_STAGE(PG8_SB(1, 0), b3, voffB); PG8_STAGE(PG8_SB(1, 1), b3 + hstep, voffB); PG8_STAGE(PG8_SA(1, 0), a3, voffA);
            PG8_WAIT_V(8); PG8_WAIT_L(0); PG8_BAR; PG8_MMA(1, 0, At, B0); PG8_MMA(1, 1, At, B1); PG8_BAR; PG8_SCHED;
            } else {
            PG8_LDB(B0, 0, 0); PG8_SCHED; PG8_LDA(At, 0, 0); PG8_STAGE(PG8_SA(1, 1), a1 + hstep, voffA);
            PG8_WAIT_L(8); PG8_BAR; PG8_WAIT_L(0); PG8_MMA(0, 0, At, B0); PG8_BAR; PG8_SCHED;
            PG8_LDB(B1, 0, 1); PG8_STAGE(PG8_SB(0, 0), b2, voffB);
            PG8_BAR; PG8_WAIT_L(0); PG8_MMA(0, 1, At, B1); PG8_BAR;
            PG8_LDA(At, 0, 1); PG8_STAGE(PG8_SA(0, 0), a2, voffA);
            PG8_BAR; PG8_WAIT_L(0); PG8_MMA(1, 0, At, B0); PG8_BAR; PG8_SCHED;
            PG8_STAGE(PG8_SB(0, 1), b2 + hstep, voffB);
            PG8_WAIT_V(6); PG8_BAR; PG8_MMA(1, 1, At, B1); PG8_BAR;
            PG8_LDB(B0, 1, 0); PG8_SCHED; PG8_LDA(At, 1, 0); PG8_STAGE(PG8_SA(0, 1), a2 + hstep, voffA);
            PG8_WAIT_L(8); PG8_BAR; PG8_WAIT_L(0); PG8_MMA(0, 0, At, B0); PG8_BAR; PG8_SCHED;
            PG8_LDB(B1, 1, 1); PG8_STAGE(PG8_SB(1, 0), b3, voffB);
            PG8_BAR; PG8_WAIT_L(0); PG8_MMA(0, 1, At, B1); PG8_BAR;
            PG8_LDA(At, 1, 1); PG8_STAGE(PG8_SA(1, 0), a3, voffA);
            PG8_BAR; PG8_WAIT_L(0); PG8_MMA(1, 0, At, B0); PG8_BAR; PG8_SCHED;
            PG8_STAGE(PG8_SB(1, 1), b3 + hstep, voffB);
            PG8_WAIT_V(6); PG8_BAR; PG8_MMA(1, 1, At, B1); PG8_BAR;
            }
        }
        if constexpr (ALIGN_EPI) { if (wr == 0) PG8_BAR; }
        if constexpr (!Epi::AFTER_DRAIN) { E(acc, cur, wr, wc, fr, fq); if constexpr (Epi::IDEM && PROBE_PH == 300) E(acc, cur, wr, wc, fr, fq); S.done(cur); }
        if (!has_next) break;
#pragma unroll
        for (int a = 0; a < 2; ++a)
#pragma unroll
            for (int b = 0; b < 2; ++b)
#pragma unroll
                for (int m = 0; m < 4; ++m)
#pragma unroll
                    for (int n = 0; n < 2; ++n) acc[a][b][m][n] = (f32x4){0.f, 0.f, 0.f, 0.f};
        cur = nxt; cA = nA; cB = nB; ++ui;
        if constexpr (ALIGN_EPI) { if (wr == 1) PG8_BAR; }
    }
    PG8_WAIT_V(0);
    if constexpr (!ALIGN_EPI) { if (wr == 0) PG8_BAR; }
    PG8_BAR;
#undef PG8_SA
#undef PG8_SB
#undef PG8_STAGE
#undef PG8_LDA
#undef PG8_LDB
#undef PG8_MMA
#undef PG8_WAIT_V
#undef PG8_WAIT_L
#undef PG8_BAR
#undef PG8_SCHED
}
}

constexpr int NWAVES = 8;
constexpr int BATCH = 32, T = 2048, D = 1024, M = BATCH * T;
constexpr int RWH = 8, RWN = 64, RWW = 512, RW_COLS = 1792;
constexpr int RTH = 8, RDK = 64, RDV = 128, RET_COLS = 3072, RCH = 128;
constexpr int IN_COLS = 6912, DFF = 2816;
constexpr float RMS_EPS = 1e-6f, RW_GN_EPS = 64e-5f, RET_GN_EPS = 1e-5f;
constexpr int N_PHASES = 10;

constexpr size_t MiB = 1u << 20;
constexpr size_t WS_CTL = 0, CTL_ZERO_BYTES = 1 * MiB;
constexpr size_t WS_WIN = 2 * MiB, WS_WRW = 16 * MiB, WS_WRET = 17 * MiB, WS_WOUT = 19 * MiB, WS_WUP = 21 * MiB, WS_WDN = 32 * MiB;
constexpr size_t WS_ROPE = 38 * MiB, WS_PART = 54 * MiB, WS_PART2 = 58 * MiB, WS_HALO = 62 * MiB, WS_RWW = 84 * MiB;
constexpr size_t WS_PRW = 88 * MiB, WS_PRET = 312 * MiB, WS_G = 696 * MiB, WS_END = 952 * MiB;
constexpr size_t WS_MERGED = WS_PRW, WS_Z = WS_PRET, WS_XN2 = WS_G, WS_H1 = WS_G + 128 * MiB, WS_ACT = WS_PRET, WS_F = WS_PRW;
static_assert(WS_WIN + (size_t)IN_COLS * D * 2 <= WS_WRW && WS_WUP + (size_t)2 * DFF * D * 2 <= WS_WDN && WS_WDN + (size_t)D * DFF * 2 <= WS_ROPE, "ws map: weights");
static_assert(WS_ROPE + (size_t)M * 32 * 8 <= WS_PART && WS_HALO + (size_t)256 * 4 * 5632 * 4 <= WS_RWW && WS_RWW + 4 * MiB <= WS_PRW, "ws map: tables");
static_assert(WS_PRW + (size_t)M * RW_COLS * 2 <= WS_PRET && WS_PRET + (size_t)M * RET_COLS * 2 <= WS_G && WS_G + (size_t)M * 2048 * 2 <= WS_END, "ws map: activations");
static_assert(WS_ACT + (size_t)M * DFF * 2 <= WS_G, "ws map: act");
constexpr int CW_BAR = 4096;
constexpr size_t OUT_XN = 0, OUT_Y = 0;
constexpr int LDY = 1536;

constexpr int RING_OFF = 0, RING_BYTES = 131072;
constexpr int XCH_OFF = RING_BYTES, XCH_BYTES = 16384;
constexpr int LDSCTL_OFF = 160 * 1024 - 512, MISC_OFF = LDSCTL_OFF + 320;
constexpr int LDS_BYTES = 160 * 1024;
static_assert(MISC_OFF + 128 <= LDS_BYTES, "LDS map");

#define GAS __attribute__((address_space(1)))
#define LAS __attribute__((address_space(3)))
typedef unsigned short bf16;
typedef unsigned v4u __attribute__((ext_vector_type(4)));
typedef unsigned v2u __attribute__((ext_vector_type(2)));
typedef float f32x4 __attribute__((ext_vector_type(4)));
typedef float f32x2 __attribute__((ext_vector_type(2)));
typedef short bf16x8 __attribute__((ext_vector_type(8)));
typedef GAS unsigned gu32;
#define RLX_AGENT __ATOMIC_RELAXED, __HIP_MEMORY_SCOPE_AGENT
#define LDS_WAIT() asm volatile("s_waitcnt lgkmcnt(0)" ::: "memory")
#define VM_WAIT() asm volatile("s_waitcnt vmcnt(0)" ::: "memory")
__device__ __forceinline__ unsigned f2bf(float f) { unsigned u = __builtin_bit_cast(unsigned, f); return (u + 0x7fffu + ((u >> 16) & 1u)) >> 16; }
__device__ __forceinline__ unsigned pk2(float lo, float hi) { return pg8::cvt_pk_native(lo, hi); }
__device__ __forceinline__ float bflo(unsigned w) { return __uint_as_float(w << 16); }
__device__ __forceinline__ float bfhi(unsigned w) { return __uint_as_float(w & 0xffff0000u); }
__device__ __forceinline__ float bf1(bf16 v) { return __uint_as_float((unsigned)v << 16); }

#define XB_TMO      128
#define XB_XCNT(j)  (256  + 64 * (j))
#define XB_XSUB(j)  (1280 + 64 * (j))
#define XB_XGEN(j)  (2304 + 64 * (j))
#define XB_TOP      3328
#define XB_TOPGEN   3392
#define XCD_BAR_WORDS 3456
#define XB_SPIN_CAP (1u << 20)

__device__ __forceinline__ unsigned xb_ld(unsigned* p)              { return __hip_atomic_load(p, __ATOMIC_RELAXED, __HIP_MEMORY_SCOPE_AGENT); }
__device__ __forceinline__ unsigned xb_add(unsigned* p, unsigned v) { return __hip_atomic_fetch_add(p, v, __ATOMIC_RELAXED, __HIP_MEMORY_SCOPE_AGENT); }
__device__ __forceinline__ unsigned xb_xcc_id() { return (unsigned)__builtin_amdgcn_s_getreg((3 << 11) | 20) & 0xFu; }
#define XB_SPIN(cond, bar) do { unsigned _sp = 0; while (cond) { __builtin_amdgcn_s_sleep(1); \
    if ((++_sp & 255u) == 0u) { if (xb_ld(&(bar)[XB_TMO])) break; if (_sp > XB_SPIN_CAP) { atomicAdd(&(bar)[XB_TMO], 1u); break; } } } } while (0)

struct XcdBarrier { unsigned* bar; unsigned x; volatile LAS unsigned* st; };

__device__ __forceinline__ XcdBarrier xcd_barrier_post(unsigned* bar, volatile LAS unsigned* st) {
    XcdBarrier b; b.bar = bar; b.x = xb_xcc_id(); b.st = st;
    if (threadIdx.x == 0) (void)xb_add(&bar[XB_XCNT(b.x)], 1u);
    return b;
}
__device__ __forceinline__ void xcd_barrier_complete(unsigned* bar, unsigned x, unsigned& nloc, unsigned& nx) {
    const unsigned G = gridDim.x * gridDim.y * gridDim.z;
    unsigned sum, cnt, mine, sp = 0u;
    for (;;) {
        sum = 0u; cnt = 0u; mine = 0u;
#pragma unroll
        for (unsigned j = 0; j < 16; ++j) { const unsigned c = xb_ld(&bar[XB_XCNT(j)]); sum += c; cnt += (c > 0u) ? 1u : 0u; mine = (j == x) ? c : mine; }
        if (sum == G) break;
        __builtin_amdgcn_s_sleep(1);
        if ((++sp & 255u) == 0u) { if (xb_ld(&bar[XB_TMO])) break; if (sp > XB_SPIN_CAP) { atomicAdd(&bar[XB_TMO], 1u); break; } }
    }
    nloc = mine > 0u ? mine : 1u; nx = cnt > 0u ? cnt : 1u;
}
__device__ __forceinline__ void xcd_barrier(const XcdBarrier& b) {
    asm volatile("s_waitcnt vmcnt(0)" ::: "memory");
    __syncthreads();
    if (threadIdx.x == 0) {
        unsigned* bar = b.bar;
        __builtin_amdgcn_s_waitcnt(0);
        unsigned nloc = b.st[0], nx = b.st[1];
        if (nloc == 0u) { xcd_barrier_complete(bar, b.x, nloc, nx); b.st[0] = nloc; b.st[1] = nx; }
        const unsigned old = xb_add(&bar[XB_XSUB(b.x)], 1u);
        const unsigned gen = old / nloc;
        if (old + 1u == (gen + 1u) * nloc) {
            __builtin_amdgcn_fence(__ATOMIC_RELEASE, "agent");
            asm volatile("s_waitcnt vmcnt(0)" ::: "memory");
            const unsigned og = xb_add(&bar[XB_TOP], 1u);
            const unsigned tg = og / nx;
            if (og + 1u == (tg + 1u) * nx) xb_add(&bar[XB_TOPGEN], 1u);
            else XB_SPIN(xb_ld(&bar[XB_TOPGEN]) == tg, bar);
            __builtin_amdgcn_fence(__ATOMIC_ACQUIRE, "agent");
            xb_add(&bar[XB_XGEN(b.x)], 1u);
            asm volatile("s_waitcnt vmcnt(0)" ::: "memory");
        } else {
            XB_SPIN(xb_ld(&bar[XB_XGEN(b.x)]) == gen, bar);
            __builtin_amdgcn_fence(__ATOMIC_ACQUIRE, "agent");
            asm volatile("s_waitcnt vmcnt(0)" ::: "memory");
        }
    }
    __syncthreads();
}

struct Frame {
    LAS unsigned char* lds;
    volatile LAS unsigned* MISC;
    gu32* ctl;
    int tid, wave;
    int vcu, G;
    const float* in[25]; float* out; unsigned char* ws;
};

template <int CTRL> __device__ __forceinline__ float dppx(float x) {
    return __builtin_bit_cast(float, __builtin_amdgcn_mov_dpp(__builtin_bit_cast(int, x), CTRL, 0xf, 0xf, true));
}
#define DPP_GUARD1(a) asm volatile("s_nop 4" : "+v"(a))
#define DPP_GUARD4(a, b, c, d) asm volatile("s_nop 4" : "+v"(a), "+v"(b), "+v"(c), "+v"(d))
template <int CTRL> __device__ __forceinline__ float dpp_add(float v) { DPP_GUARD1(v); return v + dppx<CTRL>(v); }
__device__ __forceinline__ float row16_sum(float v) {
    v = dpp_add<0xB1>(v); v = dpp_add<0x4E>(v); v = dpp_add<0x141>(v); v = dpp_add<0x128>(v); return v;
}
template <int CTRL> __device__ __forceinline__ void dpp_add4(float (&v)[4]) {
    DPP_GUARD4(v[0], v[1], v[2], v[3]);
    const float t0 = dppx<CTRL>(v[0]), t1 = dppx<CTRL>(v[1]), t2 = dppx<CTRL>(v[2]), t3 = dppx<CTRL>(v[3]);
    v[0] += t0; v[1] += t1; v[2] += t2; v[3] += t3;
}
#define DPP_STEP2(ctrl) "v_add_f32_dpp %0, %0, %0 " ctrl " row_mask:0xf bank_mask:0xf bound_ctrl:1\n\tv_add_f32_dpp %1, %1, %1 " ctrl " row_mask:0xf bank_mask:0xf bound_ctrl:1\n\t"
#define DPP_CHAIN2(a, b, steps) asm volatile("s_nop 1\n\t" steps : "+v"(a), "+v"(b))
__device__ __forceinline__ void row16_sum4(float (&v)[4]) { dpp_add4<0xB1>(v); dpp_add4<0x4E>(v); dpp_add4<0x141>(v); dpp_add4<0x128>(v); }
__device__ __forceinline__ float wave_sum(float v) {
    v = row16_sum(v);
    const float s0 = __builtin_bit_cast(float, __builtin_amdgcn_readlane(__builtin_bit_cast(int, v), 0)), s1 = __builtin_bit_cast(float, __builtin_amdgcn_readlane(__builtin_bit_cast(int, v), 16));
    const float s2 = __builtin_bit_cast(float, __builtin_amdgcn_readlane(__builtin_bit_cast(int, v), 32)), s3 = __builtin_bit_cast(float, __builtin_amdgcn_readlane(__builtin_bit_cast(int, v), 48));
    return (s0 + s1) + (s2 + s3);
}

__device__ __forceinline__ void p0_transpose_item(const float* W, int N, bf16* WT, int ldw, int k0, int n0, int drow0, const float* kscale, LAS float* scr, int lane) {
    {
        const int kr = lane >> 3, c4 = 4 * (lane & 7);
        f32x4 v[8];
#pragma unroll
        for (int i = 0; i < 8; ++i) v[i] = __builtin_nontemporal_load((const f32x4*)(W + (size_t)(k0 + kr + 8 * i) * N + n0 + c4));
#pragma unroll
        for (int i = 0; i < 8; ++i) { const int kk = kr + 8 * i; f32x4 t = v[i]; if (kscale) t = t * kscale[k0 + kk];
            LAS float* d = scr + kk * 33 + c4; d[0] = t.x; d[1] = t.y; d[2] = t.z; d[3] = t.w; }
    }
    LDS_WAIT(); asm volatile("" ::: "memory");
    const int c = lane & 7;
#pragma unroll
    for (int j = 0; j < 4; ++j) { const int n = (lane >> 3) + 8 * j; const LAS float* s = scr + (8 * c) * 33 + n;
        v4u o; o.x = pk2(s[0 * 33], s[1 * 33]); o.y = pk2(s[2 * 33], s[3 * 33]); o.z = pk2(s[4 * 33], s[5 * 33]); o.w = pk2(s[6 * 33], s[7 * 33]);
        *(GAS v4u*)(WT + (size_t)(drow0 + n) * ldw + k0 + 8 * c) = o; }
    LDS_WAIT(); asm volatile("" ::: "memory");
}
__device__ __forceinline__ void p0_prologue(Frame& F) {
    LAS float* scr = (LAS float*)(F.lds + RING_OFF + F.wave * 16384);
    const int gw = F.vcu * NWAVES + F.wave, NGW = F.G * NWAVES;
    unsigned char* ws = F.ws;
    constexpr int I_IN = (D / 64) * (IN_COLS / 32), I_RW = (RWW / 64) * (D / 32), I_RET = (D / 64) * (D / 32), I_OUT = I_RET, I_UP = (D / 64) * (2 * DFF / 32), I_DN = (DFF / 64) * (D / 32);
    constexpr int I_W2 = (64 / 64) * (RWW / 32), I_G2 = (128 / 64) * (RWW / 32);
    constexpr int NITEMS = I_IN + I_RW + I_RET + I_OUT + I_UP + I_DN + 2 * I_W2 + I_G2;
    for (int it = gw; it < NITEMS; it += NGW) {
        int r = it;
        if (r < I_IN) { const int nb = IN_COLS / 32, kb = r / nb, n0 = 32 * (r % nb); p0_transpose_item(F.in[6], IN_COLS, (bf16*)(ws + WS_WIN), D, 64 * kb, n0, n0, F.in[2], scr, ((int)(threadIdx.x & 63))); continue; } r -= I_IN;
        if (r < I_RW) { const int nb = D / 32, kb = r / nb, n0 = 32 * (r % nb); p0_transpose_item(F.in[18], D, (bf16*)(ws + WS_WRW), RWW + D, 64 * kb, n0, n0, nullptr, scr, ((int)(threadIdx.x & 63))); continue; } r -= I_RW;
        if (r < I_RET) { const int nb = D / 32, kb = r / nb, n0 = 32 * (r % nb); p0_transpose_item(F.in[19], D, (bf16*)(ws + WS_WRW) + RWW, RWW + D, 64 * kb, n0, n0, nullptr, scr, ((int)(threadIdx.x & 63))); continue; } r -= I_RET;
        if (r < I_OUT) { const int nb = D / 32, kb = r / nb, n0 = 32 * (r % nb); p0_transpose_item(F.in[20], D, (bf16*)(ws + WS_WOUT), D, 64 * kb, n0, n0, nullptr, scr, ((int)(threadIdx.x & 63))); continue; } r -= I_OUT;
        if (r < I_UP) { const int nb = 2 * DFF / 32, kb = r / nb, n0 = 32 * (r % nb);
            const int j = (n0 < DFF) ? n0 : n0 - DFF, drow = (j / 128) * 256 + (j % 128) + ((n0 < DFF) ? 0 : 128);
            p0_transpose_item(F.in[21], 2 * DFF, (bf16*)(ws + WS_WUP), D, 64 * kb, n0, drow, F.in[4], scr, ((int)(threadIdx.x & 63))); continue; } r -= I_UP;
        if (r < I_DN) { const int nb = D / 32, kb = r / nb, n0 = 32 * (r % nb); p0_transpose_item(F.in[24], D, (bf16*)(ws + WS_WDN), DFF, 64 * kb, n0, n0, nullptr, scr, ((int)(threadIdx.x & 63))); continue; } r -= I_DN;
        if (r < I_W2) { const int n0 = 32 * r; p0_transpose_item(F.in[9], RWW, (bf16*)(ws + WS_RWW), 64, 0, n0, n0, nullptr, scr, ((int)(threadIdx.x & 63))); continue; } r -= I_W2;
        if (r < I_W2) { const int n0 = 32 * r; p0_transpose_item(F.in[11], RWW, (bf16*)(ws + WS_RWW + 65536), 64, 0, n0, n0, nullptr, scr, ((int)(threadIdx.x & 63))); continue; } r -= I_W2;
        { const int nb = RWW / 32, kb = r / nb, n0 = 32 * (r % nb); p0_transpose_item(F.in[12], RWW, (bf16*)(ws + WS_RWW + 131072), 128, 64 * kb, n0, n0, nullptr, scr, ((int)(threadIdx.x & 63))); }
    }
    const float* x = F.in[0]; bf16* XN = (bf16*)((unsigned char*)F.out + OUT_XN);
    {
        constexpr int PD = 2;
        f32x4 buf[PD][4];
        const int lane = ((int)(threadIdx.x & 63));
#pragma unroll
        for (int k = 0; k < PD; ++k) { const int mm = min(gw + k * NGW, M - 1); const GAS f32x4* xr = (const GAS f32x4*)(x + (size_t)mm * D) + lane;
#pragma unroll
            for (int j = 0; j < 4; ++j) buf[k][j] = __builtin_nontemporal_load(&xr[64 * j]); }
        int m0 = gw;
        for (; m0 + (PD - 1) * NGW < M; m0 += PD * NGW) {
#pragma unroll
            for (int k = 0; k < PD; ++k) { const int m = m0 + k * NGW;
                f32x4 v[4]; float s = 0.f;
#pragma unroll
                for (int j = 0; j < 4; ++j) v[j] = buf[k][j];
                { const int mn = min(m + PD * NGW, M - 1); const GAS f32x4* xr = (const GAS f32x4*)(x + (size_t)mn * D) + lane;
#pragma unroll
                    for (int j = 0; j < 4; ++j) buf[k][j] = __builtin_nontemporal_load(&xr[64 * j]); }
#pragma unroll
                for (int j = 0; j < 4; ++j) s += (v[j].x * v[j].x + v[j].y * v[j].y) + (v[j].z * v[j].z + v[j].w * v[j].w);
                const float rstd = __builtin_amdgcn_rsqf(wave_sum(s) * (1.f / D) + RMS_EPS);
                GAS v2u* o8 = (GAS v2u*)(XN + (size_t)m * D) + lane;
#pragma unroll
                for (int j = 0; j < 4; ++j) { v2u o; o.x = pk2(v[j].x * rstd, v[j].y * rstd); o.y = pk2(v[j].z * rstd, v[j].w * rstd); o8[64 * j] = o; }
            }
        }
        for (int m = m0; m < M; m += NGW) {
            const GAS f32x4* xr = (const GAS f32x4*)(x + (size_t)m * D) + lane; f32x4 v[4]; float s = 0.f;
#pragma unroll
            for (int j = 0; j < 4; ++j) { v[j] = xr[64 * j]; s += (v[j].x * v[j].x + v[j].y * v[j].y) + (v[j].z * v[j].z + v[j].w * v[j].w); }
            const float rstd = __builtin_amdgcn_rsqf(wave_sum(s) * (1.f / D) + RMS_EPS);
            GAS v2u* o8 = (GAS v2u*)(XN + (size_t)m * D) + lane;
#pragma unroll
            for (int j = 0; j < 4; ++j) { v2u o; o.x = pk2(v[j].x * rstd, v[j].y * rstd); o.y = pk2(v[j].z * rstd, v[j].w * rstd); o8[64 * j] = o; }
        }
    }
    {
        const int* pos = (const int*)F.in[1]; f32x2* rope = (f32x2*)(ws + WS_ROPE);
        const int gt = (F.vcu * NWAVES + F.wave) * 64 + ((int)(threadIdx.x & 63)), NT = F.G * NWAVES * 64;
        const int j = gt & 31;
        const double inv = exp2(-(double)j * (13.287712379549449 / 32.0));
        for (int e = gt; e < M * 32; e += NT) {
            const int row = e >> 5;
            double a = (double)pos[row] * inv; a -= 6.283185307179586 * rint(a * 0.15915494309189535);
            float sn, cs; sincosf((float)a, &sn, &cs);
            rope[e] = (f32x2){cs, sn};
        }
    }
}

constexpr int RW_TC = 32;
constexpr int RWL_STEP = 0, RWL_YP = 49152, RWL_GATE = 81920, RWL_BV = 90112, RWL_AW = 98304, RWL_AA = 102912, RWL_AG = 107520, RWL_W2T = 116224, RWL_A2T = 125440, RWL_G2T = 134656, RWL_MU = 152064, RWL_BK = 153856, RWL_VT = 154112, RWL_END = 162304;
static_assert(RWL_END <= LDSCTL_OFF, "rwkv lds");
#define LBAR() do { asm volatile("s_waitcnt lgkmcnt(0)" ::: "memory"); __builtin_amdgcn_s_barrier(); asm volatile("" ::: "memory"); } while (0)
__device__ __forceinline__ float fexp2(float x) { return __builtin_amdgcn_exp2f(x); }
__device__ __forceinline__ float frcp(float x) { return __builtin_amdgcn_rcpf(x); }
__device__ __forceinline__ float fsig(float x) { return frcp(1.0f + fexp2(-1.44269504089f * x)); }
__device__ __forceinline__ float ftanh(float x) { return 1.0f - 2.0f * frcp(1.0f + fexp2(2.88539008178f * x)); }
__device__ __forceinline__ unsigned cvtpk(float lo, float hi) { return pg8::cvt_pk_native(lo, hi); }
template <int KIND> __device__ __forceinline__ bf16x8 frag_map(bf16x8 v) {
    v4u u = __builtin_bit_cast(v4u, v);
#pragma unroll
    for (int i = 0; i < 4; ++i) { const float lo = bflo(u[i]), hi = bfhi(u[i]); u[i] = (KIND == 1) ? cvtpk(ftanh(lo), ftanh(hi)) : cvtpk(fsig(lo), fsig(hi)); }
    return __builtin_bit_cast(bf16x8, u);
}

typedef short rw_s4 __attribute__((ext_vector_type(4)));
__device__ __forceinline__ void rwkv_phase(Frame& F) {
    LAS unsigned char* L = F.lds;
    LAS float* STEP = (LAS float*)(L + RWL_STEP);
    LAS float* YP = (LAS float*)(L + RWL_YP);
    LAS float* DECP = (LAS float*)(L + RWL_YP + 8192);
    LAS unsigned* ZW = (LAS unsigned*)(L + RWL_YP + 24576);
    LAS unsigned* BBKX = (LAS unsigned*)(L + RWL_YP + 16384);
    LAS bf16* GATEB = (LAS bf16*)(L + RWL_GATE);
    LAS float* BV = (LAS float*)(L + RWL_BV);
    LAS float* VT = (LAS float*)(L + RWL_VT);
    LAS bf16* AW = (LAS bf16*)(L + RWL_AW);
    LAS bf16* AA = (LAS bf16*)(L + RWL_AA);
    LAS bf16* AG = (LAS bf16*)(L + RWL_AG);
    LAS bf16* W2T = (LAS bf16*)(L + RWL_W2T);
    LAS bf16* A2T = (LAS bf16*)(L + RWL_A2T);
    LAS bf16* G2T = (LAS bf16*)(L + RWL_G2T);
    LAS float* MU = (LAS float*)(L + RWL_MU);
    const int tid = F.tid, lane = ((int)(threadIdx.x & 63)), w = F.wave;
    const int pt = tid & 255;
    const bf16* PRW = (const bf16*)(F.ws + WS_PRW);
    bf16* Yrw = (bf16*)((unsigned char*)F.out + OUT_Y);
    const float* mu = F.in[7]; const float* w0 = F.in[8]; const float* a0 = F.in[10]; const float* k_k = F.in[13]; const float* k_a = F.in[14]; const float* r_k = F.in[15];
    const float* lnw = F.in[16]; const float* lnb = F.in[17];
    int itt[7], icc[7];
#pragma unroll
    for (int q = 0; q < 3; ++q) { const int it = pt + 256 * q; itt[q] = it / 24; icc[q] = it % 24; }
#pragma unroll
    for (int q = 3; q < 7; ++q) { const int it = pt + 256 * (q - 3); itt[q] = it >> 5; icc[q] = 24 + (it & 31); }
    const int tt2 = tid >> 4, c4 = 4 * (tid & 15);
    constexpr int NC = T / RW_TC;
    for (int unit = F.vcu; unit < BATCH * RWH; unit += F.G) {
        const int b = unit >> 3, h = unit & 7;
        __syncthreads();
        {
            const bf16* w2g = (const bf16*)(F.ws + WS_RWW) + (size_t)h * 64 * 64; const bf16* a2g = (const bf16*)(F.ws + WS_RWW + 65536) + (size_t)h * 64 * 64; const bf16* g2g = (const bf16*)(F.ws + WS_RWW + 131072) + (size_t)h * 64 * 128;
            { const int n = tid >> 3, c = tid & 7; *(LAS v4u*)(W2T + n * 72 + 8 * c) = *(const v4u*)(w2g + n * 64 + 8 * c); *(LAS v4u*)(A2T + n * 72 + 8 * c) = *(const v4u*)(a2g + n * 64 + 8 * c); }
#pragma unroll
            for (int q = 0; q < 2; ++q) { const int e = tid + 512 * q, n = e >> 4, c = e & 15; *(LAS v4u*)(G2T + n * 136 + 8 * c) = *(const v4u*)(g2g + n * 128 + 8 * c); }
            if (tid < 4) ZW[tid] = 0u;
            if (tid < 448) { const int cc = tid >> 3; int gc; if (cc < 8) gc = h * 64 + 8 * cc; else if (cc < 16) gc = 512 + h * 64 + 8 * (cc - 8); else if (cc < 24) gc = 1024 + h * 64 + 8 * (cc - 16); else gc = 1536 + 8 * (cc - 24);
                MU[tid] = mu[gc + (tid & 7)]; }
        }
        int igc[7];
#pragma unroll
        for (int q = 0; q < 7; ++q) { const int cc = icc[q]; igc[q] = (cc < 8) ? h * 64 + 8 * cc : (cc < 16) ? 512 + h * 64 + 8 * (cc - 8) : (cc < 24) ? 1024 + h * 64 + 8 * (cc - 16) : 1536 + 8 * (cc - 24); }
        const f32x4 w0v = *(const f32x4*)(w0 + h * 64 + c4), a0v = *(const f32x4*)(a0 + h * 64 + c4), kkv = *(const f32x4*)(k_k + h * 64 + c4), kav = *(const f32x4*)(k_a + h * 64 + c4);
        const f32x4 rkv = *(const f32x4*)(r_k + h * 64 + c4), lwv = *(const f32x4*)(lnw + h * 64 + c4), lbv = *(const f32x4*)(lnb + h * 64 + c4);
        f32x4 SM[4]; v4u bS0 = (v4u){0u, 0u, 0u, 0u}, bS1 = bS0;
#pragma unroll
        for (int t = 0; t < 4; ++t) SM[t] = (f32x4){0.f, 0.f, 0.f, 0.f};
        LBAR();
#define RW_STAGE_A(cn) do { \
            v4u rc[7], rp[7];        \
            _Pragma("unroll") for (int q = 0; q < 7; ++q) { const size_t row = (size_t)b * T + (size_t)(cn) * RW_TC + itt[q]; rc[q] = *(const v4u*)(PRW + row * RW_COLS + igc[q]); \
                rp[q] = ((cn) > 0 || itt[q] > 0) ? *(const v4u*)(PRW + (row - 1) * RW_COLS + igc[q]) : (v4u){0u, 0u, 0u, 0u}; } \
            _Pragma("unroll") for (int q = 0; q < 7; ++q) { \
                const int tt = itt[q], cc = icc[q]; const v4u cw = rc[q], pw = rp[q]; \
                const f32x4 m0 = *(const LAS f32x4*)(MU + cc * 8), m1 = *(const LAS f32x4*)(MU + cc * 8 + 4); \
                float x[8]; \
                { const float c0 = bflo(cw.x), c1 = bfhi(cw.x), c2 = bflo(cw.y), c3 = bfhi(cw.y), c4_ = bflo(cw.z), c5 = bfhi(cw.z), c6 = bflo(cw.w), c7 = bfhi(cw.w); \
                  x[0] = c0 + (bflo(pw.x) - c0) * m0[0]; x[1] = c1 + (bfhi(pw.x) - c1) * m0[1]; x[2] = c2 + (bflo(pw.y) - c2) * m0[2]; x[3] = c3 + (bfhi(pw.y) - c3) * m0[3]; \
                  x[4] = c4_ + (bflo(pw.z) - c4_) * m1[0]; x[5] = c5 + (bfhi(pw.z) - c5) * m1[1]; x[6] = c6 + (bflo(pw.w) - c6) * m1[2]; x[7] = c7 + (bfhi(pw.w) - c7) * m1[3]; } \
                if (cc < 24) { \
                    const int a_ = (cc < 8) ? 4 : (cc < 16) ? 3 : 5; const int c8 = 8 * (cc & 7); \
                    LAS f32x4* d = (LAS f32x4*)(STEP + (tt * 6 + a_) * 64 + c8); \
                    d[0] = (f32x4){x[0], x[1], x[2], x[3]}; d[1] = (f32x4){x[4], x[5], x[6], x[7]}; \
                } else { \
                    v4u o; o.x = cvtpk(x[0], x[1]); o.y = cvtpk(x[2], x[3]); o.z = cvtpk(x[4], x[5]); o.w = cvtpk(x[6], x[7]); \
                    LAS bf16* dst = (cc < 32) ? AW + tt * 72 + 8 * (cc - 24) : (cc < 40) ? AA + tt * 72 + 8 * (cc - 32) : AG + tt * 136 + 8 * (cc - 40); \
                    *(LAS v4u*)dst = o; \
                } \
            } \
            } while (0)
        if (w >= 4) RW_STAGE_A(0);
        LBAR();
        for (int c = -1; c < NC; ++c) {
            if (c >= 0) {
            if (w < 4) {
                const int fr = lane & 15, fq = lane >> 4;
                const LAS unsigned* bkp = (fq == 0) ? BBKX + fr * 4 : ZW; const int bks = (fq == 0) ? 64 * 4 : 0;
                const LAS float* vrp = (fq == 0) ? VT + 16 * w + fr : (const LAS float*)ZW; const int vrs = (fq == 0) ? 64 * 4 : 0;
                const LAS bf16* kkt = (const LAS bf16*)(STEP + 128) + fq * 16 + ((fr & 1) ? 64 : 0);
                const LAS f32x4* dpp_ = (const LAS f32x4*)(DECP + fq * 16);
                LAS float* ypw = YP + 16 * w + fr;
                bf16x8 xa0 = *(const LAS bf16x8*)(kkt), xa1 = *(const LAS bf16x8*)(kkt + 8), ya0, ya1;
                f32x4 xq0 = dpp_[0], xq1 = dpp_[1], xq2 = dpp_[2], xq3 = dpp_[3], yq0, yq1, yq2, yq3;
                v4u xbk = *(const LAS v4u*)(bkp), ybk; float xv = vrp[0], yv;
                const LAS bf16* avn = kkt + ((fr & 1) ? 0 : 768);
#define RW_VMUL(d, a_, b_) asm("v_mul_f32 %0, %1, %2" : "=v"(d) : "v"(a_), "v"(b_))
#define RW_STEP(tt, A0, A1, Q0, Q1, Q2, Q3, BKc, Vc, NA0, NA1, NQ0, NQ1, NQ2, NQ3, NBK, NV) do { \
                    if ((tt) + 1 < RW_TC) { dpp_ += 16; bkp = (const LAS unsigned*)((const LAS char*)bkp + bks); vrp = (const LAS float*)((const LAS char*)vrp + vrs); } \
                    NA0 = *(const LAS bf16x8*)(avn); NA1 = *(const LAS bf16x8*)(avn + 8); \
                    NQ0 = dpp_[0]; NQ1 = dpp_[1]; NQ2 = dpp_[2]; NQ3 = dpp_[3]; NBK = *(const LAS v4u*)(bkp); NV = vrp[0]; \
                    const f32x4 d2 = __builtin_amdgcn_mfma_f32_16x16x32_bf16(A0, __builtin_bit_cast(bf16x8, bS0), (f32x4){0.f, 0.f, 0.f, 0.f}, 0, 0, 0);        \
                    const f32x4 e2 = __builtin_amdgcn_mfma_f32_16x16x32_bf16(A1, __builtin_bit_cast(bf16x8, bS1), (f32x4){0.f, 0.f, 0.f, 0.f}, 0, 0, 0); \
                    f32x4 c0, c1, c2, c3;        \
                    _Pragma("unroll") for (int j_ = 0; j_ < 4; ++j_) { RW_VMUL(c0[j_], SM[0][j_], Q0[j_]); RW_VMUL(c1[j_], SM[1][j_], Q1[j_]); RW_VMUL(c2[j_], SM[2][j_], Q2[j_]); RW_VMUL(c3[j_], SM[3][j_], Q3[j_]); } \
                    if ((tt) > 0) ypw[((tt) - 1) * 64] = d2[1] + e2[1]; \
                    const unsigned pr2 = cvtpk(d2[0] + e2[0], Vc); const v2u be = (v2u){pr2, 0u}, bo = (v2u){0u, pr2}; const v2u alo = (v2u){BKc.x, BKc.y}, ahi = (v2u){BKc.z, BKc.w}; \
                    SM[0] = __builtin_amdgcn_mfma_f32_16x16x16bf16_1k(__builtin_bit_cast(rw_s4, alo), __builtin_bit_cast(rw_s4, be), c0, 0, 0, 0); \
                    SM[1] = __builtin_amdgcn_mfma_f32_16x16x16bf16_1k(__builtin_bit_cast(rw_s4, alo), __builtin_bit_cast(rw_s4, bo), c1, 0, 0, 0); \
                    SM[2] = __builtin_amdgcn_mfma_f32_16x16x16bf16_1k(__builtin_bit_cast(rw_s4, ahi), __builtin_bit_cast(rw_s4, be), c2, 0, 0, 0); \
                    SM[3] = __builtin_amdgcn_mfma_f32_16x16x16bf16_1k(__builtin_bit_cast(rw_s4, ahi), __builtin_bit_cast(rw_s4, bo), c3, 0, 0, 0); \
                    bS0.x = cvtpk(SM[0][0], SM[0][1]); bS0.y = cvtpk(SM[0][2], SM[0][3]); bS0.z = cvtpk(SM[1][0], SM[1][1]); bS0.w = cvtpk(SM[1][2], SM[1][3]); \
                    bS1.x = cvtpk(SM[2][0], SM[2][1]); bS1.y = cvtpk(SM[2][2], SM[2][3]); bS1.z = cvtpk(SM[3][0], SM[3][1]); bS1.w = cvtpk(SM[3][2], SM[3][3]); \
                    if ((fr & 1) || (tt) + 2 < RW_TC) avn += 768;        \
                } while (0)
                for (int tt = 0; tt < RW_TC; tt += 2) {
                    RW_STEP(tt, xa0, xa1, xq0, xq1, xq2, xq3, xbk, xv, ya0, ya1, yq0, yq1, yq2, yq3, ybk, yv);
                    RW_STEP(tt + 1, ya0, ya1, yq0, yq1, yq2, yq3, ybk, yv, xa0, xa1, xq0, xq1, xq2, xq3, xbk, xv);
                    if (tt == RW_TC / 2 - 2) LBAR();
                }
#undef RW_STEP
                const bf16x8 av0 = xa0, av1 = xa1;
                {
                    f32x4 d2 = __builtin_amdgcn_mfma_f32_16x16x32_bf16(av0, __builtin_bit_cast(bf16x8, bS0), (f32x4){0.f, 0.f, 0.f, 0.f}, 0, 0, 0);
                    d2 = __builtin_amdgcn_mfma_f32_16x16x32_bf16(av1, __builtin_bit_cast(bf16x8, bS1), d2, 0, 0, 0);
                    ypw[(RW_TC - 1) * 64] = d2[1];
                }
            }
            else {
                if (c + 1 < NC) RW_STAGE_A(c + 1);
                LBAR();
                if (c + 1 < NC) {
                    LAS bf16* GATEn = GATEB + ((c + 1) & 1) * (RW_TC * 64);
#pragma unroll
                    for (int vi = 0; vi < 2; ++vi) { const int vw = 2 * (w - 4) + vi;
            {
                const int fr = lane & 15, fq = lane >> 4;
                if (vw < 4) {
                    const bool isw = (vw < 2); const int mb = vw & 1;
                    LAS bf16* Aop = isw ? AW : AA; LAS bf16* Bop = isw ? W2T : A2T;
                    f32x4 acc[4];
#pragma unroll
                    for (int nb = 0; nb < 4; ++nb) acc[nb] = (f32x4){0.f, 0.f, 0.f, 0.f};
#pragma unroll
                    for (int ks = 0; ks < 2; ++ks) { bf16x8 af = *(const LAS bf16x8*)(Aop + (mb * 16 + fr) * 72 + ks * 32 + 8 * fq); if (isw) af = frag_map<1>(af);
#pragma unroll
                        for (int nb = 0; nb < 4; ++nb) { const bf16x8 bfv = *(const LAS bf16x8*)(Bop + (nb * 16 + fr) * 72 + ks * 32 + 8 * fq);
                            acc[nb] = __builtin_amdgcn_mfma_f32_16x16x32_bf16(af, bfv, acc[nb], 0, 0, 0); } }
                    const int slot = isw ? 0 : 1;
#pragma unroll
                    for (int nb = 0; nb < 4; ++nb)
#pragma unroll
                        for (int rg4 = 0; rg4 < 4; ++rg4) STEP[((mb * 16 + 4 * fq + rg4) * 6 + slot) * 64 + nb * 16 + fr] = acc[nb][rg4];
                } else {
                    const int mb = (vw - 4) & 1, nb0 = ((vw - 4) >> 1) * 2;
                    f32x4 acc[2]; acc[0] = (f32x4){0.f, 0.f, 0.f, 0.f}; acc[1] = acc[0];
#pragma unroll
                    for (int ks = 0; ks < 4; ++ks) { const bf16x8 af = frag_map<2>(*(const LAS bf16x8*)(AG + (mb * 16 + fr) * 136 + ks * 32 + 8 * fq));
#pragma unroll
                        for (int q = 0; q < 2; ++q) { const bf16x8 bfv = *(const LAS bf16x8*)(G2T + ((nb0 + q) * 16 + fr) * 136 + ks * 32 + 8 * fq);
                            acc[q] = __builtin_amdgcn_mfma_f32_16x16x32_bf16(af, bfv, acc[q], 0, 0, 0); } }
#pragma unroll
                    for (int q = 0; q < 2; ++q)
#pragma unroll
                        for (int rg4 = 0; rg4 < 4; ++rg4) GATEn[(mb * 16 + 4 * fq + rg4) * 64 + (nb0 + q) * 16 + fr] = (bf16)(cvtpk(acc[q][rg4], 0.f) & 0xffffu);
                }
            }
                    }
                }
            }
            LBAR();
            }
            const bool prep = (c + 1 < NC);
            if (c < 0) {
                LAS bf16* GATEn = GATEB; const int vw = w;
            {
                const int fr = lane & 15, fq = lane >> 4;
                if (vw < 4) {
                    const bool isw = (vw < 2); const int mb = vw & 1;
                    LAS bf16* Aop = isw ? AW : AA; LAS bf16* Bop = isw ? W2T : A2T;
                    f32x4 acc[4];
#pragma unroll
                    for (int nb = 0; nb < 4; ++nb) acc[nb] = (f32x4){0.f, 0.f, 0.f, 0.f};
#pragma unroll
                    for (int ks = 0; ks < 2; ++ks) { bf16x8 af = *(const LAS bf16x8*)(Aop + (mb * 16 + fr) * 72 + ks * 32 + 8 * fq); if (isw) af = frag_map<1>(af);
#pragma unroll
                        for (int nb = 0; nb < 4; ++nb) { const bf16x8 bfv = *(const LAS bf16x8*)(Bop + (nb * 16 + fr) * 72 + ks * 32 + 8 * fq);
                            acc[nb] = __builtin_amdgcn_mfma_f32_16x16x32_bf16(af, bfv, acc[nb], 0, 0, 0); } }
                    const int slot = isw ? 0 : 1;
#pragma unroll
                    for (int nb = 0; nb < 4; ++nb)
#pragma unroll
                        for (int rg4 = 0; rg4 < 4; ++rg4) STEP[((mb * 16 + 4 * fq + rg4) * 6 + slot) * 64 + nb * 16 + fr] = acc[nb][rg4];
                } else {
                    const int mb = (vw - 4) & 1, nb0 = ((vw - 4) >> 1) * 2;
                    f32x4 acc[2]; acc[0] = (f32x4){0.f, 0.f, 0.f, 0.f}; acc[1] = acc[0];
#pragma unroll
                    for (int ks = 0; ks < 4; ++ks) { const bf16x8 af = frag_map<2>(*(const LAS bf16x8*)(AG + (mb * 16 + fr) * 136 + ks * 32 + 8 * fq));
#pragma unroll
                        for (int q = 0; q < 2; ++q) { const bf16x8 bfv = *(const LAS bf16x8*)(G2T + ((nb0 + q) * 16 + fr) * 136 + ks * 32 + 8 * fq);
                            acc[q] = __builtin_amdgcn_mfma_f32_16x16x32_bf16(af, bfv, acc[q], 0, 0, 0); } }
#pragma unroll
                    for (int q = 0; q < 2; ++q)
#pragma unroll
                        for (int rg4 = 0; rg4 < 4; ++rg4) GATEn[(mb * 16 + 4 * fq + rg4) * 64 + (nb0 + q) * 16 + fr] = (bf16)(cvtpk(acc[q][rg4], 0.f) & 0xffffu);
                }
            }
                LBAR();
            }
            if (c >= 0) {
                float y[4];
#pragma unroll
                for (int r = 0; r < 4; ++r) y[r] = YP[tt2 * 64 + c4 + r];
                const float mean = row16_sum((y[0] + y[1]) + (y[2] + y[3])) * (1.f / 64.f);
                const f32x4 dlt = (f32x4){y[0] - mean, y[1] - mean, y[2] - mean, y[3] - mean};
                const float var = row16_sum((dlt[0] * dlt[0] + dlt[1] * dlt[1]) + (dlt[2] * dlt[2] + dlt[3] * dlt[3])) * (1.f / 64.f);
                const float rs = __builtin_amdgcn_rsqf(var + RW_GN_EPS);
                const f32x4 bv = *(const LAS f32x4*)(BV + tt2 * 64 + c4);
                const v2u gw = *(const LAS v2u*)(GATEB + (c & 1) * (RW_TC * 64) + tt2 * 64 + c4);
                const f32x4 gt = (f32x4){bflo(gw.x), bfhi(gw.x), bflo(gw.y), bfhi(gw.y)};
                const f32x4 o = (dlt * rs * lwv + lbv + bv) * gt;
                v2u pw; pw.x = cvtpk(o[0], o[1]); pw.y = cvtpk(o[2], o[3]);
                *(v2u*)(Yrw + ((size_t)b * T + (size_t)c * RW_TC + tt2) * LDY + h * 64 + c4) = pw;
            }
            if (prep) {
                LAS float* spt = STEP + tt2 * 384 + c4;
                const f32x4 wl = *(const LAS f32x4*)(spt), al = *(const LAS f32x4*)(spt + 64), xk = *(const LAS f32x4*)(spt + 192), rr = *(const LAS f32x4*)(spt + 256), vv = *(const LAS f32x4*)(spt + 320);
                constexpr float KD = -0.60653065971f * 1.44269504089f;
                f32x4 dec, a, kkr;
#pragma unroll
                for (int i = 0; i < 4; ++i) { dec[i] = fexp2(KD * fsig(w0v[i] + wl[i])); a[i] = fsig(a0v[i] + al[i]); kkr[i] = xk[i] * kkv[i]; }
                const float n2 = row16_sum((kkr[0] * kkr[0] + kkr[1] * kkr[1]) + (kkr[2] * kkr[2] + kkr[3] * kkr[3]));
                const float inv = fminf(__builtin_amdgcn_rsqf(n2), 1e12f);
                const f32x4 kk = kkr * inv;
                const f32x4 kx = xk * (1.0f + (a - 1.0f) * kav);
                const f32x4 rk = rr * kx * rkv;
                const float bonus = row16_sum((rk[0] + rk[1]) + (rk[2] + rk[3]));
                const int tq = c4 >> 4, fqk = (c4 >> 2) & 3;
                *(LAS f32x4*)(DECP + tt2 * 64 + fqk * 16 + tq * 4) = dec;
                LAS bf16* kr = (LAS bf16*)(STEP + tt2 * 384 + 128) + fqk * 16 + (tq >> 1) * 8 + (tq & 1) * 4;
                { v2u o; o.x = cvtpk(-kk[0], -kk[1]); o.y = cvtpk(-kk[2], -kk[3]); *(LAS v2u*)kr = o; o.x = cvtpk(rr[0], rr[1]); o.y = cvtpk(rr[2], rr[3]); *(LAS v2u*)(kr + 64) = o; }
                const f32x4 bbv = kk * a;
#pragma unroll
                for (int i = 0; i < 4; ++i) BBKX[tt2 * 64 + ((c4 & 15) + i) * 4 + tq] = cvtpk(bbv[i], kx[i]);
                *(LAS f32x4*)(VT + tt2 * 64 + c4) = vv;
                *(LAS f32x4*)(BV + tt2 * 64 + c4) = bonus * vv;
            }
            LBAR();
        }
#undef RW_STAGE_A
    }
}

constexpr int RTL_Q = 0, RTL_K1 = 18432, RTL_V = 36864, RTL_SP = 73728, RTL_RT = 106496, RTL_END = 124928;
static_assert(RTL_END <= LDSCTL_OFF, "retention lds");
typedef short s16x4 __attribute__((ext_vector_type(4)));
__device__ __forceinline__ bf16x8 tr_frag(const LAS bf16* p, int rows4) {
    const s16x4 lo = __builtin_amdgcn_ds_read_tr16_b64_v4i16((LAS s16x4*)p);
    const s16x4 hi = __builtin_amdgcn_ds_read_tr16_b64_v4i16((LAS s16x4*)(p + rows4));
    return (bf16x8){lo[0], lo[1], lo[2], lo[3], hi[0], hi[1], hi[2], hi[3]};
}
__device__ __forceinline__ void retention_phase(Frame& F) {
    LAS unsigned char* L = F.lds;
    LAS bf16* Q = (LAS bf16*)(L + RTL_Q);
    LAS bf16* K1 = (LAS bf16*)(L + RTL_K1);
    LAS bf16* V = (LAS bf16*)(L + RTL_V);
    LAS bf16* SP = (LAS bf16*)(L + RTL_SP);
    LAS bf16* RT = (LAS bf16*)(L + RTL_RT);
    const int tid = F.tid, lane = ((int)(threadIdx.x & 63)), w = F.wave, fr = lane & 15, fq = lane >> 4;
    const bf16* PRET = (const bf16*)(F.ws + WS_PRET);
    const f32x2* rope = (const f32x2*)(F.ws + WS_ROPE);
    bf16* Yret = (bf16*)((unsigned char*)F.out + OUT_Y) + RWW;
    const int si = tid >> 2, sjc = tid & 3;
    const int i0 = 16 * w;
    const int trq = fr >> 2, trp = fr & 3;
    for (int unit = F.vcu; unit < BATCH * RTH; unit += F.G) {
        const int b = unit >> 3, h = unit & 7;
        const float lg2 = log1pf(-exp2f(-5.0f - (float)h)) * 1.44269504089f;
        const float cdec = fexp2(128.0f * lg2);
        const float ksc = 0.125f * fexp2(-(float)(si + 1) * lg2);
        float qd[4];
#pragma unroll
        for (int rg4 = 0; rg4 < 4; ++rg4) qd[rg4] = fexp2((float)(i0 + 4 * fq + rg4 + 1) * lg2);
        __syncthreads();
        for (int e = tid; e < 128 * 72 / 8; e += 512) *(LAS v4u*)(RT + 8 * e) = (v4u){0u, 0u, 0u, 0u};
        f32x4 accR[4];
#pragma unroll
        for (int db = 0; db < 4; ++db) accR[db] = (f32x4){0.f, 0.f, 0.f, 0.f};
        v4u pq0, pq1, pk0, pk1, pv[4]; f32x4 pr[4];
        {
            const size_t row = (size_t)b * T + si;
            const bf16* pr_ = PRET + row * RET_COLS + h * 64 + 8 * sjc;
            pq0 = *(const v4u*)(pr_); pq1 = *(const v4u*)(pr_ + 32); pk0 = *(const v4u*)(pr_ + 512); pk1 = *(const v4u*)(pr_ + 512 + 32);
            const f32x4* rp = (const f32x4*)(rope + row * 32 + 8 * sjc); pr[0] = rp[0]; pr[1] = rp[1]; pr[2] = rp[2]; pr[3] = rp[3];
#pragma unroll
            for (int q4 = 0; q4 < 4; ++q4) { const int e = tid + 512 * q4, iv = e >> 4, vc = e & 15; pv[q4] = *(const v4u*)(PRET + ((size_t)b * T + iv) * RET_COLS + 1024 + h * 128 + 8 * vc); }
        }
        for (int ch = 0; ch < T / RCH; ++ch) {
            const size_t rowbase = (size_t)b * T + (size_t)ch * RCH;
            {
                const float cs[8] = {pr[0][0], pr[0][2], pr[1][0], pr[1][2], pr[2][0], pr[2][2], pr[3][0], pr[3][2]}, sn[8] = {pr[0][1], pr[0][3], pr[1][1], pr[1][3], pr[2][1], pr[2][3], pr[3][1], pr[3][3]};
                {
                    const float z1[8] = {bflo(pq0.x), bfhi(pq0.x), bflo(pq0.y), bfhi(pq0.y), bflo(pq0.z), bfhi(pq0.z), bflo(pq0.w), bfhi(pq0.w)}, z2[8] = {bflo(pq1.x), bfhi(pq1.x), bflo(pq1.y), bfhi(pq1.y), bflo(pq1.z), bfhi(pq1.z), bflo(pq1.w), bfhi(pq1.w)};
                    float o1[8], o2[8];
#pragma unroll
                    for (int q = 0; q < 8; ++q) { o1[q] = z1[q] * cs[q] - z2[q] * sn[q]; o2[q] = z1[q] * sn[q] + z2[q] * cs[q]; }
                    v4u p1, p2; p1.x = pk2(o1[0], o1[1]); p1.y = pk2(o1[2], o1[3]); p1.z = pk2(o1[4], o1[5]); p1.w = pk2(o1[6], o1[7]); p2.x = pk2(o2[0], o2[1]); p2.y = pk2(o2[2], o2[3]); p2.z = pk2(o2[4], o2[5]); p2.w = pk2(o2[6], o2[7]);
                    *(LAS v4u*)(Q + si * 72 + 8 * sjc) = p1; *(LAS v4u*)(Q + si * 72 + 32 + 8 * sjc) = p2;
                }
                {
                    const float z1[8] = {bflo(pk0.x), bfhi(pk0.x), bflo(pk0.y), bfhi(pk0.y), bflo(pk0.z), bfhi(pk0.z), bflo(pk0.w), bfhi(pk0.w)}, z2[8] = {bflo(pk1.x), bfhi(pk1.x), bflo(pk1.y), bfhi(pk1.y), bflo(pk1.z), bfhi(pk1.z), bflo(pk1.w), bfhi(pk1.w)};
                    float o1[8], o2[8];
#pragma unroll
                    for (int q = 0; q < 8; ++q) { o1[q] = (z1[q] * cs[q] - z2[q] * sn[q]) * ksc; o2[q] = (z1[q] * sn[q] + z2[q] * cs[q]) * ksc; }
                    v4u p1, p2; p1.x = pk2(o1[0], o1[1]); p1.y = pk2(o1[2], o1[3]); p1.z = pk2(o1[4], o1[5]); p1.w = pk2(o1[6], o1[7]); p2.x = pk2(o2[0], o2[1]); p2.y = pk2(o2[2], o2[3]); p2.z = pk2(o2[4], o2[5]); p2.w = pk2(o2[6], o2[7]);
                    *(LAS v4u*)(K1 + si * 72 + 8 * sjc) = p1; *(LAS v4u*)(K1 + si * 72 + 32 + 8 * sjc) = p2;
                }
#pragma unroll
                for (int q4 = 0; q4 < 4; ++q4) { const int e = tid + 512 * q4, iv = e >> 4, vc = e & 15; *(LAS v4u*)(V + iv * 144 + 8 * vc) = pv[q4]; }
            }
            if (ch + 1 < T / RCH) {
                const size_t row = rowbase + RCH + si;
                const bf16* pr_ = PRET + row * RET_COLS + h * 64 + 8 * sjc;
                pq0 = *(const v4u*)(pr_); pq1 = *(const v4u*)(pr_ + 32); pk0 = *(const v4u*)(pr_ + 512); pk1 = *(const v4u*)(pr_ + 512 + 32);
                const f32x4* rp = (const f32x4*)(rope + row * 32 + 8 * sjc); pr[0] = rp[0]; pr[1] = rp[1]; pr[2] = rp[2]; pr[3] = rp[3];
#pragma unroll
                for (int q4 = 0; q4 < 4; ++q4) { const int e = tid + 512 * q4, iv = e >> 4, vc = e & 15; pv[q4] = *(const v4u*)(PRET + (rowbase + RCH + iv) * RET_COLS + 1024 + h * 128 + 8 * vc); }
            }
            LBAR();
            v4u gvp[4];
#pragma unroll
            for (int q = 0; q < 4; ++q) gvp[q] = *(const v4u*)(PRET + (rowbase + i0 + fr) * RET_COLS + 2048 + h * 128 + 32 * q + 8 * fq);
            bf16x8 qf[2];
#pragma unroll
            for (int ks = 0; ks < 2; ++ks) qf[ks] = *(const LAS bf16x8*)(Q + (i0 + fr) * 72 + ks * 32 + 8 * fq);
            LAS bf16* SPw = SP + w * 2048;
#pragma unroll
            for (int nb = 0; nb < 8; ++nb) {
                if (nb <= (w | 1)) {
                    f32x4 s = (f32x4){0.f, 0.f, 0.f, 0.f};
                    if (nb <= w) {
#pragma unroll
                        for (int ks = 0; ks < 2; ++ks) { const bf16x8 kf = *(const LAS bf16x8*)(K1 + (nb * 16 + fr) * 72 + ks * 32 + 8 * fq); s = __builtin_amdgcn_mfma_f32_16x16x32_bf16(qf[ks], kf, s, 0, 0, 0); }
                    }
                    const int key = nb * 16 + fr, qi = i0 + 4 * fq;
                    v2u pw; pw.x = pk2(key <= qi ? s[0] : 0.f, key <= qi + 1 ? s[1] : 0.f); pw.y = pk2(key <= qi + 2 ? s[2] : 0.f, key <= qi + 3 ? s[3] : 0.f);
                    *(LAS v2u*)(SPw + key * 16 + 4 * fq) = pw;
                }
            }
            LDS_WAIT();
            f32x4 o[8];
#pragma unroll
            for (int nb = 0; nb < 8; ++nb) o[nb] = (f32x4){0.f, 0.f, 0.f, 0.f};
#pragma unroll
            for (int ks = 0; ks < 4; ++ks) if (2 * ks <= w) { const bf16x8 sf = tr_frag(SPw + (32 * ks + 8 * fq + trq) * 16 + 4 * trp, 4 * 16);
#pragma unroll
                for (int nb = 0; nb < 8; ++nb) { const bf16x8 vf = tr_frag(V + (32 * ks + 8 * fq + trq) * 144 + 16 * nb + 4 * trp, 4 * 144); o[nb] = __builtin_amdgcn_mfma_f32_16x16x32_bf16(sf, vf, o[nb], 0, 0, 0); } }
#pragma unroll
            for (int ks = 0; ks < 2; ++ks)
#pragma unroll
                for (int n4 = 0; n4 < 2; ++n4) {
                    bf16x8 rf[4];
#pragma unroll
                    for (int nb = 0; nb < 4; ++nb) rf[nb] = *(const LAS bf16x8*)(RT + ((4 * n4 + nb) * 16 + fr) * 72 + ks * 32 + 8 * fq);
                    __builtin_amdgcn_sched_barrier(0);
#pragma unroll
                    for (int nb = 0; nb < 4; ++nb) o[4 * n4 + nb] = __builtin_amdgcn_mfma_f32_16x16x32_bf16(qf[ks], rf[nb], o[4 * n4 + nb], 0, 0, 0);
                    __builtin_amdgcn_sched_barrier(0);
                }
#pragma unroll
            for (int ks = 0; ks < 4; ++ks) { const bf16x8 vf = tr_frag(V + (32 * ks + 8 * fq + trq) * 144 + 16 * w + 4 * trp, 4 * 144);
#pragma unroll
                for (int db = 0; db < 4; ++db) { const bf16x8 kf = tr_frag(K1 + (32 * ks + 8 * fq + trq) * 72 + 16 * db + 4 * trp, 4 * 72); accR[db] = __builtin_amdgcn_mfma_f32_16x16x32_bf16(vf, kf, accR[db], 0, 0, 0); } }
#pragma unroll
            for (int db = 0; db < 4; ++db) accR[db] = accR[db] * cdec;
#pragma unroll
            for (int rg4 = 0; rg4 < 4; ++rg4)
#pragma unroll
                for (int nb = 0; nb < 8; ++nb) o[nb][rg4] *= qd[rg4];
            {
                float s1[4], s2[4];
#pragma unroll
                for (int rg4 = 0; rg4 < 4; ++rg4) { s1[rg4] = 0.f;
#pragma unroll
                    for (int nb = 0; nb < 8; ++nb) s1[rg4] += o[nb][rg4]; }
                row16_sum4(s1);
#pragma unroll
                for (int rg4 = 0; rg4 < 4; ++rg4) { const float mean = s1[rg4] * (1.f / 128.f); s2[rg4] = 0.f;
#pragma unroll
                    for (int nb = 0; nb < 8; ++nb) { o[nb][rg4] -= mean; s2[rg4] += o[nb][rg4] * o[nb][rg4]; } }
                row16_sum4(s2);
#pragma unroll
                for (int rg4 = 0; rg4 < 4; ++rg4) { const float rs = __builtin_amdgcn_rsqf(s2[rg4] * (1.f / 128.f) + RET_GN_EPS);
#pragma unroll
                    for (int nb = 0; nb < 8; ++nb) o[nb][rg4] *= rs; }
            }
#pragma unroll
            for (int nb = 0; nb < 8; ++nb) { v2u pw; pw.x = pk2(o[nb][0], o[nb][1]); pw.y = pk2(o[nb][2], o[nb][3]); *(LAS v2u*)(SPw + (nb * 16 + fr) * 16 + 4 * fq) = pw; }
            LDS_WAIT();
#pragma unroll
            for (int q = 0; q < 4; ++q) {
                const int c8 = 32 * q + 8 * fq; const size_t row = rowbase + i0 + fr;
                const v4u ov = __builtin_bit_cast(v4u, tr_frag(SPw + (32 * q + 8 * fq + trq) * 16 + 4 * trp, 4 * 16)); const v4u gv = gvp[q];
                v4u r; r.x = pk2(bflo(ov.x) * bflo(gv.x), bfhi(ov.x) * bfhi(gv.x)); r.y = pk2(bflo(ov.y) * bflo(gv.y), bfhi(ov.y) * bfhi(gv.y));
                r.z = pk2(bflo(ov.z) * bflo(gv.z), bfhi(ov.z) * bfhi(gv.z)); r.w = pk2(bflo(ov.w) * bflo(gv.w), bfhi(ov.w) * bfhi(gv.w));
                *(v4u*)(Yret + row * LDY + h * 128 + c8) = r;
            }
            LBAR();
#pragma unroll
            for (int db = 0; db < 4; ++db)
#pragma unroll
                for (int rg4 = 0; rg4 < 4; ++rg4) RT[(w * 16 + 4 * fq + rg4) * 72 + db * 16 + fr] = (bf16)(pk2(accR[db][rg4], 0.f) & 0xffffu);
        }
    }
}

__device__ __forceinline__ void norm_mix_phase(Frame& F) {
    const int gw = F.vcu * NWAVES + F.wave, NGW = F.G * NWAVES;
    const bf16* Z = (const bf16*)(F.ws + WS_Z); const float* part = (const float*)(F.ws + WS_PART); const float* x = F.in[0]; const float* gpost = F.in[3];
    bf16* XN2 = (bf16*)(F.ws + WS_XN2);
    f32x4 g[4];
#pragma unroll
    for (int j = 0; j < 4; ++j) g[j] = ((const f32x4*)gpost)[((int)(threadIdx.x & 63)) + 64 * j];
    constexpr int PD = 2;
    f32x4 bx[PD][4]; v2u bz[PD][4]; float bp[PD];
    const int lane = ((int)(threadIdx.x & 63));
#define P5_LOAD(k, mm) do { bp[k] = part[(size_t)(mm) * 16 + (lane & 15)]; \
        const GAS f32x4* xr_ = (const GAS f32x4*)(x + (size_t)(mm) * D) + lane; const GAS v2u* zr_ = (const GAS v2u*)(Z + (size_t)(mm) * D) + lane; \
        _Pragma("unroll") for (int j = 0; j < 4; ++j) { bx[k][j] = __builtin_nontemporal_load(&xr_[64 * j]); bz[k][j] = __builtin_nontemporal_load(&zr_[64 * j]); } } while (0)
#define P5_ROW(m, pv, xv, zv) do { \
        const float rstd = __builtin_amdgcn_rsqf(row16_sum(pv) * (1.f / D) + RMS_EPS);        \
        f32x4 hv[4]; float s = 0.f; \
        _Pragma("unroll") for (int j = 0; j < 4; ++j) { const v2u zw = zv[j]; const f32x4 z = (f32x4){bflo(zw.x), bfhi(zw.x), bflo(zw.y), bfhi(zw.y)}; \
            hv[j] = xv[j] + z * rstd * g[j]; s += (hv[j].x * hv[j].x + hv[j].y * hv[j].y) + (hv[j].z * hv[j].z + hv[j].w * hv[j].w); } \
        const float rstd2 = __builtin_amdgcn_rsqf(wave_sum(s) * (1.f / D) + RMS_EPS); \
        GAS v2u* h8 = (GAS v2u*)((bf16*)(F.ws + WS_H1) + (size_t)(m) * D) + lane; GAS v2u* o8 = (GAS v2u*)(XN2 + (size_t)(m) * D) + lane; \
        _Pragma("unroll") for (int j = 0; j < 4; ++j) { v2u hb; hb.x = pk2(hv[j].x, hv[j].y); hb.y = pk2(hv[j].z, hv[j].w); __builtin_nontemporal_store(hb, &h8[64 * j]); v2u o; o.x = pk2(hv[j].x * rstd2, hv[j].y * rstd2); o.y = pk2(hv[j].z * rstd2, hv[j].w * rstd2); o8[64 * j] = o; } } while (0)
#pragma unroll
    for (int k = 0; k < PD; ++k) P5_LOAD(k, min(gw + k * NGW, M - 1));
    int m0 = gw;
    for (; m0 + (PD - 1) * NGW < M; m0 += PD * NGW) {
#pragma unroll
        for (int k = 0; k < PD; ++k) { const int m = m0 + k * NGW;
            const float pv = bp[k]; f32x4 xv[4]; v2u zv[4];
#pragma unroll
            for (int j = 0; j < 4; ++j) { xv[j] = bx[k][j]; zv[j] = bz[k][j]; }
            P5_LOAD(k, min(m + PD * NGW, M - 1));
            P5_ROW(m, pv, xv, zv);
        }
    }
    for (int m = m0; m < M; m += NGW) {
        P5_LOAD(0, m); const float pv = bp[0]; f32x4 xv[4]; v2u zv[4];
#pragma unroll
        for (int j = 0; j < 4; ++j) { xv[j] = bx[0][j]; zv[j] = bz[0][j]; }
        P5_ROW(m, pv, xv, zv);
    }
#undef P5_ROW
#undef P5_LOAD
}
__device__ __forceinline__ void norm_ffn_phase(Frame& F) {
    const int gw = F.vcu * NWAVES + F.wave, NGW = F.G * NWAVES;
    const bf16* Z = (const bf16*)(F.ws + WS_F); const float* part = (const float*)(F.ws + WS_PART2); const float* gpost = F.in[5];
    f32x4 g[4];
#pragma unroll
    for (int j = 0; j < 4; ++j) g[j] = ((const f32x4*)gpost)[((int)(threadIdx.x & 63)) + 64 * j];
    constexpr int PD = 2;
    v2u bz[PD][4], bh[PD][4]; float bp[PD];
    const int lane = ((int)(threadIdx.x & 63));
#define P9_LOAD(k, mm) do { bp[k] = part[(size_t)(mm) * 16 + (lane & 15)]; \
        const GAS v2u* zr_ = (const GAS v2u*)(Z + (size_t)(mm) * D) + lane; const GAS v2u* hr_ = (const GAS v2u*)((const bf16*)(F.ws + WS_H1) + (size_t)(mm) * D) + lane; \
        _Pragma("unroll") for (int j = 0; j < 4; ++j) { bz[k][j] = __builtin_nontemporal_load(&zr_[64 * j]); bh[k][j] = __builtin_nontemporal_load(&hr_[64 * j]); } } while (0)
#define P9_ROW(m, pv, zv, hv) do { \
        const float rstd = __builtin_amdgcn_rsqf(row16_sum(pv) * (1.f / D) + RMS_EPS); \
        GAS f32x4* orow = (GAS f32x4*)(F.out + (size_t)(m) * D) + lane; \
        _Pragma("unroll") for (int j = 0; j < 4; ++j) { const v2u zw = zv[j], hw = hv[j]; const f32x4 z = (f32x4){bflo(zw.x), bfhi(zw.x), bflo(zw.y), bfhi(zw.y)}, hh = (f32x4){bflo(hw.x), bfhi(hw.x), bflo(hw.y), bfhi(hw.y)}; \
            __builtin_nontemporal_store(hh + z * rstd * g[j], &orow[64 * j]); } } while (0)
#pragma unroll
    for (int k = 0; k < PD; ++k) P9_LOAD(k, min(gw + k * NGW, M - 1));
    int m0 = gw;
    for (; m0 + (PD - 1) * NGW < M; m0 += PD * NGW) {
#pragma unroll
        for (int k = 0; k < PD; ++k) { const int m = m0 + k * NGW;
            const float pv = bp[k]; v2u zv[4], hv[4];
#pragma unroll
            for (int j = 0; j < 4; ++j) { zv[j] = bz[k][j]; hv[j] = bh[k][j]; }
            P9_LOAD(k, min(m + PD * NGW, M - 1));
            P9_ROW(m, pv, zv, hv);
        }
    }
    for (int m = m0; m < M; m += NGW) {
        P9_LOAD(0, m); const float pv = bp[0]; v2u zv[4], hv[4];
#pragma unroll
        for (int j = 0; j < 4; ++j) { zv[j] = bz[0][j]; hv[j] = bh[0][j]; }
        P9_ROW(m, pv, zv, hv);
    }
#undef P9_ROW
#undef P9_LOAD
}
__device__ __forceinline__ void conv_fixup_phase(Frame& F) {
    const float* halo = (const float*)(F.ws + WS_HALO); const float* cw = F.in[22]; const float* cb = F.in[23]; bf16* act = (bf16*)(F.ws + WS_ACT);
    const int gt = (F.vcu * NWAVES + F.wave) * 64 + ((int)(threadIdx.x & 63)), NT = F.G * NWAVES * 64;
    for (int e = gt; e < 256 * DFF; e += NT) {
        const int pm = e / DFF, j = e % DFF; if ((pm & 7) == 0) continue;
        const int tg = (j >> 7) * 256 + (j & 127), tv = tg + 128;
        const float* hc = halo + (size_t)pm * 4 * 5632; const float* hp = halo + (size_t)(pm - 1) * 4 * 5632;
        const float g254 = hp[2 * 5632 + tg], g255 = hp[3 * 5632 + tg], g0 = hc[tg], g1 = hc[5632 + tg];
        const float v254 = hp[2 * 5632 + tv], v255 = hp[3 * 5632 + tv], v0 = hc[tv], v1 = hc[5632 + tv];
        const float cg0 = cw[j], cg1 = cw[5632 + j], cg2 = cw[2 * 5632 + j], cgb = cb[j];
        const float cv0 = cw[DFF + j], cv1 = cw[5632 + DFF + j], cv2 = cw[2 * 5632 + DFF + j], cvb = cb[DFF + j];
        const float og0 = cgb + cg0 * g254 + cg1 * g255 + cg2 * g0, og1 = cgb + cg0 * g255 + cg1 * g0 + cg2 * g1;
        const float ov0 = cvb + cv0 * v254 + cv1 * v255 + cv2 * v0, ov1 = cvb + cv0 * v255 + cv1 * v0 + cv2 * v1;
        act[(size_t)(pm * 256) * DFF + j] = (bf16)f2bf(pg8::gelu_tanh(og0) * ov0);
        act[(size_t)(pm * 256 + 1) * DFF + j] = (bf16)f2bf(pg8::gelu_tanh(og1) * ov1);
    }
}

struct Args { const float* in[25]; float* out; unsigned char* ws; int ph_lo, ph_hi, li, pad; };
__global__ void __launch_bounds__(NWAVES * 64, 2) hyb_fwd(Args args) {
    extern __shared__ __attribute__((aligned(16))) unsigned char lds[];
    Frame F;
    F.lds = (LAS unsigned char*)lds;
    F.MISC = (volatile LAS unsigned*)(F.lds + MISC_OFF);
    F.tid = threadIdx.x; F.wave = __builtin_amdgcn_readfirstlane(F.tid >> 6);
    F.G = gridDim.x; { const int bx = blockIdx.x; F.vcu = (F.G % 8 == 0) ? (bx % 8) * (F.G / 8) + bx / 8 : bx; }
    unsigned char* ws = args.ws; F.ws = ws; F.out = args.out;
#pragma unroll
    for (int i = 0; i < 25; ++i) F.in[i] = args.in[i];
    F.ctl = (gu32*)(ws + WS_CTL);
    for (int u = F.tid; u < (LDS_BYTES - LDSCTL_OFF) / 4; u += NWAVES * 64) ((LAS unsigned*)(F.lds + LDSCTL_OFF))[u] = 0u;
    __syncthreads();
    XcdBarrier bar; bar.bar = (unsigned*)(F.ctl + CW_BAR) + args.li * XCD_BAR_WORDS; bar.x = 0; bar.st = nullptr;
    if (MK_N_LAUNCHES == 1) bar = xcd_barrier_post((unsigned*)(F.ctl + CW_BAR) + args.li * XCD_BAR_WORDS, F.MISC + 8);
    const int lo = args.ph_lo, hi = args.ph_hi;
#define IN(k) (lo <= (k) && (k) < hi)
#define SEAM(k) do { if (IN(k) && IN((k) + 1)) xcd_barrier(bar); } while (0)
    using namespace pg8;
    bf16* XN = (bf16*)((unsigned char*)F.out + OUT_XN);

    if (IN(0)) { REP(0) p0_prologue(F); } SEAM(0);
    if (IN(1)) REP(1) {
        Gemm g{XN, (const bf16_t*)(ws + WS_WIN), M, IN_COLS, D}; StaticOrder S; S.init(M, IN_COLS, F.G, (int)blockIdx.x);
        EpiIn E{(bf16_t*)(ws + WS_PRW), (bf16_t*)(ws + WS_PRET), (bf16_t*)(ws + WS_G)};
        gemm_phase<EpiIn, StaticOrder, true, true>(F.lds + RING_OFF, g, S, E);
    } SEAM(1);
    if (IN(2)) { REP(20) rwkv_phase(F); __syncthreads(); REP(21) retention_phase(F); } SEAM(2);
    if (IN(3)) REP(3) {
        Gemm g{(const bf16_t*)((unsigned char*)F.out + OUT_Y), (const bf16_t*)(ws + WS_WRW), M, D, LDY}; StaticOrder S; S.init(M, D, F.G, (int)blockIdx.x);
        EpiMerge E{(bf16_t*)(ws + WS_MERGED), (const bf16_t*)(ws + WS_G)};
        gemm_phase<EpiMerge, StaticOrder, true, true>(F.lds + RING_OFF, g, S, E);
    } SEAM(3);
    if (IN(4)) REP(4) {
        Gemm g{(const bf16_t*)(ws + WS_MERGED), (const bf16_t*)(ws + WS_WOUT), M, D, D}; StaticOrder S; S.init(M, D, F.G, (int)blockIdx.x);
        EpiZ E{(bf16_t*)(ws + WS_Z), (float*)(ws + WS_PART), (PROBE_NOSTORE != 0) && args.li == 1 && lo == 4};
        gemm_phase<EpiZ, StaticOrder, true, true>(F.lds + RING_OFF, g, S, E);
    } SEAM(4);
    if (IN(5)) { REP(5) norm_mix_phase(F); } SEAM(5);
    if (IN(6)) REP(6) {
        Gemm g{(const bf16_t*)(ws + WS_XN2), (const bf16_t*)(ws + WS_WUP), M, 2 * DFF, D}; StaticOrder S; S.init(M, 2 * DFF, F.G, (int)blockIdx.x);
        EpiConv E{(bf16_t*)(ws + WS_ACT), F.in[22], F.in[23], (float*)(ws + WS_HALO), (PG8_LAS float*)(F.lds + XCH_OFF)};
        gemm_phase<EpiConv, StaticOrder, true, true>(F.lds + RING_OFF, g, S, E);
    } SEAM(6);
    if (IN(7)) { REP(7) conv_fixup_phase(F); } SEAM(7);
    if (IN(8)) REP(8) {
        Gemm g{(const bf16_t*)(ws + WS_ACT), (const bf16_t*)(ws + WS_WDN), M, D, DFF}; StaticOrder S; S.init(M, D, F.G, (int)blockIdx.x);
        EpiZ E{(bf16_t*)(ws + WS_F), (float*)(ws + WS_PART2)};
        gemm_phase<EpiZ, StaticOrder, true, true>(F.lds + RING_OFF, g, S, E);
    } SEAM(8);
    if (IN(9)) { REP(9) norm_ffn_phase(F); }
#undef IN
#undef SEAM
}

extern "C" void kernel_launch(void* const* d_in, const int* in_sizes, int n_in, void* d_out, int out_size, void* d_ws, size_t ws_size, hipStream_t stream) {
    static int grid = 0;
    if (grid == 0) {
        if (n_in != 25 || in_sizes[0] != M * D || out_size != M * D || ws_size < WS_END) { fprintf(stderr, "kernel_launch: unexpected shapes (n_in %d, in0 %d, out %d, ws %zu); nothing launched\n", n_in, n_in > 0 ? in_sizes[0] : -1, out_size, ws_size); grid = -1; return; }
        int dev = 0, cus = 0, per_cu = 0;
        if (hipGetDevice(&dev) != hipSuccess || hipDeviceGetAttribute(&cus, hipDeviceAttributeMultiprocessorCount, dev) != hipSuccess) { grid = -1; return; }
        if (hipFuncSetAttribute((const void*)hyb_fwd, hipFuncAttributeMaxDynamicSharedMemorySize, LDS_BYTES) != hipSuccess) { fprintf(stderr, "kernel_launch: hipFuncSetAttribute failed\n"); grid = -1; return; }
        if (hipOccupancyMaxActiveBlocksPerMultiprocessor(&per_cu, (const void*)hyb_fwd, NWAVES * 64, LDS_BYTES) != hipSuccess || per_cu < 1) { fprintf(stderr, "kernel_launch: occupancy query reports %d workgroups per CU\n", per_cu); (void)hipGetLastError(); grid = -1; return; }
        (void)hipGetLastError();
        grid = cus;
    }
    if (grid < 0) return;
    if (hipMemsetAsync((char*)d_ws + WS_CTL, 0, CTL_ZERO_BYTES, stream) != hipSuccess) return;
    Args a{};
    for (int i = 0; i < 25; ++i) a.in[i] = (const float*)d_in[i];
    a.out = (float*)d_out; a.ws = (unsigned char*)d_ws;
#if MK_N_LAUNCHES == 1
    if (PROBE_SPLIT >= 0) {
        a.ph_lo = 0; a.ph_hi = PROBE_SPLIT + 1; a.li = 0; hipLaunchKernelGGL(hyb_fwd, dim3(grid), dim3(NWAVES * 64), LDS_BYTES, stream, a);
        a.ph_lo = PROBE_SPLIT; a.ph_hi = N_PHASES; a.li = 1; hipLaunchKernelGGL(hyb_fwd, dim3(grid), dim3(NWAVES * 64), LDS_BYTES, stream, a);
        return;
    }
    a.ph_lo = 0; a.ph_hi = N_PHASES; a.li = 0;
    hipLaunchKernelGGL(hyb_fwd, dim3(grid), dim3(NWAVES * 64), LDS_BYTES, stream, a);
#else
    for (int li = 0; li < N_PHASES; ++li) { a.ph_lo = li; a.ph_hi = li + 1; a.li = 0; hipLaunchKernelGGL(hyb_fwd, dim3(grid), dim3(NWAVES * 64), LDS_BYTES, stream, a); }
#endif
}
```

```cpp
#include <hip/hip_runtime.h>
#include <cstdio>
#include <cstdint>

#ifndef MK_N_LAUNCHES
#define MK_N_LAUNCHES 1
#endif
#ifndef PROBE_PH
#define PROBE_PH (-1)
#endif
#ifndef PROBE_NOSTORE
#define PROBE_NOSTORE 0
#endif
#ifndef PROBE_SPLIT
#define PROBE_SPLIT (-1)
#endif
#define REP(k) for (int _r = 0; _r < ((PROBE_PH == (k) || (PROBE_PH == 95 && ((k) == 0 || (k) == 5 || (k) == 9))) ? 2 : 1); ++_r)

namespace pg8 {
#define PG8_LAS __attribute__((address_space(3)))
typedef unsigned short bf16_t;
typedef short bf16x8 __attribute__((ext_vector_type(8)));
typedef float f32x4 __attribute__((ext_vector_type(4)));
typedef float f32x2 __attribute__((ext_vector_type(2)));
typedef unsigned u32x4 __attribute__((ext_vector_type(4)));
typedef unsigned u32x2 __attribute__((ext_vector_type(2)));
constexpr int BM = 256, BK = 64, HALF = 128, HTB = HALF * BK * 2, STAGE_BYTES = 8 * HTB, NXCD = 8, WGM = 4;

__host__ __device__ __forceinline__ int lds_byte(int r, int c) { const int st = (r >> 4) * 2 + (c >> 5), rr = r & 15, cc = c & 31, ob = rr * 64 + cc * 2; return st * 1024 + (ob ^ (((ob >> 9) & 1) << 5)); }
__host__ __device__ __forceinline__ void stage_rc(int b, int& R, int& C) { const int st = b / 1024, sb = b % 1024, swz = sb ^ (((sb >> 9) & 1) << 5); R = (st >> 1) * 16 + swz / 64; C = (st & 1) * 32 + (swz % 64) / 2; }
__host__ __device__ __forceinline__ int perm32(int rho) { const int n = rho >> 4, i = rho & 15; return 8 * (i >> 2) + 4 * n + (i & 3); }

struct Unit { int pm, pn; };
struct Gemm { const bf16_t* A; const bf16_t* Bt; int M, N, K; };

struct StaticOrder {
    int nM, nN, nwg, G, c;
    __host__ __device__ void init(int M, int N, int G_, int c_) { nM = M / BM; nN = N / BM; nwg = nM * nN; G = G_; c = c_; }
    __host__ __device__ bool next(int i, Unit& u) const {
        const long L = (long)i * G + c; if (L >= nwg) return false;
        int wgid = (int)L; { const int q = nwg / NXCD, r = nwg % NXCD, xcd = wgid % NXCD, off = wgid / NXCD; wgid = (xcd < r ? xcd * (q + 1) : r * (q + 1) + (xcd - r) * q) + off; }
        const int nig = WGM * nN, gid = wgid / nig, fm = gid * WGM, gsz = (nM - fm) < WGM ? (nM - fm) : WGM;
        u.pm = fm + ((wgid % nig) % gsz); u.pn = (wgid % nig) / gsz; return true;
    }
    __device__ __forceinline__ void a_ready(const Unit&) const {}
    __device__ __forceinline__ void done(const Unit&) const {}
};

typedef __bf16 nbf16x2 __attribute__((ext_vector_type(2)));
__device__ __forceinline__ unsigned cvt_pk_native(float lo, float hi) { const f32x2 v = {lo, hi}; return __builtin_bit_cast(unsigned, __builtin_convertvector(v, nbf16x2)); }
__device__ __forceinline__ unsigned cvt_pk_bf16(float lo, float hi) { unsigned r; asm volatile("s_nop 0\n\tv_cvt_pk_bf16_f32 %0, %1, %2" : "=v"(r) : "v"(lo), "v"(hi)); return r; }
__device__ __forceinline__ float bf_lo(unsigned w) { return __uint_as_float(w << 16); }
__device__ __forceinline__ float bf_hi(unsigned w) { return __uint_as_float(w & 0xffff0000u); }
__device__ __forceinline__ float fsigmoid(float x) { return __builtin_amdgcn_rcpf(1.0f + __builtin_amdgcn_exp2f(-1.44269504089f * x)); }


#ifndef NT_FROM
#define NT_FROM 7
#endif
struct EpiIn {
    static constexpr bool PERM = true, AFTER_DRAIN = false, IDEM = true; static constexpr int HOOK_T = 0;
    bf16_t* prw; bf16_t* pret; bf16_t* gg;
    __device__ __forceinline__ void operator()(const f32x4 (&acc)[2][2][4][2], const Unit& u, int wr, int wc, int fr, int fq) const {
        const int pn = u.pn; bf16_t* base; int ldc, colt, actk;
        if (pn < 7) { base = prw; ldc = 1792; colt = pn * 256; actk = 0; }
        else if (pn < 19) { base = pret; ldc = 3072; colt = (pn - 7) * 256; actk = (pn - 7 >= 8) ? 2 : 0; }
        else { base = gg; ldc = 2048; colt = (pn - 19) * 256; actk = 1; }
        const int row0 = u.pm * BM + wr * 64 + fr; const int col0 = colt + wc * 32 + 8 * fq;
#pragma unroll
        for (int ai = 0; ai < 2; ++ai)
#pragma unroll
            for (int m = 0; m < 4; ++m) { bf16_t* rowp = base + (size_t)(row0 + ai * HALF + m * 16) * ldc + col0;
#pragma unroll
                for (int bj = 0; bj < 2; ++bj) { f32x4 v0 = acc[ai][bj][m][0], v1 = acc[ai][bj][m][1];
                    if (actk) {
#pragma unroll
                        for (int i = 0; i < 4; ++i) { const float s0 = fsigmoid(v0[i]), s1 = fsigmoid(v1[i]); v0[i] = (actk == 2) ? v0[i] * s0 : s0; v1[i] = (actk == 2) ? v1[i] * s1 : s1; }
                    }
                    u32x4 w; w.x = cvt_pk_bf16(v0[0], v0[1]); w.y = cvt_pk_bf16(v0[2], v0[3]); w.z = cvt_pk_bf16(v1[0], v1[1]); w.w = cvt_pk_bf16(v1[2], v1[3]);
                    if (pn >= NT_FROM) __builtin_nontemporal_store(w, (u32x4*)(rowp + bj * HALF)); else *(u32x4*)(rowp + bj * HALF) = w; } }
    }
};

template <bool ADD> struct EpiGate {
    static constexpr bool PERM = true, AFTER_DRAIN = false, IDEM = false; static constexpr int HOOK_T = 0;
    bf16_t* O; const bf16_t* G; int gcol0;
    __device__ __forceinline__ void operator()(const f32x4 (&acc)[2][2][4][2], const Unit& u, int wr, int wc, int fr, int fq) const {
        const int row0 = u.pm * BM + wr * 64 + fr; const int col0 = u.pn * BM + wc * 32 + 8 * fq;
#pragma unroll
        for (int ai = 0; ai < 2; ++ai)
#pragma unroll
            for (int m = 0; m < 4; ++m) { const size_t row = (size_t)(row0 + ai * HALF + m * 16);
#pragma unroll
                for (int bj = 0; bj < 2; ++bj) { const f32x4 v0 = acc[ai][bj][m][0], v1 = acc[ai][bj][m][1];
                    const u32x4 gw = *(const u32x4*)(G + row * 2048 + gcol0 + col0 + bj * HALF);
                    float o[8];
                    o[0] = v0[0] * bf_lo(gw.x); o[1] = v0[1] * bf_hi(gw.x); o[2] = v0[2] * bf_lo(gw.y); o[3] = v0[3] * bf_hi(gw.y);
                    o[4] = v1[0] * bf_lo(gw.z); o[5] = v1[1] * bf_hi(gw.z); o[6] = v1[2] * bf_lo(gw.w); o[7] = v1[3] * bf_hi(gw.w);
                    bf16_t* op = O + row * 1024 + col0 + bj * HALF;
                    if (ADD) { const u32x4 pw = *(const u32x4*)op;
                        o[0] += bf_lo(pw.x); o[1] += bf_hi(pw.x); o[2] += bf_lo(pw.y); o[3] += bf_hi(pw.y); o[4] += bf_lo(pw.z); o[5] += bf_hi(pw.z); o[6] += bf_lo(pw.w); o[7] += bf_hi(pw.w); }
                    u32x4 w; w.x = cvt_pk_bf16(o[0], o[1]); w.y = cvt_pk_bf16(o[2], o[3]); w.z = cvt_pk_bf16(o[4], o[5]); w.w = cvt_pk_bf16(o[6], o[7]);
                    *(u32x4*)op = w; } }
    }
};

struct EpiMerge {
    static constexpr bool PERM = true, AFTER_DRAIN = false, IDEM = false; static constexpr int HOOK_T = 8;
    bf16_t* O; const bf16_t* G;
    __device__ __forceinline__ void hook(f32x4 (&acc)[2][2][4][2], const Unit& u, int wr, int wc, int fr, int fq) const {
        unsigned goff = (unsigned)((u.pm * BM + wr * 64 + fr) * 2048 + u.pn * BM + wc * 32 + 8 * fq) * 2u;
        asm volatile("" : "+v"(goff));
        const char* gp = (const char*)G;
#pragma unroll
        for (int ai = 0; ai < 2; ++ai)
#pragma unroll
            for (int m = 0; m < 4; ++m) {
#pragma unroll
                for (int bj = 0; bj < 2; ++bj) { const unsigned o = goff + (unsigned)(((ai * HALF + m * 16) * 2048 + bj * HALF) * 2);
                    const u32x4 ga = *(const u32x4*)(gp + o), gb = *(const u32x4*)(gp + o + 2048);
                    float r[8];
                    r[0] = bf_lo(ga.x) * __builtin_amdgcn_rcpf(fmaxf(bf_lo(gb.x), 1e-30f)); r[1] = bf_hi(ga.x) * __builtin_amdgcn_rcpf(fmaxf(bf_hi(gb.x), 1e-30f));
                    r[2] = bf_lo(ga.y) * __builtin_amdgcn_rcpf(fmaxf(bf_lo(gb.y), 1e-30f)); r[3] = bf_hi(ga.y) * __builtin_amdgcn_rcpf(fmaxf(bf_hi(gb.y), 1e-30f));
                    r[4] = bf_lo(ga.z) * __builtin_amdgcn_rcpf(fmaxf(bf_lo(gb.z), 1e-30f)); r[5] = bf_hi(ga.z) * __builtin_amdgcn_rcpf(fmaxf(bf_hi(gb.z), 1e-30f));
                    r[6] = bf_lo(ga.w) * __builtin_amdgcn_rcpf(fmaxf(bf_lo(gb.w), 1e-30f)); r[7] = bf_hi(ga.w) * __builtin_amdgcn_rcpf(fmaxf(bf_hi(gb.w), 1e-30f));
                    acc[ai][bj][m][0] = acc[ai][bj][m][0] * (f32x4){r[0], r[1], r[2], r[3]}; acc[ai][bj][m][1] = acc[ai][bj][m][1] * (f32x4){r[4], r[5], r[6], r[7]}; }
                asm volatile("" ::: "memory"); }
    }
    __device__ __forceinline__ void operator()(const f32x4 (&acc)[2][2][4][2], const Unit& u, int wr, int wc, int fr, int fq) const {
        const int row0 = u.pm * BM + wr * 64 + fr; const int col0 = u.pn * BM + wc * 32 + 8 * fq;
#pragma unroll
        for (int ai = 0; ai < 2; ++ai)
#pragma unroll
            for (int m = 0; m < 4; ++m) { const size_t row = (size_t)(row0 + ai * HALF + m * 16);
#pragma unroll
                for (int bj = 0; bj < 2; ++bj) { const f32x4 v0 = acc[ai][bj][m][0], v1 = acc[ai][bj][m][1];
                    const u32x4 gw = *(const u32x4*)(G + row * 2048 + 1024 + col0 + bj * HALF);
                    u32x4 w; w.x = cvt_pk_bf16(v0[0] * bf_lo(gw.x), v0[1] * bf_hi(gw.x)); w.y = cvt_pk_bf16(v0[2] * bf_lo(gw.y), v0[3] * bf_hi(gw.y));
                    w.z = cvt_pk_bf16(v1[0] * bf_lo(gw.z), v1[1] * bf_hi(gw.z)); w.w = cvt_pk_bf16(v1[2] * bf_lo(gw.w), v1[3] * bf_hi(gw.w));
                    *(u32x4*)(O + row * 1024 + col0 + bj * HALF) = w; } }
    }
};

struct EpiZ {
    static constexpr bool PERM = true, AFTER_DRAIN = false, IDEM = false; static constexpr int HOOK_T = 0;
    bf16_t* O; float* part; bool skip = false;
    __device__ __forceinline__ void operator()(const f32x4 (&acc)[2][2][4][2], const Unit& u, int wr, int wc, int fr, int fq) const {
        const int row0 = u.pm * BM + wr * 64 + fr; const int col0 = u.pn * BM + wc * 32 + 8 * fq;
#pragma unroll
        for (int ai = 0; ai < 2; ++ai)
#pragma unroll
            for (int m = 0; m < 4; ++m) { const size_t row = (size_t)(row0 + ai * HALF + m * 16); float ss = 0.f;
#pragma unroll
                for (int bj = 0; bj < 2; ++bj) { const f32x4 v0 = acc[ai][bj][m][0], v1 = acc[ai][bj][m][1];
                    ss += (v0[0] * v0[0] + v0[1] * v0[1]) + (v0[2] * v0[2] + v0[3] * v0[3]) + (v1[0] * v1[0] + v1[1] * v1[1]) + (v1[2] * v1[2] + v1[3] * v1[3]);
                    u32x4 w; w.x = cvt_pk_bf16(v0[0], v0[1]); w.y = cvt_pk_bf16(v0[2], v0[3]); w.z = cvt_pk_bf16(v1[0], v1[1]); w.w = cvt_pk_bf16(v1[2], v1[3]);
                    if (!skip) *(u32x4*)(O + row * 1024 + col0 + bj * HALF) = w; else asm volatile("" :: "v"(w)); }
                ss += __shfl_xor(ss, 16); ss += __shfl_xor(ss, 32);
                if (fq == 0 && !skip) part[row * 16 + u.pn * 4 + wc] = ss; }
    }
};

template <int CTRL> __device__ __forceinline__ float dpp0(float x) {
    return __builtin_bit_cast(float, __builtin_amdgcn_update_dpp(0, __builtin_bit_cast(int, x), CTRL, 0xf, 0xf, true));
}
__device__ __forceinline__ float gelu_tanh(float x) {
    const float in = x * (1.0f + 0.044715f * x * x);
    return x * __builtin_amdgcn_rcpf(1.0f + __builtin_amdgcn_exp2f(-2.302208198f * in));
}

struct EpiConv {
    static constexpr bool PERM = true, AFTER_DRAIN = false, IDEM = false; static constexpr int HOOK_T = 0;
    bf16_t* act; const float* cw; const float* cb; float* halo; PG8_LAS float* xch;
    __device__ __forceinline__ void operator()(const f32x4 (&acc)[2][2][4][2], const Unit& u, int wr, int wc, int fr, int fq) const {
        PG8_LAS f32x4* X = (PG8_LAS f32x4*)xch;
        if (fr >= 14) {
#pragma unroll
            for (int ai = 0; ai < 2; ++ai)
#pragma unroll
                for (int bj = 0; bj < 2; ++bj)
#pragma unroll
                    for (int n = 0; n < 2; ++n) X[(((((ai * 2 + wr) * 4 + wc) * 2 + (fr - 14)) * 2 + bj) * 2 + n) * 4 + fq] = acc[ai][bj][3][n];
        }
        {
            const int tcol = u.pn * 256 + wc * 32 + 8 * fq;
            if (wr == 0 && fr < 2) {
#pragma unroll
                for (int bj = 0; bj < 2; ++bj)
#pragma unroll
                    for (int n = 0; n < 2; ++n) *(f32x4*)(halo + ((size_t)(u.pm * 4 + fr)) * 5632 + tcol + bj * HALF + 4 * n) = acc[0][bj][0][n];
            }
            if (wr == 1 && fr >= 14) {
#pragma unroll
                for (int bj = 0; bj < 2; ++bj)
#pragma unroll
                    for (int n = 0; n < 2; ++n) *(f32x4*)(halo + ((size_t)(u.pm * 4 + 2 + (fr - 14))) * 5632 + tcol + bj * HALF + 4 * n) = acc[1][bj][3][n];
            }
        }
        asm volatile("s_waitcnt lgkmcnt(0)" ::: "memory"); __builtin_amdgcn_s_barrier(); asm volatile("" ::: "memory");
        const int j0 = u.pn * 128 + wc * 32 + 8 * fq;
        const float m0 = (fr == 0) ? 1.f : 0.f, m01 = (fr < 2) ? 1.f : 0.f;
        const bool first_tile = (u.pm & 7) == 0; (void)first_tile;
#pragma unroll
        for (int ai = 0; ai < 2; ++ai) {
            f32x4 xb[2][2];
#pragma unroll
            for (int bj = 0; bj < 2; ++bj)
#pragma unroll
                for (int n = 0; n < 2; ++n) xb[bj][n] = (f32x4){0.f, 0.f, 0.f, 0.f};
            if (!(ai == 0 && wr == 0) && fr >= 14) {
                const int sai = (wr == 1) ? ai : ai - 1, swr = (wr == 1) ? 0 : 1;
#pragma unroll
                for (int bj = 0; bj < 2; ++bj)
#pragma unroll
                    for (int n = 0; n < 2; ++n) xb[bj][n] = X[(((((sai * 2 + swr) * 4 + wc) * 2 + (fr - 14)) * 2 + bj) * 2 + n) * 4 + fq];
            }
            unsigned pk[4][4];
#pragma unroll
            for (int n = 0; n < 2; ++n) {
                const int jc = j0 + 4 * n;
                const f32x4 g0 = *(const f32x4*)(cw + jc), g1 = *(const f32x4*)(cw + 5632 + jc), g2 = *(const f32x4*)(cw + 2 * 5632 + jc), gb = *(const f32x4*)(cb + jc);
                const f32x4 v0 = *(const f32x4*)(cw + 2816 + jc), v1 = *(const f32x4*)(cw + 5632 + 2816 + jc), v2 = *(const f32x4*)(cw + 2 * 5632 + 2816 + jc), vb = *(const f32x4*)(cb + 2816 + jc);
#pragma unroll
                for (int i = 0; i < 4; ++i) {
                    const float g1m = g1[i] * m0, g0m = g0[i] * m01, v1m = v1[i] * m0, v0m = v0[i] * m01;
                    float og[4], ov[4];
#pragma unroll
                    for (int m = 0; m < 4; ++m) {
                        const float xg = acc[ai][0][m][n][i], xv = acc[ai][1][m][n][i];
                        const float pg = (m == 0) ? xb[0][n][i] : acc[ai][0][m - 1][n][i], pv = (m == 0) ? xb[1][n][i] : acc[ai][1][m - 1][n][i];
                        float a = gb[i] + g2[i] * xg; a += g1[i] * dpp0<0x111>(xg); a += g0[i] * dpp0<0x112>(xg); a += g1m * dpp0<0x121>(pg); a += g0m * dpp0<0x122>(pg);
                        float b = vb[i] + v2[i] * xv; b += v1[i] * dpp0<0x111>(xv); b += v0[i] * dpp0<0x112>(xv); b += v1m * dpp0<0x121>(pv); b += v0m * dpp0<0x122>(pv);
                        og[m] = a; ov[m] = b;
                    }
#pragma unroll
                    for (int m = 0; m < 4; ++m) og[m] = gelu_tanh(og[m]) * ov[m];
                    if (i & 1) {
#pragma unroll
                        for (int m = 0; m < 4; ++m) pk[m][n * 2 + (i >> 1)] = cvt_pk_bf16(__uint_as_float(pk[m][n * 2 + (i >> 1)]), og[m]);
                    } else {
#pragma unroll
                        for (int m = 0; m < 4; ++m) pk[m][n * 2 + (i >> 1)] = __float_as_uint(og[m]);
                    }
                }
            }
#pragma unroll
            for (int m = 0; m < 4; ++m) {
                u32x4 w; w.x = pk[m][0]; w.y = pk[m][1]; w.z = pk[m][2]; w.w = pk[m][3];
                *(u32x4*)(act + (size_t)(u.pm * BM + ai * HALF + wr * 64 + m * 16 + fr) * 2816 + j0) = w;
            }
        }
    }
};

#ifndef STAGGER_PCT
#define STAGGER_PCT 100
#endif
template <class Epi, class Sched, bool ALIGN_EPI = false, bool SP2 = false>
__device__ __forceinline__ void gemm_phase(PG8_LAS unsigned char* lds, const Gemm g, const Sched& S, const Epi& E, const int stagger_ticks = 0) {
    if (stagger_ticks > 0) {
        const unsigned long long target = __builtin_amdgcn_s_memrealtime() + (unsigned long long)((stagger_ticks * STAGGER_PCT / 100) * (int)((blockIdx.x >> 3) & 7));
        while (__builtin_amdgcn_s_memrealtime() < target) __builtin_amdgcn_s_sleep(8);
    }
    const int tid = threadIdx.x, wid = __builtin_amdgcn_readfirstlane(tid >> 6), lane = tid & 63, wr = wid >> 2, wc = wid & 3, fr = lane & 15, fq = lane >> 4;
    const int K = g.K, nt = K / BK;
    unsigned voffA[2], voffB[2];
#pragma unroll
    for (int i = 0; i < 2; ++i) { int R, C; stage_rc(tid * 16 + i * 8192, R, C); const int Rb = Epi::PERM ? ((R & ~31) + perm32(R & 31)) : R;
        voffA[i] = (unsigned)(R * K + C) * 2u; voffB[i] = (unsigned)(Rb * K + C) * 2u; }
    const size_t kstep = (size_t)(BK * 2);
    const size_t hstep = (size_t)HALF * K * 2;
    const size_t tstep = 2 * hstep;
    const unsigned ldsw = (unsigned)wid * 1024u;
    const int aoff = lds_byte(wr * 64 + fr, fq * 8), boff = lds_byte(wc * 32 + fr, fq * 8);
#define PG8_SA(b, h) (((b) * 2 + (h)) * HTB)
#define PG8_SB(b, h) ((4 + (b) * 2 + (h)) * HTB)
#define PG8_STAGE(bufoff, gbase, voff) do { _Pragma("unroll") for (int _i = 0; _i < 2; ++_i) \
        __builtin_amdgcn_global_load_lds((const unsigned*)((const char*)(gbase) + (voff)[_i]), (PG8_LAS unsigned*)(lds + (bufoff) + ldsw + _i * 8192), 16, 0, 0); } while (0)
#define PG8_LDA(dst, b, h) do { _Pragma("unroll") for (int m = 0; m < 4; ++m) _Pragma("unroll") for (int k = 0; k < 2; ++k) dst[m][k] = *(const PG8_LAS bf16x8*)(lds + PG8_SA(b, h) + aoff + m * 2048 + k * 1024); } while (0)
#define PG8_LDB(dst, b, h) do { _Pragma("unroll") for (int n = 0; n < 2; ++n) _Pragma("unroll") for (int k = 0; k < 2; ++k) dst[n][k] = *(const PG8_LAS bf16x8*)(lds + PG8_SB(b, h) + boff + n * 2048 + k * 1024); } while (0)
#define PG8_MMA(ai, bj, At, Bt) do { __builtin_amdgcn_s_setprio(1); _Pragma("unroll") for (int m = 0; m < 4; ++m) _Pragma("unroll") for (int n = 0; n < 2; ++n) _Pragma("unroll") for (int k = 0; k < 2; ++k) \
        acc[ai][bj][m][n] = __builtin_amdgcn_mfma_f32_16x16x32_bf16(Bt[n][k], At[m][k], acc[ai][bj][m][n], 0, 0, 0); __builtin_amdgcn_s_setprio(0); } while (0)
#define PG8_WAIT_V(n) asm volatile("s_waitcnt vmcnt(" #n ")" ::: "memory")
#define PG8_WAIT_L(n) asm volatile("s_waitcnt lgkmcnt(" #n ")" ::: "memory")
#define PG8_BAR __builtin_amdgcn_s_barrier()
#define PG8_SCHED __builtin_amdgcn_sched_barrier(0)
    Unit cur, nxt; int ui = 0;
    if (!S.next(0, cur)) return;
    f32x4 acc[2][2][4][2];
#pragma unroll
    for (int a = 0; a < 2; ++a)
#pragma unroll
        for (int b = 0; b < 2; ++b)
#pragma unroll
            for (int m = 0; m < 4; ++m)
#pragma unroll
                for (int n = 0; n < 2; ++n) acc[a][b][m][n] = (f32x4){0.f, 0.f, 0.f, 0.f};
    bf16x8 At[4][2], B0[2][2], B1[2][2];
    const char* cA = (const char*)g.A + (size_t)cur.pm * tstep; const char* cB = (const char*)g.Bt + (size_t)cur.pn * tstep;
    S.a_ready(cur);
    if constexpr (SP2) {
        PG8_STAGE(PG8_SB(0, 0), cB, voffB); PG8_STAGE(PG8_SB(0, 1), cB + hstep, voffB); PG8_STAGE(PG8_SA(0, 0), cA, voffA); PG8_STAGE(PG8_SA(0, 1), cA + hstep, voffA);
        if (wr == 1) PG8_BAR;
        PG8_WAIT_V(2); PG8_BAR;
        PG8_STAGE(PG8_SB(1, 0), cB + kstep, voffB); PG8_STAGE(PG8_SA(1, 0), cA + kstep, voffA); PG8_STAGE(PG8_SB(1, 1), cB + hstep + kstep, voffB);
        PG8_WAIT_V(6); PG8_BAR;
    } else {
        PG8_STAGE(PG8_SB(0, 0), cB, voffB); PG8_STAGE(PG8_SA(0, 0), cA, voffA); PG8_STAGE(PG8_SB(0, 1), cB + hstep, voffB); PG8_STAGE(PG8_SA(0, 1), cA + hstep, voffA);
        if (wr == 1) PG8_BAR;
        PG8_WAIT_V(4); PG8_BAR;
        PG8_STAGE(PG8_SB(1, 0), cB + kstep, voffB); PG8_STAGE(PG8_SA(1, 0), cA + kstep, voffA); PG8_STAGE(PG8_SB(1, 1), cB + hstep + kstep, voffB);
        PG8_WAIT_V(6); PG8_BAR;
    }
    for (;;) {
        const bool has_next = S.next(ui + 1, nxt);
        const char* nA = has_next ? (const char*)g.A + (size_t)nxt.pm * tstep : cA; const char* nB = has_next ? (const char*)g.Bt + (size_t)nxt.pn * tstep : cB;
        for (int t = 0; t < nt; t += 2) {
            const bool last = (t == nt - 2);
            const char* a1 = cA + (size_t)(t + 1) * kstep;
            const char* a2 = last ? nA : cA + (size_t)(t + 2) * kstep; const char* b2 = last ? nB : cB + (size_t)(t + 2) * kstep;
            const char* a3 = a2 + kstep; const char* b3 = b2 + kstep;
            if (last && has_next) S.a_ready(nxt);
            if constexpr (Epi::HOOK_T > 0) { if (t == Epi::HOOK_T) E.hook(acc, cur, wr, wc, fr, fq); }
            if constexpr (SP2) {
            PG8_LDB(B0, 0, 0); PG8_LDB(B1, 0, 1); PG8_SCHED; PG8_LDA(At, 0, 0); PG8_STAGE(PG8_SA(1, 1), a1 + hstep, voffA);
            PG8_WAIT_V(8); PG8_WAIT_L(0); PG8_BAR; PG8_MMA(0, 0, At, B0); PG8_MMA(0, 1, At, B1); PG8_BAR; PG8_SCHED;
            PG8_LDA(At, 0, 1); PG8_STAGE(PG8_SB(0, 0), b2, voffB); PG8_STAGE(PG8_SB(0, 1), b2 + hstep, voffB); PG8_STAGE(PG8_SA(0, 0), a2, voffA);
            PG8_WAIT_V(8); PG8_WAIT_L(0); PG8_BAR; PG8_MMA(1, 0, At, B0); PG8_MMA(1, 1, At, B1); PG8_BAR; PG8_SCHED;
            PG8_LDB(B0, 1, 0); PG8_LDB(B1, 1, 1); PG8_SCHED; PG8_LDA(At, 1, 0); PG8_STAGE(PG8_SA(0, 1), a2 + hstep, voffA);
            PG8_WAIT_V(8); PG8_WAIT_L(0); PG8_BAR; PG8_MMA(0, 0, At, B0); PG8_MMA(0, 1, At, B1); PG8_BAR; PG8_SCHED;
            PG8_LDA(At, 1, 1); PG8_STAGE(PG8_SB(1, 0), b3, voffB); PG8_STAGE(PG8_SB(1, 1), b3 + hstep, voffB); PG8_STAGE(PG8_SA(1, 0), a3, voffA);
            PG8_WAIT_V(8); PG8_WAIT_L(0); PG8_BAR; PG8_MMA(1, 0, At, B0); PG8_MMA(1, 1, At, B1); PG8_BAR; PG8_SCHED;
            } else {
            PG8_LDB(B0, 0, 0); PG8_SCHED; PG8_LDA(At, 0, 0); PG8_STAGE(PG8_SA(1, 1), a1 + hstep, voffA);
            PG8_WAIT_L(8); PG8_BAR; PG8_WAIT_L(0); PG8_MMA(0, 0, At, B0); PG8_BAR; PG8_SCHED;
            PG8_LDB(B1, 0, 1); PG8_STAGE(PG8_SB(0, 0), b2, voffB);
            PG8_BAR; PG8_WAIT_L(0); PG8_MMA(0, 1, At, B1); PG8_BAR;
            PG8_LDA(At, 0, 1); PG8_STAGE(PG8_SA(0, 0), a2, voffA);
            PG8_BAR; PG8_WAIT_L(0); PG8_MMA(1, 0, At, B0); PG8_BAR; PG8_SCHED;
            PG8_STAGE(PG8_SB(0, 1), b2 + hstep, voffB);
            PG8_WAIT_V(6); PG8_BAR; PG8_MMA(1, 1, At, B1); PG8_BAR;
            PG8_LDB(B0, 1, 0); PG8_SCHED; PG8_LDA(At, 1, 0); PG8_STAGE(PG8_SA(0, 1), a2 + hstep, voffA);
            PG8_WAIT_L(8); PG8_BAR; PG8_WAIT_L(0); PG8_MMA(0, 0, At, B0); PG8_BAR; PG8_SCHED;
            PG8_LDB(B1, 1, 1); PG8_STAGE(PG8_SB(1, 0), b3, voffB);
            PG8_BAR; PG8_WAIT_L(0); PG8_MMA(0, 1, At, B1); PG8_BAR;
            PG8_LDA(At, 1, 1); PG8_STAGE(PG8_SA(1, 0), a3, voffA);
            PG8_BAR; PG8_WAIT_L(0); PG8_MMA(1, 0, At, B0); PG8_BAR; PG8_SCHED;
            PG8_STAGE(PG8_SB(1, 1), b3 + hstep, voffB);
            PG8_WAIT_V(6); PG8_BAR; PG8_MMA(1, 1, At, B1); PG8_BAR;
            }
        }
        if constexpr (ALIGN_EPI) { if (wr == 0) PG8_BAR; }
        if constexpr (!Epi::AFTER_DRAIN) { E(acc, cur, wr, wc, fr, fq); if constexpr (Epi::IDEM && PROBE_PH == 300) E(acc, cur, wr, wc, fr, fq); S.done(cur); }
        if (!has_next) break;
#pragma unroll
        for (int a = 0; a < 2; ++a)
#pragma unroll
            for (int b = 0; b < 2; ++b)
#pragma unroll
                for (int m = 0; m < 4; ++m)
#pragma unroll
                    for (int n = 0; n < 2; ++n) acc[a][b][m][n] = (f32x4){0.f, 0.f, 0.f, 0.f};
        cur = nxt; cA = nA; cB = nB; ++ui;
        if constexpr (ALIGN_EPI) { if (wr == 1) PG8_BAR; }
    }
    PG8_WAIT_V(0);
    if constexpr (!ALIGN_EPI) { if (wr == 0) PG8_BAR; }
    PG8_BAR;
#undef PG8_SA
#undef PG8_SB
#undef PG8_STAGE
#undef PG8_LDA
#undef PG8_LDB
#undef PG8_MMA
#undef PG8_WAIT_V
#undef PG8_WAIT_L
#undef PG8_BAR
#undef PG8_SCHED
}
}

constexpr int NWAVES = 8;
constexpr int BATCH = 32, T = 2048, D = 1024, M = BATCH * T;
constexpr int RWH = 8, RWN = 64, RWW = 512, RW_COLS = 1792;
constexpr int RTH = 8, RDK = 64, RDV = 128, RET_COLS = 3072, RCH = 128;
constexpr int IN_COLS = 6912, DFF = 2816;
constexpr float RMS_EPS = 1e-6f, RW_GN_EPS = 64e-5f, RET_GN_EPS = 1e-5f;
constexpr int N_PHASES = 10;

constexpr size_t MiB = 1u << 20;
constexpr size_t WS_CTL = 0, CTL_ZERO_BYTES = 1 * MiB;
constexpr size_t WS_WIN = 2 * MiB, WS_WRW = 16 * MiB, WS_WRET = 17 * MiB, WS_WOUT = 19 * MiB, WS_WUP = 21 * MiB, WS_WDN = 32 * MiB;
constexpr size_t WS_ROPE = 38 * MiB, WS_PART = 54 * MiB, WS_PART2 = 58 * MiB, WS_HALO = 62 * MiB, WS_RWW = 84 * MiB;
constexpr size_t WS_PRW = 88 * MiB, WS_PRET = 312 * MiB, WS_G = 696 * MiB, WS_END = 952 * MiB;
constexpr size_t WS_MERGED = WS_PRW, WS_Z = WS_PRET, WS_XN2 = WS_G, WS_H1 = WS_G + 128 * MiB, WS_ACT = WS_PRET, WS_F = WS_PRW;
static_assert(WS_WIN + (size_t)IN_COLS * D * 2 <= WS_WRW && WS_WUP + (size_t)2 * DFF * D * 2 <= WS_WDN && WS_WDN + (size_t)D * DFF * 2 <= WS_ROPE, "ws map: weights");
static_assert(WS_ROPE + (size_t)M * 32 * 8 <= WS_PART && WS_HALO + (size_t)256 * 4 * 5632 * 4 <= WS_RWW && WS_RWW + 4 * MiB <= WS_PRW, "ws map: tables");
static_assert(WS_PRW + (size_t)M * RW_COLS * 2 <= WS_PRET && WS_PRET + (size_t)M * RET_COLS * 2 <= WS_G && WS_G + (size_t)M * 2048 * 2 <= WS_END, "ws map: activations");
static_assert(WS_ACT + (size_t)M * DFF * 2 <= WS_G, "ws map: act");
constexpr int CW_BAR = 4096;
constexpr size_t OUT_XN = 0, OUT_Y = 0;
constexpr int LDY = 1536;

constexpr int RING_OFF = 0, RING_BYTES = 131072;
constexpr int XCH_OFF = RING_BYTES, XCH_BYTES = 16384;
constexpr int LDSCTL_OFF = 160 * 1024 - 512, MISC_OFF = LDSCTL_OFF + 320;
constexpr int LDS_BYTES = 160 * 1024;
static_assert(MISC_OFF + 128 <= LDS_BYTES, "LDS map");

#define GAS __attribute__((address_space(1)))
#define LAS __attribute__((address_space(3)))
typedef unsigned short bf16;
typedef unsigned v4u __attribute__((ext_vector_type(4)));
typedef unsigned v2u __attribute__((ext_vector_type(2)));
typedef float f32x4 __attribute__((ext_vector_type(4)));
typedef float f32x2 __attribute__((ext_vector_type(2)));
typedef short bf16x8 __attribute__((ext_vector_type(8)));
typedef GAS unsigned gu32;
#define RLX_AGENT __ATOMIC_RELAXED, __HIP_MEMORY_SCOPE_AGENT
#define LDS_WAIT() asm volatile("s_waitcnt lgkmcnt(0)" ::: "memory")
#define VM_WAIT() asm volatile("s_waitcnt vmcnt(0)" ::: "memory")
__device__ __forceinline__ unsigned f2bf(float f) { unsigned u = __builtin_bit_cast(unsigned, f); return (u + 0x7fffu + ((u >> 16) & 1u)) >> 16; }
__device__ __forceinline__ unsigned pk2(float lo, float hi) { return pg8::cvt_pk_native(lo, hi); }
__device__ __forceinline__ float bflo(unsigned w) { return __uint_as_float(w << 16); }
__device__ __forceinline__ float bfhi(unsigned w) { return __uint_as_float(w & 0xffff0000u); }
__device__ __forceinline__ float bf1(bf16 v) { return __uint_as_float((unsigned)v << 16); }

#define XB_TMO      128
#define XB_XCNT(j)  (256  + 64 * (j))
#define XB_XSUB(j)  (1280 + 64 * (j))
#define XB_XGEN(j)  (2304 + 64 * (j))
#define XB_TOP      3328
#define XB_TOPGEN   3392
#define XCD_BAR_WORDS 3456
#define XB_SPIN_CAP (1u << 20)

__device__ __forceinline__ unsigned xb_ld(unsigned* p)              { return __hip_atomic_load(p, __ATOMIC_RELAXED, __HIP_MEMORY_SCOPE_AGENT); }
__device__ __forceinline__ unsigned xb_add(unsigned* p, unsigned v) { return __hip_atomic_fetch_add(p, v, __ATOMIC_RELAXED, __HIP_MEMORY_SCOPE_AGENT); }
__device__ __forceinline__ unsigned xb_xcc_id() { return (unsigned)__builtin_amdgcn_s_getreg((3 << 11) | 20) & 0xFu; }
#define XB_SPIN(cond, bar) do { unsigned _sp = 0; while (cond) { __builtin_amdgcn_s_sleep(1); \
    if ((++_sp & 255u) == 0u) { if (xb_ld(&(bar)[XB_TMO])) break; if (_sp > XB_SPIN_CAP) { atomicAdd(&(bar)[XB_TMO], 1u); break; } } } } while (0)

struct XcdBarrier { unsigned* bar; unsigned x; volatile LAS unsigned* st; };

__device__ __forceinline__ XcdBarrier xcd_barrier_post(unsigned* bar, volatile LAS unsigned* st) {
    XcdBarrier b; b.bar = bar; b.x = xb_xcc_id(); b.st = st;
    if (threadIdx.x == 0) (void)xb_add(&bar[XB_XCNT(b.x)], 1u);
    return b;
}
__device__ __forceinline__ void xcd_barrier_complete(unsigned* bar, unsigned x, unsigned& nloc, unsigned& nx) {
    const unsigned G = gridDim.x * gridDim.y * gridDim.z;
    unsigned sum, cnt, mine, sp = 0u;
    for (;;) {
        sum = 0u; cnt = 0u; mine = 0u;
#pragma unroll
        for (unsigned j = 0; j < 16; ++j) { const unsigned c = xb_ld(&bar[XB_XCNT(j)]); sum += c; cnt += (c > 0u) ? 1u : 0u; mine = (j == x) ? c : mine; }
        if (sum == G) break;
        __builtin_amdgcn_s_sleep(1);
        if ((++sp & 255u) == 0u) { if (xb_ld(&bar[XB_TMO])) break; if (sp > XB_SPIN_CAP) { atomicAdd(&bar[XB_TMO], 1u); break; } }
    }
    nloc = mine > 0u ? mine : 1u; nx = cnt > 0u ? cnt : 1u;
}
__device__ __forceinline__ void xcd_barrier(const XcdBarrier& b) {
    asm volatile("s_waitcnt vmcnt(0)" ::: "memory");
    __syncthreads();
    if (threadIdx.x == 0) {
        unsigned* bar = b.bar;
        __builtin_amdgcn_s_waitcnt(0);
        unsigned nloc = b.st[0], nx = b.st[1];
        if (nloc == 0u) { xcd_barrier_complete(bar, b.x, nloc, nx); b.st[0] = nloc; b.st[1] = nx; }
        const unsigned old = xb_add(&bar[XB_XSUB(b.x)], 1u);
        const unsigned gen = old / nloc;
        if (old + 1u == (gen + 1u) * nloc) {
            __builtin_amdgcn_fence(__ATOMIC_RELEASE, "agent");
            asm volatile("s_waitcnt vmcnt(0)" ::: "memory");
            const unsigned og = xb_add(&bar[XB_TOP], 1u);
            const unsigned tg = og / nx;
            if (og + 1u == (tg + 1u) * nx) xb_add(&bar[XB_TOPGEN], 1u);
            else XB_SPIN(xb_ld(&bar[XB_TOPGEN]) == tg, bar);
            __builtin_amdgcn_fence(__ATOMIC_ACQUIRE, "agent");
            xb_add(&bar[XB_XGEN(b.x)], 1u);
            asm volatile("s_waitcnt vmcnt(0)" ::: "memory");
        } else {
            XB_SPIN(xb_ld(&bar[XB_XGEN(b.x)]) == gen, bar);
            __builtin_amdgcn_fence(__ATOMIC_ACQUIRE, "agent");
            asm volatile("s_waitcnt vmcnt(0)" ::: "memory");
        }
    }
    __syncthreads();
}

struct Frame {
    LAS unsigned char* lds;
    volatile LAS unsigned* MISC;
    gu32* ctl;
    int tid, wave;
    int vcu, G;
    const float* in[25]; float* out; unsigned char* ws;
};

template <int CTRL> __device__ __forceinline__ float dppx(float x) {
    return __builtin_bit_cast(float, __builtin_amdgcn_mov_dpp(__builtin_bit_cast(int, x), CTRL, 0xf, 0xf, true));
}
#define DPP_GUARD1(a) asm volatile("s_nop 4" : "+v"(a))
#define DPP_GUARD4(a, b, c, d) asm volatile("s_nop 4" : "+v"(a), "+v"(b), "+v"(c), "+v"(d))
template <int CTRL> __device__ __forceinline__ float dpp_add(float v) { DPP_GUARD1(v); return v + dppx<CTRL>(v); }
__device__ __forceinline__ float row16_sum(float v) {
    v = dpp_add<0xB1>(v); v = dpp_add<0x4E>(v); v = dpp_add<0x141>(v); v = dpp_add<0x128>(v); return v;
}
template <int CTRL> __device__ __forceinline__ void dpp_add4(float (&v)[4]) {
    DPP_GUARD4(v[0], v[1], v[2], v[3]);
    const float t0 = dppx<CTRL>(v[0]), t1 = dppx<CTRL>(v[1]), t2 = dppx<CTRL>(v[2]), t3 = dppx<CTRL>(v[3]);
    v[0] += t0; v[1] += t1; v[2] += t2; v[3] += t3;
}
#define DPP_STEP2(ctrl) "v_add_f32_dpp %0, %0, %0 " ctrl " row_mask:0xf bank_mask:0xf bound_ctrl:1\n\tv_add_f32_dpp %1, %1, %1 " ctrl " row_mask:0xf bank_mask:0xf bound_ctrl:1\n\t"
#define DPP_CHAIN2(a, b, steps) asm volatile("s_nop 1\n\t" steps : "+v"(a), "+v"(b))
__device__ __forceinline__ void row16_sum4(float (&v)[4]) { dpp_add4<0xB1>(v); dpp_add4<0x4E>(v); dpp_add4<0x141>(v); dpp_add4<0x128>(v); }
__device__ __forceinline__ float wave_sum(float v) {
    v = row16_sum(v);
    const float s0 = __builtin_bit_cast(float, __builtin_amdgcn_readlane(__builtin_bit_cast(int, v), 0)), s1 = __builtin_bit_cast(float, __builtin_amdgcn_readlane(__builtin_bit_cast(int, v), 16));
    const float s2 = __builtin_bit_cast(float, __builtin_amdgcn_readlane(__builtin_bit_cast(int, v), 32)), s3 = __builtin_bit_cast(float, __builtin_amdgcn_readlane(__builtin_bit_cast(int, v), 48));
    return (s0 + s1) + (s2 + s3);
}

__device__ __forceinline__ void p0_transpose_item(const float* W, int N, bf16* WT, int ldw, int k0, int n0, int drow0, const float* kscale, LAS float* scr, int lane) {
    {
        const int kr = lane >> 3, c4 = 4 * (lane & 7);
        f32x4 v[8];
#pragma unroll
        for (int i = 0; i < 8; ++i) v[i] = __builtin_nontemporal_load((const f32x4*)(W + (size_t)(k0 + kr + 8 * i) * N + n0 + c4));
#pragma unroll
        for (int i = 0; i < 8; ++i) { const int kk = kr + 8 * i; f32x4 t = v[i]; if (kscale) t = t * kscale[k0 + kk];
            LAS float* d = scr + kk * 33 + c4; d[0] = t.x; d[1] = t.y; d[2] = t.z; d[3] = t.w; }
    }
    LDS_WAIT(); asm volatile("" ::: "memory");
    const int c = lane & 7;
#pragma unroll
    for (int j = 0; j < 4; ++j) { const int n = (lane >> 3) + 8 * j; const LAS float* s = scr + (8 * c) * 33 + n;
        v4u o; o.x = pk2(s[0 * 33], s[1 * 33]); o.y = pk2(s[2 * 33], s[3 * 33]); o.z = pk2(s[4 * 33], s[5 * 33]); o.w = pk2(s[6 * 33], s[7 * 33]);
        *(GAS v4u*)(WT + (size_t)(drow0 + n) * ldw + k0 + 8 * c) = o; }
    LDS_WAIT(); asm volatile("" ::: "memory");
}
__device__ __forceinline__ void p0_prologue(Frame& F) {
    LAS float* scr = (LAS float*)(F.lds + RING_OFF + F.wave * 16384);
    const int gw = F.vcu * NWAVES + F.wave, NGW = F.G * NWAVES;
    unsigned char* ws = F.ws;
    constexpr int I_IN = (D / 64) * (IN_COLS / 32), I_RW = (RWW / 64) * (D / 32), I_RET = (D / 64) * (D / 32), I_OUT = I_RET, I_UP = (D / 64) * (2 * DFF / 32), I_DN = (DFF / 64) * (D / 32);
    constexpr int I_W2 = (64 / 64) * (RWW / 32), I_G2 = (128 / 64) * (RWW / 32);
    constexpr int NITEMS = I_IN + I_RW + I_RET + I_OUT + I_UP + I_DN + 2 * I_W2 + I_G2;
    for (int it = gw; it < NITEMS; it += NGW) {
        int r = it;
        if (r < I_IN) { const int nb = IN_COLS / 32, kb = r / nb, n0 = 32 * (r % nb); p0_transpose_item(F.in[6], IN_COLS, (bf16*)(ws + WS_WIN), D, 64 * kb, n0, n0, F.in[2], scr, ((int)(threadIdx.x & 63))); continue; } r -= I_IN;
        if (r < I_RW) { const int nb = D / 32, kb = r / nb, n0 = 32 * (r % nb); p0_transpose_item(F.in[18], D, (bf16*)(ws + WS_WRW), RWW + D, 64 * kb, n0, n0, nullptr, scr, ((int)(threadIdx.x & 63))); continue; } r -= I_RW;
        if (r < I_RET) { const int nb = D / 32, kb = r / nb, n0 = 32 * (r % nb); p0_transpose_item(F.in[19], D, (bf16*)(ws + WS_WRW) + RWW, RWW + D, 64 * kb, n0, n0, nullptr, scr, ((int)(threadIdx.x & 63))); continue; } r -= I_RET;
        if (r < I_OUT) { const int nb = D / 32, kb = r / nb, n0 = 32 * (r % nb); p0_transpose_item(F.in[20], D, (bf16*)(ws + WS_WOUT), D, 64 * kb, n0, n0, nullptr, scr, ((int)(threadIdx.x & 63))); continue; } r -= I_OUT;
        if (r < I_UP) { const int nb = 2 * DFF / 32, kb = r / nb, n0 = 32 * (r % nb);
            const int j = (n0 < DFF) ? n0 : n0 - DFF, drow = (j / 128) * 256 + (j % 128) + ((n0 < DFF) ? 0 : 128);
            p0_transpose_item(F.in[21], 2 * DFF, (bf16*)(ws + WS_WUP), D, 64 * kb, n0, drow, F.in[4], scr, ((int)(threadIdx.x & 63))); continue; } r -= I_UP;
        if (r < I_DN) { const int nb = D / 32, kb = r / nb, n0 = 32 * (r % nb); p0_transpose_item(F.in[24], D, (bf16*)(ws + WS_WDN), DFF, 64 * kb, n0, n0, nullptr, scr, ((int)(threadIdx.x & 63))); continue; } r -= I_DN;
        if (r < I_W2) { const int n0 = 32 * r; p0_transpose_item(F.in[9], RWW, (bf16*)(ws + WS_RWW), 64, 0, n0, n0, nullptr, scr, ((int)(threadIdx.x & 63))); continue; } r -= I_W2;
        if (r < I_W2) { const int n0 = 32 * r; p0_transpose_item(F.in[11], RWW, (bf16*)(ws + WS_RWW + 65536), 64, 0, n0, n0, nullptr, scr, ((int)(threadIdx.x & 63))); continue; } r -= I_W2;
        { const int nb = RWW / 32, kb = r / nb, n0 = 32 * (r % nb); p0_transpose_item(F.in[12], RWW, (bf16*)(ws + WS_RWW + 131072), 128, 64 * kb, n0, n0, nullptr, scr, ((int)(threadIdx.x & 63))); }
    }
    const float* x = F.in[0]; bf16* XN = (bf16*)((unsigned char*)F.out + OUT_XN);
    {
        constexpr int PD = 2;
        f32x4 buf[PD][4];
        const int lane = ((int)(threadIdx.x & 63));
#pragma unroll
        for (int k = 0; k < PD; ++k) { const int mm = min(gw + k * NGW, M - 1); const GAS f32x4* xr = (const GAS f32x4*)(x + (size_t)mm * D) + lane;
#pragma unroll
            for (int j = 0; j < 4; ++j) buf[k][j] = __builtin_nontemporal_load(&xr[64 * j]); }
        int m0 = gw;
        for (; m0 + (PD - 1) * NGW < M; m0 += PD * NGW) {
#pragma unroll
            for (int k = 0; k < PD; ++k) { const int m = m0 + k * NGW;
                f32x4 v[4]; float s = 0.f;
#pragma unroll
                for (int j = 0; j < 4; ++j) v[j] = buf[k][j];
                { const int mn = min(m + PD * NGW, M - 1); const GAS f32x4* xr = (const GAS f32x4*)(x + (size_t)mn * D) + lane;
#pragma unroll
                    for (int j = 0; j < 4; ++j) buf[k][j] = __builtin_nontemporal_load(&xr[64 * j]); }
#pragma unroll
                for (int j = 0; j < 4; ++j) s += (v[j].x * v[j].x + v[j].y * v[j].y) + (v[j].z * v[j].z + v[j].w * v[j].w);
                const float rstd = __builtin_amdgcn_rsqf(wave_sum(s) * (1.f / D) + RMS_EPS);
                GAS v2u* o8 = (GAS v2u*)(XN + (size_t)m * D) + lane;
#pragma unroll
                for (int j = 0; j < 4; ++j) { v2u o; o.x = pk2(v[j].x * rstd, v[j].y * rstd); o.y = pk2(v[j].z * rstd, v[j].w * rstd); o8[64 * j] = o; }
            }
        }
        for (int m = m0; m < M; m += NGW) {
            const GAS f32x4* xr = (const GAS f32x4*)(x + (size_t)m * D) + lane; f32x4 v[4]; float s = 0.f;
#pragma unroll
            for (int j = 0; j < 4; ++j) { v[j] = xr[64 * j]; s += (v[j].x * v[j].x + v[j].y * v[j].y) + (v[j].z * v[j].z + v[j].w * v[j].w); }
            const float rstd = __builtin_amdgcn_rsqf(wave_sum(s) * (1.f / D) + RMS_EPS);
            GAS v2u* o8 = (GAS v2u*)(XN + (size_t)m * D) + lane;
#pragma unroll
            for (int j = 0; j < 4; ++j) { v2u o; o.x = pk2(v[j].x * rstd, v[j].y * rstd); o.y = pk2(v[j].z * rstd, v[j].w * rstd); o8[64 * j] = o; }
        }
    }
    {
        const int* pos = (const int*)F.in[1]; f32x2* rope = (f32x2*)(ws + WS_ROPE);
        const int gt = (F.vcu * NWAVES + F.wave) * 64 + ((int)(threadIdx.x & 63)), NT = F.G * NWAVES * 64;
        const int j = gt & 31;
        const double inv = exp2(-(double)j * (13.287712379549449 / 32.0));
        for (int e = gt; e < M * 32; e += NT) {
            const int row = e >> 5;
            double a = (double)pos[row] * inv; a -= 6.283185307179586 * rint(a * 0.15915494309189535);
            float sn, cs; sincosf((float)a, &sn, &cs);
            rope[e] = (f32x2){cs, sn};
        }
    }
}

constexpr int RW_TC = 32;
constexpr int RWL_STEP = 0, RWL_YP = 49152, RWL_GATE = 81920, RWL_BV = 90112, RWL_AW = 98304, RWL_AA = 102912, RWL_AG = 107520, RWL_W2T = 116224, RWL_A2T = 125440, RWL_G2T = 134656, RWL_MU = 152064, RWL_BK = 153856, RWL_VT = 154112, RWL_END = 162304;
static_assert(RWL_END <= LDSCTL_OFF, "rwkv lds");
#define LBAR() do { asm volatile("s_waitcnt lgkmcnt(0)" ::: "memory"); __builtin_amdgcn_s_barrier(); asm volatile("" ::: "memory"); } while (0)
__device__ __forceinline__ float fexp2(float x) { return __builtin_amdgcn_exp2f(x); }
__device__ __forceinline__ float frcp(float x) { return __builtin_amdgcn_rcpf(x); }
__device__ __forceinline__ float fsig(float x) { return frcp(1.0f + fexp2(-1.44269504089f * x)); }
__device__ __forceinline__ float ftanh(float x) { return 1.0f - 2.0f * frcp(1.0f + fexp2(2.88539008178f * x)); }
__device__ __forceinline__ unsigned cvtpk(float lo, float hi) { return pg8::cvt_pk_native(lo, hi); }
template <int KIND> __device__ __forceinline__ bf16x8 frag_map(bf16x8 v) {
    v4u u = __builtin_bit_cast(v4u, v);
#pragma unroll
    for (int i = 0; i < 4; ++i) { const float lo = bflo(u[i]), hi = bfhi(u[i]); u[i] = (KIND == 1) ? cvtpk(ftanh(lo), ftanh(hi)) : cvtpk(fsig(lo), fsig(hi)); }
    return __builtin_bit_cast(bf16x8, u);
}

typedef short rw_s4 __attribute__((ext_vector_type(4)));
__device__ __forceinline__ void rwkv_phase(Frame& F) {
    LAS unsigned char* L = F.lds;
    LAS float* STEP = (LAS float*)(L + RWL_STEP);
    LAS float* YP = (LAS float*)(L + RWL_YP);
    LAS float* DECP = (LAS float*)(L + RWL_YP + 8192);
    LAS unsigned* ZW = (LAS unsigned*)(L + RWL_YP + 24576);
    LAS unsigned* BBKX = (LAS unsigned*)(L + RWL_YP + 16384);
    LAS bf16* GATEB = (LAS bf16*)(L + RWL_GATE);
    LAS float* BV = (LAS float*)(L + RWL_BV);
    LAS float* VT = (LAS float*)(L + RWL_VT);
    LAS bf16* AW = (LAS bf16*)(L + RWL_AW);
    LAS bf16* AA = (LAS bf16*)(L + RWL_AA);
    LAS bf16* AG = (LAS bf16*)(L + RWL_AG);
    LAS bf16* W2T = (LAS bf16*)(L + RWL_W2T);
    LAS bf16* A2T = (LAS bf16*)(L + RWL_A2T);
    LAS bf16* G2T = (LAS bf16*)(L + RWL_G2T);
    LAS float* MU = (LAS float*)(L + RWL_MU);
    const int tid = F.tid, lane = ((int)(threadIdx.x & 63)), w = F.wave;
    const int pt = tid & 255;
    const bf16* PRW = (const bf16*)(F.ws + WS_PRW);
    bf16* Yrw = (bf16*)((unsigned char*)F.out + OUT_Y);
    const float* mu = F.in[7]; const float* w0 = F.in[8]; const float* a0 = F.in[10]; const float* k_k = F.in[13]; const float* k_a = F.in[14]; const float* r_k = F.in[15];
    const float* lnw = F.in[16]; const float* lnb = F.in[17];
    int itt[7], icc[7];
#pragma unroll
    for (int q = 0; q < 3; ++q) { const int it = pt + 256 * q; itt[q] = it / 24; icc[q] = it % 24; }
#pragma unroll
    for (int q = 3; q < 7; ++q) { const int it = pt + 256 * (q - 3); itt[q] = it >> 5; icc[q] = 24 + (it & 31); }
    const int tt2 = tid >> 4, c4 = 4 * (tid & 15);
    constexpr int NC = T / RW_TC;
    for (int unit = F.vcu; unit < BATCH * RWH; unit += F.G) {
        const int b = unit >> 3, h = unit & 7;
        __syncthreads();
        {
            const bf16* w2g = (const bf16*)(F.ws + WS_RWW) + (size_t)h * 64 * 64; const bf16* a2g = (const bf16*)(F.ws + WS_RWW + 65536) + (size_t)h * 64 * 64; const bf16* g2g = (const bf16*)(F.ws + WS_RWW + 131072) + (size_t)h * 64 * 128;
            { const int n = tid >> 3, c = tid & 7; *(LAS v4u*)(W2T + n * 72 + 8 * c) = *(const v4u*)(w2g + n * 64 + 8 * c); *(LAS v4u*)(A2T + n * 72 + 8 * c) = *(const v4u*)(a2g + n * 64 + 8 * c); }
#pragma unroll
            for (int q = 0; q < 2; ++q) { const int e = tid + 512 * q, n = e >> 4, c = e & 15; *(LAS v4u*)(G2T + n * 136 + 8 * c) = *(const v4u*)(g2g + n * 128 + 8 * c); }
            if (tid < 4) ZW[tid] = 0u;
            if (tid < 448) { const int cc = tid >> 3; int gc; if (cc < 8) gc = h * 64 + 8 * cc; else if (cc < 16) gc = 512 + h * 64 + 8 * (cc - 8); else if (cc < 24) gc = 1024 + h * 64 + 8 * (cc - 16); else gc = 1536 + 8 * (cc - 24);
                MU[tid] = mu[gc + (tid & 7)]; }
        }
        int igc[7];
#pragma unroll
        for (int q = 0; q < 7; ++q) { const int cc = icc[q]; igc[q] = (cc < 8) ? h * 64 + 8 * cc : (cc < 16) ? 512 + h * 64 + 8 * (cc - 8) : (cc < 24) ? 1024 + h * 64 + 8 * (cc - 16) : 1536 + 8 * (cc - 24); }
        const f32x4 w0v = *(const f32x4*)(w0 + h * 64 + c4), a0v = *(const f32x4*)(a0 + h * 64 + c4), kkv = *(const f32x4*)(k_k + h * 64 + c4), kav = *(const f32x4*)(k_a + h * 64 + c4);
        const f32x4 rkv = *(const f32x4*)(r_k + h * 64 + c4), lwv = *(const f32x4*)(lnw + h * 64 + c4), lbv = *(const f32x4*)(lnb + h * 64 + c4);
        f32x4 SM[4]; v4u bS0 = (v4u){0u, 0u, 0u, 0u}, bS1 = bS0;
#pragma unroll
        for (int t = 0; t < 4; ++t) SM[t] = (f32x4){0.f, 0.f, 0.f, 0.f};
        LBAR();
#define RW_STAGE_A(cn) do { \
            v4u rc[7], rp[7];        \
            _Pragma("unroll") for (int q = 0; q < 7; ++q) { const size_t row = (size_t)b * T + (size_t)(cn) * RW_TC + itt[q]; rc[q] = *(const v4u*)(PRW + row * RW_COLS + igc[q]); \
                rp[q] = ((cn) > 0 || itt[q] > 0) ? *(const v4u*)(PRW + (row - 1) * RW_COLS + igc[q]) : (v4u){0u, 0u, 0u, 0u}; } \
            _Pragma("unroll") for (int q = 0; q < 7; ++q) { \
                const int tt = itt[q], cc = icc[q]; const v4u cw = rc[q], pw = rp[q]; \
                const f32x4 m0 = *(const LAS f32x4*)(MU + cc * 8), m1 = *(const LAS f32x4*)(MU + cc * 8 + 4); \
                float x[8]; \
                { const float c0 = bflo(cw.x), c1 = bfhi(cw.x), c2 = bflo(cw.y), c3 = bfhi(cw.y), c4_ = bflo(cw.z), c5 = bfhi(cw.z), c6 = bflo(cw.w), c7 = bfhi(cw.w); \
                  x[0] = c0 + (bflo(pw.x) - c0) * m0[0]; x[1] = c1 + (bfhi(pw.x) - c1) * m0[1]; x[2] = c2 + (bflo(pw.y) - c2) * m0[2]; x[3] = c3 + (bfhi(pw.y) - c3) * m0[3]; \
                  x[4] = c4_ + (bflo(pw.z) - c4_) * m1[0]; x[5] = c5 + (bfhi(pw.z) - c5) * m1[1]; x[6] = c6 + (bflo(pw.w) - c6) * m1[2]; x[7] = c7 + (bfhi(pw.w) - c7) * m1[3]; } \
                if (cc < 24) { \
                    const int a_ = (cc < 8) ? 4 : (cc < 16) ? 3 : 5; const int c8 = 8 * (cc & 7); \
                    LAS f32x4* d = (LAS f32x4*)(STEP + (tt * 6 + a_) * 64 + c8); \
                    d[0] = (f32x4){x[0], x[1], x[2], x[3]}; d[1] = (f32x4){x[4], x[5], x[6], x[7]}; \
                } else { \
                    v4u o; o.x = cvtpk(x[0], x[1]); o.y = cvtpk(x[2], x[3]); o.z = cvtpk(x[4], x[5]); o.w = cvtpk(x[6], x[7]); \
                    LAS bf16* dst = (cc < 32) ? AW + tt * 72 + 8 * (cc - 24) : (cc < 40) ? AA + tt * 72 + 8 * (cc - 32) : AG + tt * 136 + 8 * (cc - 40); \
                    *(LAS v4u*)dst = o; \
                } \
            } \
            } while (0)
        if (w >= 4) RW_STAGE_A(0);
        LBAR();
        for (int c = -1; c < NC; ++c) {
            if (c >= 0) {
            if (w < 4) {
                __builtin_amdgcn_s_setprio(3);
                const int fr = lane & 15, fq = lane >> 4;
                const LAS unsigned* bkp = (fq == 0) ? BBKX + fr * 4 : ZW; const int bks = (fq == 0) ? 64 * 4 : 0;
                const LAS float* vrp = (fq == 0) ? VT + 16 * w + fr : (const LAS float*)ZW; const int vrs = (fq == 0) ? 64 * 4 : 0;
                const LAS bf16* kkt = (const LAS bf16*)(STEP + 128) + fq * 16 + ((fr & 1) ? 64 : 0);
                const LAS f32x4* dpp_ = (const LAS f32x4*)(DECP + fq * 16);
                LAS float* ypw = YP + 16 * w + fr;
                bf16x8 xa0 = *(const LAS bf16x8*)(kkt), xa1 = *(const LAS bf16x8*)(kkt + 8), ya0, ya1;
                f32x4 xq0 = dpp_[0], xq1 = dpp_[1], xq2 = dpp_[2], xq3 = dpp_[3], yq0, yq1, yq2, yq3;
                v4u xbk = *(const LAS v4u*)(bkp), ybk; float xv = vrp[0], yv;
                const LAS bf16* avn = kkt + ((fr & 1) ? 0 : 768);
#define RW_STEP(tt, A0, A1, Q0, Q1, Q2, Q3, BKc, Vc, NA0, NA1, NQ0, NQ1, NQ2, NQ3, NBK, NV) do { \
                    if ((tt) + 1 < RW_TC) { dpp_ += 16; bkp = (const LAS unsigned*)((const LAS char*)bkp + bks); vrp = (const LAS float*)((const LAS char*)vrp + vrs); } \
                    NA0 = *(const LAS bf16x8*)(avn); NA1 = *(const LAS bf16x8*)(avn + 8); \
                    NQ0 = dpp_[0]; NQ1 = dpp_[1]; NQ2 = dpp_[2]; NQ3 = dpp_[3]; NBK = *(const LAS v4u*)(bkp); NV = vrp[0]; \
                    const f32x4 d2 = __builtin_amdgcn_mfma_f32_16x16x32_bf16(A0, __builtin_bit_cast(bf16x8, bS0), (f32x4){0.f, 0.f, 0.f, 0.f}, 0, 0, 0);        \
                    const f32x4 e2 = __builtin_amdgcn_mfma_f32_16x16x32_bf16(A1, __builtin_bit_cast(bf16x8, bS1), (f32x4){0.f, 0.f, 0.f, 0.f}, 0, 0, 0); \
                    const f32x4 c0 = SM[0] * Q0, c1 = SM[1] * Q1, c2 = SM[2] * Q2, c3 = SM[3] * Q3; \
                    if ((tt) > 0) ypw[((tt) - 1) * 64] = d2[1] + e2[1]; \
                    const unsigned pr2 = cvtpk(d2[0] + e2[0], Vc); const v2u be = (v2u){pr2, 0u}, bo = (v2u){0u, pr2}; const v2u alo = (v2u){BKc.x, BKc.y}, ahi = (v2u){BKc.z, BKc.w}; \
                    SM[0] = __builtin_amdgcn_mfma_f32_16x16x16bf16_1k(__builtin_bit_cast(rw_s4, alo), __builtin_bit_cast(rw_s4, be), c0, 0, 0, 0); \
                    SM[1] = __builtin_amdgcn_mfma_f32_16x16x16bf16_1k(__builtin_bit_cast(rw_s4, alo), __builtin_bit_cast(rw_s4, bo), c1, 0, 0, 0); \
                    SM[2] = __builtin_amdgcn_mfma_f32_16x16x16bf16_1k(__builtin_bit_cast(rw_s4, ahi), __builtin_bit_cast(rw_s4, be), c2, 0, 0, 0); \
                    SM[3] = __builtin_amdgcn_mfma_f32_16x16x16bf16_1k(__builtin_bit_cast(rw_s4, ahi), __builtin_bit_cast(rw_s4, bo), c3, 0, 0, 0); \
                    bS0.x = cvtpk(SM[0][0], SM[0][1]); bS0.y = cvtpk(SM[0][2], SM[0][3]); bS0.z = cvtpk(SM[1][0], SM[1][1]); bS0.w = cvtpk(SM[1][2], SM[1][3]); \
                    bS1.x = cvtpk(SM[2][0], SM[2][1]); bS1.y = cvtpk(SM[2][2], SM[2][3]); bS1.z = cvtpk(SM[3][0], SM[3][1]); bS1.w = cvtpk(SM[3][2], SM[3][3]); \
                    if ((fr & 1) || (tt) + 2 < RW_TC) avn += 768;        \
                } while (0)
                for (int tt = 0; tt < RW_TC; tt += 2) {
                    RW_STEP(tt, xa0, xa1, xq0, xq1, xq2, xq3, xbk, xv, ya0, ya1, yq0, yq1, yq2, yq3, ybk, yv);
                    RW_STEP(tt + 1, ya0, ya1, yq0, yq1, yq2, yq3, ybk, yv, xa0, xa1, xq0, xq1, xq2, xq3, xbk, xv);
                    if (tt == RW_TC / 2 - 2) LBAR();
                }
#undef RW_STEP
                const bf16x8 av0 = xa0, av1 = xa1;
                {
                    f32x4 d2 = __builtin_amdgcn_mfma_f32_16x16x32_bf16(av0, __builtin_bit_cast(bf16x8, bS0), (f32x4){0.f, 0.f, 0.f, 0.f}, 0, 0, 0);
                    d2 = __builtin_amdgcn_mfma_f32_16x16x32_bf16(av1, __builtin_bit_cast(bf16x8, bS1), d2, 0, 0, 0);
                    ypw[(RW_TC - 1) * 64] = d2[1];
                }
                __builtin_amdgcn_s_setprio(0);
            }
            else {
                if (c + 1 < NC) RW_STAGE_A(c + 1);
                LBAR();
                if (c + 1 < NC) {
                    LAS bf16* GATEn = GATEB + ((c + 1) & 1) * (RW_TC * 64);
#pragma unroll
                    for (int vi = 0; vi < 2; ++vi) { const int vw = 2 * (w - 4) + vi;
            {
                const int fr = lane & 15, fq = lane >> 4;
                if (vw < 4) {
                    const bool isw = (vw < 2); const int mb = vw & 1;
                    LAS bf16* Aop = isw ? AW : AA; LAS bf16* Bop = isw ? W2T : A2T;
                    f32x4 acc[4];
#pragma unroll
                    for (int nb = 0; nb < 4; ++nb) acc[nb] = (f32x4){0.f, 0.f, 0.f, 0.f};
#pragma unroll
                    for (int ks = 0; ks < 2; ++ks) { bf16x8 af = *(const LAS bf16x8*)(Aop + (mb * 16 + fr) * 72 + ks * 32 + 8 * fq); if (isw) af = frag_map<1>(af);
#pragma unroll
                        for (int nb = 0; nb < 4; ++nb) { const bf16x8 bfv = *(const LAS bf16x8*)(Bop + (nb * 16 + fr) * 72 + ks * 32 + 8 * fq);
                            acc[nb] = __builtin_amdgcn_mfma_f32_16x16x32_bf16(af, bfv, acc[nb], 0, 0, 0); } }
                    const int slot = isw ? 0 : 1;
#pragma unroll
                    for (int nb = 0; nb < 4; ++nb)
#pragma unroll
                        for (int rg4 = 0; rg4 < 4; ++rg4) STEP[((mb * 16 + 4 * fq + rg4) * 6 + slot) * 64 + nb * 16 + fr] = acc[nb][rg4];
                } else {
                    const int mb = (vw - 4) & 1, nb0 = ((vw - 4) >> 1) * 2;
                    f32x4 acc[2]; acc[0] = (f32x4){0.f, 0.f, 0.f, 0.f}; acc[1] = acc[0];
#pragma unroll
                    for (int ks = 0; ks < 4; ++ks) { const bf16x8 af = frag_map<2>(*(const LAS bf16x8*)(AG + (mb * 16 + fr) * 136 + ks * 32 + 8 * fq));
#pragma unroll
                        for (int q = 0; q < 2; ++q) { const bf16x8 bfv = *(const LAS bf16x8*)(G2T + ((nb0 + q) * 16 + fr) * 136 + ks * 32 + 8 * fq);
                            acc[q] = __builtin_amdgcn_mfma_f32_16x16x32_bf16(af, bfv, acc[q], 0, 0, 0); } }
#pragma unroll
                    for (int q = 0; q < 2; ++q)
#pragma unroll
                        for (int rg4 = 0; rg4 < 4; ++rg4) GATEn[(mb * 16 + 4 * fq + rg4) * 64 + (nb0 + q) * 16 + fr] = (bf16)(cvtpk(acc[q][rg4], 0.f) & 0xffffu);
                }
            }
                    }
                }
            }
            LBAR();
            }
            const bool prep = (c + 1 < NC);
            if (c < 0) {
                LAS bf16* GATEn = GATEB; const int vw = w;
            {
                const int fr = lane & 15, fq = lane >> 4;
                if (vw < 4) {
                    const bool isw = (vw < 2); const int mb = vw & 1;
                    LAS bf16* Aop = isw ? AW : AA; LAS bf16* Bop = isw ? W2T : A2T;
                    f32x4 acc[4];
#pragma unroll
                    for (int nb = 0; nb < 4; ++nb) acc[nb] = (f32x4){0.f, 0.f, 0.f, 0.f};
#pragma unroll
                    for (int ks = 0; ks < 2; ++ks) { bf16x8 af = *(const LAS bf16x8*)(Aop + (mb * 16 + fr) * 72 + ks * 32 + 8 * fq); if (isw) af = frag_map<1>(af);
#pragma unroll
                        for (int nb = 0; nb < 4; ++nb) { const bf16x8 bfv = *(const LAS bf16x8*)(Bop + (nb * 16 + fr) * 72 + ks * 32 + 8 * fq);
                            acc[nb] = __builtin_amdgcn_mfma_f32_16x16x32_bf16(af, bfv, acc[nb], 0, 0, 0); } }
                    const int slot = isw ? 0 : 1;
#pragma unroll
                    for (int nb = 0; nb < 4; ++nb)
#pragma unroll
                        for (int rg4 = 0; rg4 < 4; ++rg4) STEP[((mb * 16 + 4 * fq + rg4) * 6 + slot) * 64 + nb * 16 + fr] = acc[nb][rg4];
                } else {
                    const int mb = (vw - 4) & 1, nb0 = ((vw - 4) >> 1) * 2;
                    f32x4 acc[2]; acc[0] = (f32x4){0.f, 0.f, 0.f, 0.f}; acc[1] = acc[0];
#pragma unroll
                    for (int ks = 0; ks < 4; ++ks) { const bf16x8 af = frag_map<2>(*(const LAS bf16x8*)(AG + (mb * 16 + fr) * 136 + ks * 32 + 8 * fq));
#pragma unroll
                        for (int q = 0; q < 2; ++q) { const bf16x8 bfv = *(const LAS bf16x8*)(G2T + ((nb0 + q) * 16 + fr) * 136 + ks * 32 + 8 * fq);
                            acc[q] = __builtin_amdgcn_mfma_f32_16x16x32_bf16(af, bfv, acc[q], 0, 0, 0); } }
#pragma unroll
                    for (int q = 0; q < 2; ++q)
#pragma unroll
                        for (int rg4 = 0; rg4 < 4; ++rg4) GATEn[(mb * 16 + 4 * fq + rg4) * 64 + (nb0 + q) * 16 + fr] = (bf16)(cvtpk(acc[q][rg4], 0.f) & 0xffffu);
                }
            }
                LBAR();
            }
            if (c >= 0) {
                float y[4];
#pragma unroll
                for (int r = 0; r < 4; ++r) y[r] = YP[tt2 * 64 + c4 + r];
                const float mean = row16_sum((y[0] + y[1]) + (y[2] + y[3])) * (1.f / 64.f);
                const f32x4 dlt = (f32x4){y[0] - mean, y[1] - mean, y[2] - mean, y[3] - mean};
                const float var = row16_sum((dlt[0] * dlt[0] + dlt[1] * dlt[1]) + (dlt[2] * dlt[2] + dlt[3] * dlt[3])) * (1.f / 64.f);
                const float rs = __builtin_amdgcn_rsqf(var + RW_GN_EPS);
                const f32x4 bv = *(const LAS f32x4*)(BV + tt2 * 64 + c4);
                const v2u gw = *(const LAS v2u*)(GATEB + (c & 1) * (RW_TC * 64) + tt2 * 64 + c4);
                const f32x4 gt = (f32x4){bflo(gw.x), bfhi(gw.x), bflo(gw.y), bfhi(gw.y)};
                const f32x4 o = (dlt * rs * lwv + lbv + bv) * gt;
                v2u pw; pw.x = cvtpk(o[0], o[1]); pw.y = cvtpk(o[2], o[3]);
                *(v2u*)(Yrw + ((size_t)b * T + (size_t)c * RW_TC + tt2) * LDY + h * 64 + c4) = pw;
            }
            if (prep) {
                LAS float* spt = STEP + tt2 * 384 + c4;
                const f32x4 wl = *(const LAS f32x4*)(spt), al = *(const LAS f32x4*)(spt + 64), xk = *(const LAS f32x4*)(spt + 192), rr = *(const LAS f32x4*)(spt + 256), vv = *(const LAS f32x4*)(spt + 320);
                constexpr float KD = -0.60653065971f * 1.44269504089f;
                f32x4 dec, a, kkr;
#pragma unroll
                for (int i = 0; i < 4; ++i) { dec[i] = fexp2(KD * fsig(w0v[i] + wl[i])); a[i] = fsig(a0v[i] + al[i]); kkr[i] = xk[i] * kkv[i]; }
                const float n2 = row16_sum((kkr[0] * kkr[0] + kkr[1] * kkr[1]) + (kkr[2] * kkr[2] + kkr[3] * kkr[3]));
                const float inv = fminf(__builtin_amdgcn_rsqf(n2), 1e12f);
                const f32x4 kk = kkr * inv;
                const f32x4 kx = xk * (1.0f + (a - 1.0f) * kav);
                const f32x4 rk = rr * kx * rkv;
                const float bonus = row16_sum((rk[0] + rk[1]) + (rk[2] + rk[3]));
                const int tq = c4 >> 4, fqk = (c4 >> 2) & 3;
                *(LAS f32x4*)(DECP + tt2 * 64 + fqk * 16 + tq * 4) = dec;
                LAS bf16* kr = (LAS bf16*)(STEP + tt2 * 384 + 128) + fqk * 16 + (tq >> 1) * 8 + (tq & 1) * 4;
                { v2u o; o.x = cvtpk(-kk[0], -kk[1]); o.y = cvtpk(-kk[2], -kk[3]); *(LAS v2u*)kr = o; o.x = cvtpk(rr[0], rr[1]); o.y = cvtpk(rr[2], rr[3]); *(LAS v2u*)(kr + 64) = o; }
                const f32x4 bbv = kk * a;
#pragma unroll
                for (int i = 0; i < 4; ++i) BBKX[tt2 * 64 + ((c4 & 15) + i) * 4 + tq] = cvtpk(bbv[i], kx[i]);
                *(LAS f32x4*)(VT + tt2 * 64 + c4) = vv;
                *(LAS f32x4*)(BV + tt2 * 64 + c4) = bonus * vv;
            }
            LBAR();
        }
#undef RW_STAGE_A
    }
}

constexpr int RTL_Q = 0, RTL_K1 = 18432, RTL_V = 36864, RTL_SP = 73728, RTL_RT = 106496, RTL_END = 124928;
static_assert(RTL_END <= LDSCTL_OFF, "retention lds");
typedef short s16x4 __attribute__((ext_vector_type(4)));
__device__ __forceinline__ bf16x8 tr_frag(const LAS bf16* p, int rows4) {
    const s16x4 lo = __builtin_amdgcn_ds_read_tr16_b64_v4i16((LAS s16x4*)p);
    const s16x4 hi = __builtin_amdgcn_ds_read_tr16_b64_v4i16((LAS s16x4*)(p + rows4));
    return (bf16x8){lo[0], lo[1], lo[2], lo[3], hi[0], hi[1], hi[2], hi[3]};
}
__device__ __forceinline__ void retention_phase(Frame& F) {
    LAS unsigned char* L = F.lds;
    LAS bf16* Q = (LAS bf16*)(L + RTL_Q);
    LAS bf16* K1 = (LAS bf16*)(L + RTL_K1);
    LAS bf16* V = (LAS bf16*)(L + RTL_V);
    LAS bf16* SP = (LAS bf16*)(L + RTL_SP);
    LAS bf16* RT = (LAS bf16*)(L + RTL_RT);
    const int tid = F.tid, lane = ((int)(threadIdx.x & 63)), w = F.wave, fr = lane & 15, fq = lane >> 4;
    const bf16* PRET = (const bf16*)(F.ws + WS_PRET);
    const f32x2* rope = (const f32x2*)(F.ws + WS_ROPE);
    bf16* Yret = (bf16*)((unsigned char*)F.out + OUT_Y) + RWW;
    const int si = tid >> 2, sjc = tid & 3;
    const int i0 = 16 * w;
    const int trq = fr >> 2, trp = fr & 3;
    for (int unit = F.vcu; unit < BATCH * RTH; unit += F.G) {
        const int b = unit >> 3, h = unit & 7;
        const float lg2 = log1pf(-exp2f(-5.0f - (float)h)) * 1.44269504089f;
        const float cdec = fexp2(128.0f * lg2);
        const float ksc = 0.125f * fexp2(-(float)(si + 1) * lg2);
        float qd[4];
#pragma unroll
        for (int rg4 = 0; rg4 < 4; ++rg4) qd[rg4] = fexp2((float)(i0 + 4 * fq + rg4 + 1) * lg2);
        __syncthreads();
        for (int e = tid; e < 128 * 72 / 8; e += 512) *(LAS v4u*)(RT + 8 * e) = (v4u){0u, 0u, 0u, 0u};
        f32x4 accR[4];
#pragma unroll
        for (int db = 0; db < 4; ++db) accR[db] = (f32x4){0.f, 0.f, 0.f, 0.f};
        v4u pq0, pq1, pk0, pk1, pv[4]; f32x4 pr[4];
        {
            const size_t row = (size_t)b * T + si;
            const bf16* pr_ = PRET + row * RET_COLS + h * 64 + 8 * sjc;
            pq0 = *(const v4u*)(pr_); pq1 = *(const v4u*)(pr_ + 32); pk0 = *(const v4u*)(pr_ + 512); pk1 = *(const v4u*)(pr_ + 512 + 32);
            const f32x4* rp = (const f32x4*)(rope + row * 32 + 8 * sjc); pr[0] = rp[0]; pr[1] = rp[1]; pr[2] = rp[2]; pr[3] = rp[3];
#pragma unroll
            for (int q4 = 0; q4 < 4; ++q4) { const int e = tid + 512 * q4, iv = e >> 4, vc = e & 15; pv[q4] = *(const v4u*)(PRET + ((size_t)b * T + iv) * RET_COLS + 1024 + h * 128 + 8 * vc); }
        }
        for (int ch = 0; ch < T / RCH; ++ch) {
            const size_t rowbase = (size_t)b * T + (size_t)ch * RCH;
            {
                const float cs[8] = {pr[0][0], pr[0][2], pr[1][0], pr[1][2], pr[2][0], pr[2][2], pr[3][0], pr[3][2]}, sn[8] = {pr[0][1], pr[0][3], pr[1][1], pr[1][3], pr[2][1], pr[2][3], pr[3][1], pr[3][3]};
                {
                    const float z1[8] = {bflo(pq0.x), bfhi(pq0.x), bflo(pq0.y), bfhi(pq0.y), bflo(pq0.z), bfhi(pq0.z), bflo(pq0.w), bfhi(pq0.w)}, z2[8] = {bflo(pq1.x), bfhi(pq1.x), bflo(pq1.y), bfhi(pq1.y), bflo(pq1.z), bfhi(pq1.z), bflo(pq1.w), bfhi(pq1.w)};
                    float o1[8], o2[8];
#pragma unroll
                    for (int q = 0; q < 8; ++q) { o1[q] = z1[q] * cs[q] - z2[q] * sn[q]; o2[q] = z1[q] * sn[q] + z2[q] * cs[q]; }
                    v4u p1, p2; p1.x = pk2(o1[0], o1[1]); p1.y = pk2(o1[2], o1[3]); p1.z = pk2(o1[4], o1[5]); p1.w = pk2(o1[6], o1[7]); p2.x = pk2(o2[0], o2[1]); p2.y = pk2(o2[2], o2[3]); p2.z = pk2(o2[4], o2[5]); p2.w = pk2(o2[6], o2[7]);
                    *(LAS v4u*)(Q + si * 72 + 8 * sjc) = p1; *(LAS v4u*)(Q + si * 72 + 32 + 8 * sjc) = p2;
                }
                {
                    const float z1[8] = {bflo(pk0.x), bfhi(pk0.x), bflo(pk0.y), bfhi(pk0.y), bflo(pk0.z), bfhi(pk0.z), bflo(pk0.w), bfhi(pk0.w)}, z2[8] = {bflo(pk1.x), bfhi(pk1.x), bflo(pk1.y), bfhi(pk1.y), bflo(pk1.z), bfhi(pk1.z), bflo(pk1.w), bfhi(pk1.w)};
                    float o1[8], o2[8];
#pragma unroll
                    for (int q = 0; q < 8; ++q) { o1[q] = (z1[q] * cs[q] - z2[q] * sn[q]) * ksc; o2[q] = (z1[q] * sn[q] + z2[q] * cs[q]) * ksc; }
                    v4u p1, p2; p1.x = pk2(o1[0], o1[1]); p1.y = pk2(o1[2], o1[3]); p1.z = pk2(o1[4], o1[5]); p1.w = pk2(o1[6], o1[7]); p2.x = pk2(o2[0], o2[1]); p2.y = pk2(o2[2], o2[3]); p2.z = pk2(o2[4], o2[5]); p2.w = pk2(o2[6], o2[7]);
                    *(LAS v4u*)(K1 + si * 72 + 8 * sjc) = p1; *(LAS v4u*)(K1 + si * 72 + 32 + 8 * sjc) = p2;
                }
#pragma unroll
                for (int q4 = 0; q4 < 4; ++q4) { const int e = tid + 512 * q4, iv = e >> 4, vc = e & 15; *(LAS v4u*)(V + iv * 144 + 8 * vc) = pv[q4]; }
            }
            if (ch + 1 < T / RCH) {
                const size_t row = rowbase + RCH + si;
                const bf16* pr_ = PRET + row * RET_COLS + h * 64 + 8 * sjc;
                pq0 = *(const v4u*)(pr_); pq1 = *(const v4u*)(pr_ + 32); pk0 = *(const v4u*)(pr_ + 512); pk1 = *(const v4u*)(pr_ + 512 + 32);
                const f32x4* rp = (const f32x4*)(rope + row * 32 + 8 * sjc); pr[0] = rp[0]; pr[1] = rp[1]; pr[2] = rp[2]; pr[3] = rp[3];
#pragma unroll
                for (int q4 = 0; q4 < 4; ++q4) { const int e = tid + 512 * q4, iv = e >> 4, vc = e & 15; pv[q4] = *(const v4u*)(PRET + (rowbase + RCH + iv) * RET_COLS + 1024 + h * 128 + 8 * vc); }
            }
            LBAR();
            v4u gvp[4];
#pragma unroll
            for (int q = 0; q < 4; ++q) gvp[q] = *(const v4u*)(PRET + (rowbase + i0 + fr) * RET_COLS + 2048 + h * 128 + 32 * q + 8 * fq);
            bf16x8 qf[2];
#pragma unroll
            for (int ks = 0; ks < 2; ++ks) qf[ks] = *(const LAS bf16x8*)(Q + (i0 + fr) * 72 + ks * 32 + 8 * fq);
            LAS bf16* SPw = SP + w * 2048;
#pragma unroll
            for (int nb = 0; nb < 8; ++nb) {
                if (nb <= (w | 1)) {
                    f32x4 s = (f32x4){0.f, 0.f, 0.f, 0.f};
                    if (nb <= w) {
#pragma unroll
                        for (int ks = 0; ks < 2; ++ks) { const bf16x8 kf = *(const LAS bf16x8*)(K1 + (nb * 16 + fr) * 72 + ks * 32 + 8 * fq); s = __builtin_amdgcn_mfma_f32_16x16x32_bf16(qf[ks], kf, s, 0, 0, 0); }
                    }
                    const int key = nb * 16 + fr, qi = i0 + 4 * fq;
                    v2u pw; pw.x = pk2(key <= qi ? s[0] : 0.f, key <= qi + 1 ? s[1] : 0.f); pw.y = pk2(key <= qi + 2 ? s[2] : 0.f, key <= qi + 3 ? s[3] : 0.f);
                    *(LAS v2u*)(SPw + key * 16 + 4 * fq) = pw;
                }
            }
            LDS_WAIT();
            f32x4 o[8];
#pragma unroll
            for (int nb = 0; nb < 8; ++nb) o[nb] = (f32x4){0.f, 0.f, 0.f, 0.f};
#pragma unroll
            for (int ks = 0; ks < 4; ++ks) if (2 * ks <= w) { const bf16x8 sf = tr_frag(SPw + (32 * ks + 8 * fq + trq) * 16 + 4 * trp, 4 * 16);
#pragma unroll
                for (int nb = 0; nb < 8; ++nb) { const bf16x8 vf = tr_frag(V + (32 * ks + 8 * fq + trq) * 144 + 16 * nb + 4 * trp, 4 * 144); o[nb] = __builtin_amdgcn_mfma_f32_16x16x32_bf16(sf, vf, o[nb], 0, 0, 0); } }
#pragma unroll
            for (int ks = 0; ks < 2; ++ks)
#pragma unroll
                for (int n4 = 0; n4 < 2; ++n4) {
                    bf16x8 rf[4];
#pragma unroll
                    for (int nb = 0; nb < 4; ++nb) rf[nb] = *(const LAS bf16x8*)(RT + ((4 * n4 + nb) * 16 + fr) * 72 + ks * 32 + 8 * fq);
                    __builtin_amdgcn_sched_barrier(0);
#pragma unroll
                    for (int nb = 0; nb < 4; ++nb) o[4 * n4 + nb] = __builtin_amdgcn_mfma_f32_16x16x32_bf16(qf[ks], rf[nb], o[4 * n4 + nb], 0, 0, 0);
                    __builtin_amdgcn_sched_barrier(0);
                }
#pragma unroll
            for (int ks = 0; ks < 4; ++ks) { const bf16x8 vf = tr_frag(V + (32 * ks + 8 * fq + trq) * 144 + 16 * w + 4 * trp, 4 * 144);
#pragma unroll
                for (int db = 0; db < 4; ++db) { const bf16x8 kf = tr_frag(K1 + (32 * ks + 8 * fq + trq) * 72 + 16 * db + 4 * trp, 4 * 72); accR[db] = __builtin_amdgcn_mfma_f32_16x16x32_bf16(vf, kf, accR[db], 0, 0, 0); } }
#pragma unroll
            for (int db = 0; db < 4; ++db) accR[db] = accR[db] * cdec;
#pragma unroll
            for (int rg4 = 0; rg4 < 4; ++rg4)
#pragma unroll
                for (int nb = 0; nb < 8; ++nb) o[nb][rg4] *= qd[rg4];
            {
                float s1[4], s2[4];
#pragma unroll
                for (int rg4 = 0; rg4 < 4; ++rg4) { s1[rg4] = 0.f;
#pragma unroll
                    for (int nb = 0; nb < 8; ++nb) s1[rg4] += o[nb][rg4]; }
                row16_sum4(s1);
#pragma unroll
                for (int rg4 = 0; rg4 < 4; ++rg4) { const float mean = s1[rg4] * (1.f / 128.f); s2[rg4] = 0.f;
#pragma unroll
                    for (int nb = 0; nb < 8; ++nb) { o[nb][rg4] -= mean; s2[rg4] += o[nb][rg4] * o[nb][rg4]; } }
                row16_sum4(s2);
#pragma unroll
                for (int rg4 = 0; rg4 < 4; ++rg4) { const float rs = __builtin_amdgcn_rsqf(s2[rg4] * (1.f / 128.f) + RET_GN_EPS);
#pragma unroll
                    for (int nb = 0; nb < 8; ++nb) o[nb][rg4] *= rs; }
            }
#pragma unroll
            for (int nb = 0; nb < 8; ++nb) { v2u pw; pw.x = pk2(o[nb][0], o[nb][1]); pw.y = pk2(o[nb][2], o[nb][3]); *(LAS v2u*)(SPw + (nb * 16 + fr) * 16 + 4 * fq) = pw; }
            LDS_WAIT();
#pragma unroll
            for (int q = 0; q < 4; ++q) {
                const int c8 = 32 * q + 8 * fq; const size_t row = rowbase + i0 + fr;
                const v4u ov = __builtin_bit_cast(v4u, tr_frag(SPw + (32 * q + 8 * fq + trq) * 16 + 4 * trp, 4 * 16)); const v4u gv = gvp[q];
                v4u r; r.x = pk2(bflo(ov.x) * bflo(gv.x), bfhi(ov.x) * bfhi(gv.x)); r.y = pk2(bflo(ov.y) * bflo(gv.y), bfhi(ov.y) * bfhi(gv.y));
                r.z = pk2(bflo(ov.z) * bflo(gv.z), bfhi(ov.z) * bfhi(gv.z)); r.w = pk2(bflo(ov.w) * bflo(gv.w), bfhi(ov.w) * bfhi(gv.w));
                *(v4u*)(Yret + row * LDY + h * 128 + c8) = r;
            }
            LBAR();
#pragma unroll
            for (int db = 0; db < 4; ++db)
#pragma unroll
                for (int rg4 = 0; rg4 < 4; ++rg4) RT[(w * 16 + 4 * fq + rg4) * 72 + db * 16 + fr] = (bf16)(pk2(accR[db][rg4], 0.f) & 0xffffu);
        }
    }
}

__device__ __forceinline__ void norm_mix_phase(Frame& F) {
    const int gw = F.vcu * NWAVES + F.wave, NGW = F.G * NWAVES;
    const bf16* Z = (const bf16*)(F.ws + WS_Z); const float* part = (const float*)(F.ws + WS_PART); const float* x = F.in[0]; const float* gpost = F.in[3];
    bf16* XN2 = (bf16*)(F.ws + WS_XN2);
    f32x4 g[4];
#pragma unroll
    for (int j = 0; j < 4; ++j) g[j] = ((const f32x4*)gpost)[((int)(threadIdx.x & 63)) + 64 * j];
    constexpr int PD = 2;
    f32x4 bx[PD][4]; v2u bz[PD][4]; float bp[PD];
    const int lane = ((int)(threadIdx.x & 63));
#define P5_LOAD(k, mm) do { bp[k] = part[(size_t)(mm) * 16 + (lane & 15)]; \
        const GAS f32x4* xr_ = (const GAS f32x4*)(x + (size_t)(mm) * D) + lane; const GAS v2u* zr_ = (const GAS v2u*)(Z + (size_t)(mm) * D) + lane; \
        _Pragma("unroll") for (int j = 0; j < 4; ++j) { bx[k][j] = __builtin_nontemporal_load(&xr_[64 * j]); bz[k][j] = __builtin_nontemporal_load(&zr_[64 * j]); } } while (0)
#define P5_ROW(m, pv, xv, zv) do { \
        const float rstd = __builtin_amdgcn_rsqf(row16_sum(pv) * (1.f / D) + RMS_EPS);        \
        f32x4 hv[4]; float s = 0.f; \
        _Pragma("unroll") for (int j = 0; j < 4; ++j) { const v2u zw = zv[j]; const f32x4 z = (f32x4){bflo(zw.x), bfhi(zw.x), bflo(zw.y), bfhi(zw.y)}; \
            hv[j] = xv[j] + z * rstd * g[j]; s += (hv[j].x * hv[j].x + hv[j].y * hv[j].y) + (hv[j].z * hv[j].z + hv[j].w * hv[j].w); } \
        const float rstd2 = __builtin_amdgcn_rsqf(wave_sum(s) * (1.f / D) + RMS_EPS); \
        GAS v2u* h8 = (GAS v2u*)((bf16*)(F.ws + WS_H1) + (size_t)(m) * D) + lane; GAS v2u* o8 = (GAS v2u*)(XN2 + (size_t)(m) * D) + lane; \
        _Pragma("unroll") for (int j = 0; j < 4; ++j) { v2u hb; hb.x = pk2(hv[j].x, hv[j].y); hb.y = pk2(hv[j].z, hv[j].w); __builtin_nontemporal_store(hb, &h8[64 * j]); v2u o; o.x = pk2(hv[j].x * rstd2, hv[j].y * rstd2); o.y = pk2(hv[j].z * rstd2, hv[j].w * rstd2); o8[64 * j] = o; } } while (0)
#pragma unroll
    for (int k = 0; k < PD; ++k) P5_LOAD(k, min(gw + k * NGW, M - 1));
    int m0 = gw;
    for (; m0 + (PD - 1) * NGW < M; m0 += PD * NGW) {
#pragma unroll
        for (int k = 0; k < PD; ++k) { const int m = m0 + k * NGW;
            const float pv = bp[k]; f32x4 xv[4]; v2u zv[4];
#pragma unroll
            for (int j = 0; j < 4; ++j) { xv[j] = bx[k][j]; zv[j] = bz[k][j]; }
            P5_LOAD(k, min(m + PD * NGW, M - 1));
            P5_ROW(m, pv, xv, zv);
        }
    }
    for (int m = m0; m < M; m += NGW) {
        P5_LOAD(0, m); const float pv = bp[0]; f32x4 xv[4]; v2u zv[4];
#pragma unroll
        for (int j = 0; j < 4; ++j) { xv[j] = bx[0][j]; zv[j] = bz[0][j]; }
        P5_ROW(m, pv, xv, zv);
    }
#undef P5_ROW
#undef P5_LOAD
}
__device__ __forceinline__ void norm_ffn_phase(Frame& F) {
    const int gw = F.vcu * NWAVES + F.wave, NGW = F.G * NWAVES;
    const bf16* Z = (const bf16*)(F.ws + WS_F); const float* part = (const float*)(F.ws + WS_PART2); const float* gpost = F.in[5];
    f32x4 g[4];
#pragma unroll
    for (int j = 0; j < 4; ++j) g[j] = ((const f32x4*)gpost)[((int)(threadIdx.x & 63)) + 64 * j];
    constexpr int PD = 2;
    v2u bz[PD][4], bh[PD][4]; float bp[PD];
    const int lane = ((int)(threadIdx.x & 63));
#define P9_LOAD(k, mm) do { bp[k] = part[(size_t)(mm) * 16 + (lane & 15)]; \
        const GAS v2u* zr_ = (const GAS v2u*)(Z + (size_t)(mm) * D) + lane; const GAS v2u* hr_ = (const GAS v2u*)((const bf16*)(F.ws + WS_H1) + (size_t)(mm) * D) + lane; \
        _Pragma("unroll") for (int j = 0; j < 4; ++j) { bz[k][j] = __builtin_nontemporal_load(&zr_[64 * j]); bh[k][j] = __builtin_nontemporal_load(&hr_[64 * j]); } } while (0)
#define P9_ROW(m, pv, zv, hv) do { \
        const float rstd = __builtin_amdgcn_rsqf(row16_sum(pv) * (1.f / D) + RMS_EPS); \
        GAS f32x4* orow = (GAS f32x4*)(F.out + (size_t)(m) * D) + lane; \
        _Pragma("unroll") for (int j = 0; j < 4; ++j) { const v2u zw = zv[j], hw = hv[j]; const f32x4 z = (f32x4){bflo(zw.x), bfhi(zw.x), bflo(zw.y), bfhi(zw.y)}, hh = (f32x4){bflo(hw.x), bfhi(hw.x), bflo(hw.y), bfhi(hw.y)}; \
            __builtin_nontemporal_store(hh + z * rstd * g[j], &orow[64 * j]); } } while (0)
#pragma unroll
    for (int k = 0; k < PD; ++k) P9_LOAD(k, min(gw + k * NGW, M - 1));
    int m0 = gw;
    for (; m0 + (PD - 1) * NGW < M; m0 += PD * NGW) {
#pragma unroll
        for (int k = 0; k < PD; ++k) { const int m = m0 + k * NGW;
            const float pv = bp[k]; v2u zv[4], hv[4];
#pragma unroll
            for (int j = 0; j < 4; ++j) { zv[j] = bz[k][j]; hv[j] = bh[k][j]; }
            P9_LOAD(k, min(m + PD * NGW, M - 1));
            P9_ROW(m, pv, zv, hv);
        }
    }
    for (int m = m0; m < M; m += NGW) {
        P9_LOAD(0, m); const float pv = bp[0]; v2u zv[4], hv[4];
#pragma unroll
        for (int j = 0; j < 4; ++j) { zv[j] = bz[0][j]; hv[j] = bh[0][j]; }
        P9_ROW(m, pv, zv, hv);
    }
#undef P9_ROW
#undef P9_LOAD
}
__device__ __forceinline__ void conv_fixup_phase(Frame& F) {
    const float* halo = (const float*)(F.ws + WS_HALO); const float* cw = F.in[22]; const float* cb = F.in[23]; bf16* act = (bf16*)(F.ws + WS_ACT);
    const int gt = (F.vcu * NWAVES + F.wave) * 64 + ((int)(threadIdx.x & 63)), NT = F.G * NWAVES * 64;
    for (int e = gt; e < 256 * DFF; e += NT) {
        const int pm = e / DFF, j = e % DFF; if ((pm & 7) == 0) continue;
        const int tg = (j >> 7) * 256 + (j & 127), tv = tg + 128;
        const float* hc = halo + (size_t)pm * 4 * 5632; const float* hp = halo + (size_t)(pm - 1) * 4 * 5632;
        const float g254 = hp[2 * 5632 + tg], g255 = hp[3 * 5632 + tg], g0 = hc[tg], g1 = hc[5632 + tg];
        const float v254 = hp[2 * 5632 + tv], v255 = hp[3 * 5632 + tv], v0 = hc[tv], v1 = hc[5632 + tv];
        const float cg0 = cw[j], cg1 = cw[5632 + j], cg2 = cw[2 * 5632 + j], cgb = cb[j];
        const float cv0 = cw[DFF + j], cv1 = cw[5632 + DFF + j], cv2 = cw[2 * 5632 + DFF + j], cvb = cb[DFF + j];
        const float og0 = cgb + cg0 * g254 + cg1 * g255 + cg2 * g0, og1 = cgb + cg0 * g255 + cg1 * g0 + cg2 * g1;
        const float ov0 = cvb + cv0 * v254 + cv1 * v255 + cv2 * v0, ov1 = cvb + cv0 * v255 + cv1 * v0 + cv2 * v1;
        act[(size_t)(pm * 256) * DFF + j] = (bf16)f2bf(pg8::gelu_tanh(og0) * ov0);
        act[(size_t)(pm * 256 + 1) * DFF + j] = (bf16)f2bf(pg8::gelu_tanh(og1) * ov1);
    }
}

struct Args { const float* in[25]; float* out; unsigned char* ws; int ph_lo, ph_hi, li, pad; };
__global__ void __launch_bounds__(NWAVES * 64, 2) hyb_fwd(Args args) {
    extern __shared__ __attribute__((aligned(16))) unsigned char lds[];
    Frame F;
    F.lds = (LAS unsigned char*)lds;
    F.MISC = (volatile LAS unsigned*)(F.lds + MISC_OFF);
    F.tid = threadIdx.x; F.wave = __builtin_amdgcn_readfirstlane(F.tid >> 6);
    F.G = gridDim.x; { const int bx = blockIdx.x; F.vcu = (F.G % 8 == 0) ? (bx % 8) * (F.G / 8) + bx / 8 : bx; }
    unsigned char* ws = args.ws; F.ws = ws; F.out = args.out;
#pragma unroll
    for (int i = 0; i < 25; ++i) F.in[i] = args.in[i];
    F.ctl = (gu32*)(ws + WS_CTL);
    for (int u = F.tid; u < (LDS_BYTES - LDSCTL_OFF) / 4; u += NWAVES * 64) ((LAS unsigned*)(F.lds + LDSCTL_OFF))[u] = 0u;
    __syncthreads();
    XcdBarrier bar; bar.bar = (unsigned*)(F.ctl + CW_BAR) + args.li * XCD_BAR_WORDS; bar.x = 0; bar.st = nullptr;
    if (MK_N_LAUNCHES == 1) bar = xcd_barrier_post((unsigned*)(F.ctl + CW_BAR) + args.li * XCD_BAR_WORDS, F.MISC + 8);
    const int lo = args.ph_lo, hi = args.ph_hi;
#define IN(k) (lo <= (k) && (k) < hi)
#define SEAM(k) do { if (IN(k) && IN((k) + 1)) xcd_barrier(bar); } while (0)
    using namespace pg8;
    bf16* XN = (bf16*)((unsigned char*)F.out + OUT_XN);

    if (IN(0)) { REP(0) p0_prologue(F); } SEAM(0);
    if (IN(1)) REP(1) {
        Gemm g{XN, (const bf16_t*)(ws + WS_WIN), M, IN_COLS, D}; StaticOrder S; S.init(M, IN_COLS, F.G, (int)blockIdx.x);
        EpiIn E{(bf16_t*)(ws + WS_PRW), (bf16_t*)(ws + WS_PRET), (bf16_t*)(ws + WS_G)};
        gemm_phase<EpiIn, StaticOrder, true, true>(F.lds + RING_OFF, g, S, E);
    } SEAM(1);
    if (IN(2)) { REP(20) rwkv_phase(F); __syncthreads(); REP(21) retention_phase(F); } SEAM(2);
    if (IN(3)) REP(3) {
        Gemm g{(const bf16_t*)((unsigned char*)F.out + OUT_Y), (const bf16_t*)(ws + WS_WRW), M, D, LDY}; StaticOrder S; S.init(M, D, F.G, (int)blockIdx.x);
        EpiMerge E{(bf16_t*)(ws + WS_MERGED), (const bf16_t*)(ws + WS_G)};
        gemm_phase<EpiMerge, StaticOrder, true, true>(F.lds + RING_OFF, g, S, E);
    } SEAM(3);
    if (IN(4)) REP(4) {
        Gemm g{(const bf16_t*)(ws + WS_MERGED), (const bf16_t*)(ws + WS_WOUT), M, D, D}; StaticOrder S; S.init(M, D, F.G, (int)blockIdx.x);
        EpiZ E{(bf16_t*)(ws + WS_Z), (float*)(ws + WS_PART), (PROBE_NOSTORE != 0) && args.li == 1 && lo == 4};
        gemm_phase<EpiZ, StaticOrder, true, true>(F.lds + RING_OFF, g, S, E);
    } SEAM(4);
    if (IN(5)) { REP(5) norm_mix_phase(F); } SEAM(5);
    if (IN(6)) REP(6) {
        Gemm g{(const bf16_t*)(ws + WS_XN2), (const bf16_t*)(ws + WS_WUP), M, 2 * DFF, D}; StaticOrder S; S.init(M, 2 * DFF, F.G, (int)blockIdx.x);
        EpiConv E{(bf16_t*)(ws + WS_ACT), F.in[22], F.in[23], (float*)(ws + WS_HALO), (PG8_LAS float*)(F.lds + XCH_OFF)};
        gemm_phase<EpiConv, StaticOrder, true, true>(F.lds + RING_OFF, g, S, E);
    } SEAM(6);
    if (IN(7)) { REP(7) conv_fixup_phase(F); } SEAM(7);
    if (IN(8)) REP(8) {
        Gemm g{(const bf16_t*)(ws + WS_ACT), (const bf16_t*)(ws + WS_WDN), M, D, DFF}; StaticOrder S; S.init(M, D, F.G, (int)blockIdx.x);
        EpiZ E{(bf16_t*)(ws + WS_F), (float*)(ws + WS_PART2)};
        gemm_phase<EpiZ, StaticOrder, true, true>(F.lds + RING_OFF, g, S, E);
    } SEAM(8);
    if (IN(9)) { REP(9) norm_ffn_phase(F); }
#undef IN
#undef SEAM
}

extern "C" void kernel_launch(void* const* d_in, const int* in_sizes, int n_in, void* d_out, int out_size, void* d_ws, size_t ws_size, hipStream_t stream) {
    static int grid = 0;
    if (grid == 0) {
        if (n_in != 25 || in_sizes[0] != M * D || out_size != M * D || ws_size < WS_END) { fprintf(stderr, "kernel_launch: unexpected shapes (n_in %d, in0 %d, out %d, ws %zu); nothing launched\n", n_in, n_in > 0 ? in_sizes[0] : -1, out_size, ws_size); grid = -1; return; }
        int dev = 0, cus = 0, per_cu = 0;
        if (hipGetDevice(&dev) != hipSuccess || hipDeviceGetAttribute(&cus, hipDeviceAttributeMultiprocessorCount, dev) != hipSuccess) { grid = -1; return; }
        if (hipFuncSetAttribute((const void*)hyb_fwd, hipFuncAttributeMaxDynamicSharedMemorySize, LDS_BYTES) != hipSuccess) { fprintf(stderr, "kernel_launch: hipFuncSetAttribute failed\n"); grid = -1; return; }
        if (hipOccupancyMaxActiveBlocksPerMultiprocessor(&per_cu, (const void*)hyb_fwd, NWAVES * 64, LDS_BYTES) != hipSuccess || per_cu < 1) { fprintf(stderr, "kernel_launch: occupancy query reports %d workgroups per CU\n", per_cu); (void)hipGetLastError(); grid = -1; return; }
        (void)hipGetLastError();
        grid = cus;
    }
    if (grid < 0) return;
    if (hipMemsetAsync((char*)d_ws + WS_CTL, 0, CTL_ZERO_BYTES, stream) != hipSuccess) return;
    Args a{};
    for (int i = 0; i < 25; ++i) a.in[i] = (const float*)d_in[i];
    a.out = (float*)d_out; a.ws = (unsigned char*)d_ws;
#if MK_N_LAUNCHES == 1
    if (PROBE_SPLIT >= 0) {
        a.ph_lo = 0; a.ph_hi = PROBE_SPLIT + 1; a.li = 0; hipLaunchKernelGGL(hyb_fwd, dim3(grid), dim3(NWAVES * 64), LDS_BYTES, stream, a);
        a.ph_lo = PROBE_SPLIT; a.ph_hi = N_PHASES; a.li = 1; hipLaunchKernelGGL(hyb_fwd, dim3(grid), dim3(NWAVES * 64), LDS_BYTES, stream, a);
        return;
    }
    a.ph_lo = 0; a.ph_hi = N_PHASES; a.li = 0;
    hipLaunchKernelGGL(hyb_fwd, dim3(grid), dim3(NWAVES * 64), LDS_BYTES, stream, a);
#else
    for (int li = 0; li < N_PHASES; ++li) { a.ph_lo = li; a.ph_hi = li + 1; a.li = 0; hipLaunchKernelGGL(hyb_fwd, dim3(grid), dim3(NWAVES * 64), LDS_BYTES, stream, a); }
#endif
}
```

```cpp
#include <hip/hip_runtime.h>
#include <cstdio>
#include <cstdint>

#ifndef MK_N_LAUNCHES
#define MK_N_LAUNCHES 1
#endif
#ifndef PROBE_PH
#define PROBE_PH (-1)
#endif
#ifndef PROBE_NOSTORE
#define PROBE_NOSTORE 0
#endif
#ifndef PROBE_SPLIT
#define PROBE_SPLIT (-1)
#endif
#define REP(k) for (int _r = 0; _r < ((PROBE_PH == (k) || (PROBE_PH == 95 && ((k) == 0 || (k) == 5 || (k) == 9))) ? 2 : 1); ++_r)

namespace pg8 {
#define PG8_LAS __attribute__((address_space(3)))
typedef unsigned short bf16_t;
typedef short bf16x8 __attribute__((ext_vector_type(8)));
typedef float f32x4 __attribute__((ext_vector_type(4)));
typedef float f32x2 __attribute__((ext_vector_type(2)));
typedef unsigned u32x4 __attribute__((ext_vector_type(4)));
typedef unsigned u32x2 __attribute__((ext_vector_type(2)));
constexpr int BM = 256, BK = 64, HALF = 128, HTB = HALF * BK * 2, STAGE_BYTES = 8 * HTB, NXCD = 8, WGM = 4;

__host__ __device__ __forceinline__ int lds_byte(int r, int c) { const int st = (r >> 4) * 2 + (c >> 5), rr = r & 15, cc = c & 31, ob = rr * 64 + cc * 2; return st * 1024 + (ob ^ (((ob >> 9) & 1) << 5)); }
__host__ __device__ __forceinline__ void stage_rc(int b, int& R, int& C) { const int st = b / 1024, sb = b % 1024, swz = sb ^ (((sb >> 9) & 1) << 5); R = (st >> 1) * 16 + swz / 64; C = (st & 1) * 32 + (swz % 64) / 2; }
__host__ __device__ __forceinline__ int perm32(int rho) { const int n = rho >> 4, i = rho & 15; return 8 * (i >> 2) + 4 * n + (i & 3); }

struct Unit { int pm, pn; };
struct Gemm { const bf16_t* A; const bf16_t* Bt; int M, N, K; };

struct StaticOrder {
    int nM, nN, nwg, G, c;
    __host__ __device__ void init(int M, int N, int G_, int c_) { nM = M / BM; nN = N / BM; nwg = nM * nN; G = G_; c = c_; }
    __host__ __device__ bool next(int i, Unit& u) const {
        const long L = (long)i * G + c; if (L >= nwg) return false;
        int wgid = (int)L; { const int q = nwg / NXCD, r = nwg % NXCD, xcd = wgid % NXCD, off = wgid / NXCD; wgid = (xcd < r ? xcd * (q + 1) : r * (q + 1) + (xcd - r) * q) + off; }
        const int nig = WGM * nN, gid = wgid / nig, fm = gid * WGM, gsz = (nM - fm) < WGM ? (nM - fm) : WGM;
        u.pm = fm + ((wgid % nig) % gsz); u.pn = (wgid % nig) / gsz; return true;
    }
    __device__ __forceinline__ void a_ready(const Unit&) const {}
    __device__ __forceinline__ void done(const Unit&) const {}
};

typedef __bf16 nbf16x2 __attribute__((ext_vector_type(2)));
__device__ __forceinline__ unsigned cvt_pk_native(float lo, float hi) { const f32x2 v = {lo, hi}; return __builtin_bit_cast(unsigned, __builtin_convertvector(v, nbf16x2)); }
__device__ __forceinline__ unsigned cvt_pk_bf16(float lo, float hi) { unsigned r; asm volatile("s_nop 0\n\tv_cvt_pk_bf16_f32 %0, %1, %2" : "=v"(r) : "v"(lo), "v"(hi)); return r; }
__device__ __forceinline__ float bf_lo(unsigned w) { return __uint_as_float(w << 16); }
__device__ __forceinline__ float bf_hi(unsigned w) { return __uint_as_float(w & 0xffff0000u); }
__device__ __forceinline__ float fsigmoid(float x) { return __builtin_amdgcn_rcpf(1.0f + __builtin_amdgcn_exp2f(-1.44269504089f * x)); }


#ifndef NT_FROM
#define NT_FROM 7
#endif
struct EpiIn {
    static constexpr bool PERM = true, AFTER_DRAIN = false, IDEM = true; static constexpr int HOOK_T = 0;
    bf16_t* prw; bf16_t* pret; bf16_t* gg;
    __device__ __forceinline__ void operator()(const f32x4 (&acc)[2][2][4][2], const Unit& u, int wr, int wc, int fr, int fq) const {
        const int pn = u.pn; bf16_t* base; int ldc, colt, actk;
        if (pn < 7) { base = prw; ldc = 1792; colt = pn * 256; actk = 0; }
        else if (pn < 19) { base = pret; ldc = 3072; colt = (pn - 7) * 256; actk = (pn - 7 >= 8) ? 2 : 0; }
        else { base = gg; ldc = 2048; colt = (pn - 19) * 256; actk = 1; }
        const int row0 = u.pm * BM + wr * 64 + fr; const int col0 = colt + wc * 32 + 8 * fq;
#pragma unroll
        for (int ai = 0; ai < 2; ++ai)
#pragma unroll
            for (int m = 0; m < 4; ++m) { bf16_t* rowp = base + (size_t)(row0 + ai * HALF + m * 16) * ldc + col0;
#pragma unroll
                for (int bj = 0; bj < 2; ++bj) { f32x4 v0 = acc[ai][bj][m][0], v1 = acc[ai][bj][m][1];
                    if (actk) {
#pragma unroll
                        for (int i = 0; i < 4; ++i) { const float s0 = fsigmoid(v0[i]), s1 = fsigmoid(v1[i]); v0[i] = (actk == 2) ? v0[i] * s0 : s0; v1[i] = (actk == 2) ? v1[i] * s1 : s1; }
                    }
                    u32x4 w; w.x = cvt_pk_bf16(v0[0], v0[1]); w.y = cvt_pk_bf16(v0[2], v0[3]); w.z = cvt_pk_bf16(v1[0], v1[1]); w.w = cvt_pk_bf16(v1[2], v1[3]);
                    if (pn >= NT_FROM) __builtin_nontemporal_store(w, (u32x4*)(rowp + bj * HALF)); else *(u32x4*)(rowp + bj * HALF) = w; } }
    }
};

template <bool ADD> struct EpiGate {
    static constexpr bool PERM = true, AFTER_DRAIN = false, IDEM = false; static constexpr int HOOK_T = 0;
    bf16_t* O; const bf16_t* G; int gcol0;
    __device__ __forceinline__ void operator()(const f32x4 (&acc)[2][2][4][2], const Unit& u, int wr, int wc, int fr, int fq) const {
        const int row0 = u.pm * BM + wr * 64 + fr; const int col0 = u.pn * BM + wc * 32 + 8 * fq;
#pragma unroll
        for (int ai = 0; ai < 2; ++ai)
#pragma unroll
            for (int m = 0; m < 4; ++m) { const size_t row = (size_t)(row0 + ai * HALF + m * 16);
#pragma unroll
                for (int bj = 0; bj < 2; ++bj) { const f32x4 v0 = acc[ai][bj][m][0], v1 = acc[ai][bj][m][1];
                    const u32x4 gw = *(const u32x4*)(G + row * 2048 + gcol0 + col0 + bj * HALF);
                    float o[8];
                    o[0] = v0[0] * bf_lo(gw.x); o[1] = v0[1] * bf_hi(gw.x); o[2] = v0[2] * bf_lo(gw.y); o[3] = v0[3] * bf_hi(gw.y);
                    o[4] = v1[0] * bf_lo(gw.z); o[5] = v1[1] * bf_hi(gw.z); o[6] = v1[2] * bf_lo(gw.w); o[7] = v1[3] * bf_hi(gw.w);
                    bf16_t* op = O + row * 1024 + col0 + bj * HALF;
                    if (ADD) { const u32x4 pw = *(const u32x4*)op;
                        o[0] += bf_lo(pw.x); o[1] += bf_hi(pw.x); o[2] += bf_lo(pw.y); o[3] += bf_hi(pw.y); o[4] += bf_lo(pw.z); o[5] += bf_hi(pw.z); o[6] += bf_lo(pw.w); o[7] += bf_hi(pw.w); }
                    u32x4 w; w.x = cvt_pk_bf16(o[0], o[1]); w.y = cvt_pk_bf16(o[2], o[3]); w.z = cvt_pk_bf16(o[4], o[5]); w.w = cvt_pk_bf16(o[6], o[7]);
                    *(u32x4*)op = w; } }
    }
};

struct EpiMerge {
    static constexpr bool PERM = true, AFTER_DRAIN = false, IDEM = false; static constexpr int HOOK_T = 8;
    bf16_t* O; const bf16_t* G;
    __device__ __forceinline__ void hook(f32x4 (&acc)[2][2][4][2], const Unit& u, int wr, int wc, int fr, int fq) const {
        unsigned goff = (unsigned)((u.pm * BM + wr * 64 + fr) * 2048 + u.pn * BM + wc * 32 + 8 * fq) * 2u;
        asm volatile("" : "+v"(goff));
        const char* gp = (const char*)G;
#pragma unroll
        for (int ai = 0; ai < 2; ++ai)
#pragma unroll
            for (int m = 0; m < 4; ++m) {
#pragma unroll
                for (int bj = 0; bj < 2; ++bj) { const unsigned o = goff + (unsigned)(((ai * HALF + m * 16) * 2048 + bj * HALF) * 2);
                    const u32x4 ga = *(const u32x4*)(gp + o), gb = *(const u32x4*)(gp + o + 2048);
                    float r[8];
                    r[0] = bf_lo(ga.x) * __builtin_amdgcn_rcpf(fmaxf(bf_lo(gb.x), 1e-30f)); r[1] = bf_hi(ga.x) * __builtin_amdgcn_rcpf(fmaxf(bf_hi(gb.x), 1e-30f));
                    r[2] = bf_lo(ga.y) * __builtin_amdgcn_rcpf(fmaxf(bf_lo(gb.y), 1e-30f)); r[3] = bf_hi(ga.y) * __builtin_amdgcn_rcpf(fmaxf(bf_hi(gb.y), 1e-30f));
                    r[4] = bf_lo(ga.z) * __builtin_amdgcn_rcpf(fmaxf(bf_lo(gb.z), 1e-30f)); r[5] = bf_hi(ga.z) * __builtin_amdgcn_rcpf(fmaxf(bf_hi(gb.z), 1e-30f));
                    r[6] = bf_lo(ga.w) * __builtin_amdgcn_rcpf(fmaxf(bf_lo(gb.w), 1e-30f)); r[7] = bf_hi(ga.w) * __builtin_amdgcn_rcpf(fmaxf(bf_hi(gb.w), 1e-30f));
                    acc[ai][bj][m][0] = acc[ai][bj][m][0] * (f32x4){r[0], r[1], r[2], r[3]}; acc[ai][bj][m][1] = acc[ai][bj][m][1] * (f32x4){r[4], r[5], r[6], r[7]}; }
                asm volatile("" ::: "memory"); }
    }
    __device__ __forceinline__ void operator()(const f32x4 (&acc)[2][2][4][2], const Unit& u, int wr, int wc, int fr, int fq) const {
        const int row0 = u.pm * BM + wr * 64 + fr; const int col0 = u.pn * BM + wc * 32 + 8 * fq;
#pragma unroll
        for (int ai = 0; ai < 2; ++ai)
#pragma unroll
            for (int m = 0; m < 4; ++m) { const size_t row = (size_t)(row0 + ai * HALF + m * 16);
#pragma unroll
                for (int bj = 0; bj < 2; ++bj) { const f32x4 v0 = acc[ai][bj][m][0], v1 = acc[ai][bj][m][1];
                    const u32x4 gw = *(const u32x4*)(G + row * 2048 + 1024 + col0 + bj * HALF);
                    u32x4 w; w.x = cvt_pk_bf16(v0[0] * bf_lo(gw.x), v0[1] * bf_hi(gw.x)); w.y = cvt_pk_bf16(v0[2] * bf_lo(gw.y), v0[3] * bf_hi(gw.y));
                    w.z = cvt_pk_bf16(v1[0] * bf_lo(gw.z), v1[1] * bf_hi(gw.z)); w.w = cvt_pk_bf16(v1[2] * bf_lo(gw.w), v1[3] * bf_hi(gw.w));
                    *(u32x4*)(O + row * 1024 + col0 + bj * HALF) = w; } }
    }
};

struct EpiZ {
    static constexpr bool PERM = true, AFTER_DRAIN = false, IDEM = false; static constexpr int HOOK_T = 0;
    bf16_t* O; float* part; bool skip = false;
    __device__ __forceinline__ void operator()(const f32x4 (&acc)[2][2][4][2], const Unit& u, int wr, int wc, int fr, int fq) const {
        const int row0 = u.pm * BM + wr * 64 + fr; const int col0 = u.pn * BM + wc * 32 + 8 * fq;
#pragma unroll
        for (int ai = 0; ai < 2; ++ai)
#pragma unroll
            for (int m = 0; m < 4; ++m) { const size_t row = (size_t)(row0 + ai * HALF + m * 16); float ss = 0.f;
#pragma unroll
                for (int bj = 0; bj < 2; ++bj) { const f32x4 v0 = acc[ai][bj][m][0], v1 = acc[ai][bj][m][1];
                    ss += (v0[0] * v0[0] + v0[1] * v0[1]) + (v0[2] * v0[2] + v0[3] * v0[3]) + (v1[0] * v1[0] + v1[1] * v1[1]) + (v1[2] * v1[2] + v1[3] * v1[3]);
                    u32x4 w; w.x = cvt_pk_bf16(v0[0], v0[1]); w.y = cvt_pk_bf16(v0[2], v0[3]); w.z = cvt_pk_bf16(v1[0], v1[1]); w.w = cvt_pk_bf16(v1[2], v1[3]);
                    if (!skip) *(u32x4*)(O + row * 1024 + col0 + bj * HALF) = w; else asm volatile("" :: "v"(w)); }
                ss += __shfl_xor(ss, 16); ss += __shfl_xor(ss, 32);
                if (fq == 0 && !skip) part[row * 16 + u.pn * 4 + wc] = ss; }
    }
};

template <int CTRL> __device__ __forceinline__ float dpp0(float x) {
    return __builtin_bit_cast(float, __builtin_amdgcn_update_dpp(0, __builtin_bit_cast(int, x), CTRL, 0xf, 0xf, true));
}
__device__ __forceinline__ float gelu_tanh(float x) {
    const float in = x * (1.0f + 0.044715f * x * x);
    return x * __builtin_amdgcn_rcpf(1.0f + __builtin_amdgcn_exp2f(-2.302208198f * in));
}

struct EpiConv {
    static constexpr bool PERM = true, AFTER_DRAIN = false, IDEM = false; static constexpr int HOOK_T = 0;
    bf16_t* act; const float* cw; const float* cb; float* halo; PG8_LAS float* xch;
    __device__ __forceinline__ void operator()(const f32x4 (&acc)[2][2][4][2], const Unit& u, int wr, int wc, int fr, int fq) const {
        PG8_LAS f32x4* X = (PG8_LAS f32x4*)xch;
        if (fr >= 14) {
#pragma unroll
            for (int ai = 0; ai < 2; ++ai)
#pragma unroll
                for (int bj = 0; bj < 2; ++bj)
#pragma unroll
                    for (int n = 0; n < 2; ++n) X[(((((ai * 2 + wr) * 4 + wc) * 2 + (fr - 14)) * 2 + bj) * 2 + n) * 4 + fq] = acc[ai][bj][3][n];
        }
        {
            const int tcol = u.pn * 256 + wc * 32 + 8 * fq;
            if (wr == 0 && fr < 2) {
#pragma unroll
                for (int bj = 0; bj < 2; ++bj)
#pragma unroll
                    for (int n = 0; n < 2; ++n) *(f32x4*)(halo + ((size_t)(u.pm * 4 + fr)) * 5632 + tcol + bj * HALF + 4 * n) = acc[0][bj][0][n];
            }
            if (wr == 1 && fr >= 14) {
#pragma unroll
                for (int bj = 0; bj < 2; ++bj)
#pragma unroll
                    for (int n = 0; n < 2; ++n) *(f32x4*)(halo + ((size_t)(u.pm * 4 + 2 + (fr - 14))) * 5632 + tcol + bj * HALF + 4 * n) = acc[1][bj][3][n];
            }
        }
        asm volatile("s_waitcnt lgkmcnt(0)" ::: "memory"); __builtin_amdgcn_s_barrier(); asm volatile("" ::: "memory");
        const int j0 = u.pn * 128 + wc * 32 + 8 * fq;
        const float m0 = (fr == 0) ? 1.f : 0.f, m01 = (fr < 2) ? 1.f : 0.f;
        const bool first_tile = (u.pm & 7) == 0; (void)first_tile;
#pragma unroll
        for (int ai = 0; ai < 2; ++ai) {
            f32x4 xb[2][2];
#pragma unroll
            for (int bj = 0; bj < 2; ++bj)
#pragma unroll
                for (int n = 0; n < 2; ++n) xb[bj][n] = (f32x4){0.f, 0.f, 0.f, 0.f};
            if (!(ai == 0 && wr == 0) && fr >= 14) {
                const int sai = (wr == 1) ? ai : ai - 1, swr = (wr == 1) ? 0 : 1;
#pragma unroll
                for (int bj = 0; bj < 2; ++bj)
#pragma unroll
                    for (int n = 0; n < 2; ++n) xb[bj][n] = X[(((((sai * 2 + swr) * 4 + wc) * 2 + (fr - 14)) * 2 + bj) * 2 + n) * 4 + fq];
            }
            unsigned pk[4][4];
#pragma unroll
            for (int n = 0; n < 2; ++n) {
                const int jc = j0 + 4 * n;
                const f32x4 g0 = *(const f32x4*)(cw + jc), g1 = *(const f32x4*)(cw + 5632 + jc), g2 = *(const f32x4*)(cw + 2 * 5632 + jc), gb = *(const f32x4*)(cb + jc);
                const f32x4 v0 = *(const f32x4*)(cw + 2816 + jc), v1 = *(const f32x4*)(cw + 5632 + 2816 + jc), v2 = *(const f32x4*)(cw + 2 * 5632 + 2816 + jc), vb = *(const f32x4*)(cb + 2816 + jc);
#pragma unroll
                for (int i = 0; i < 4; ++i) {
                    const float g1m = g1[i] * m0, g0m = g0[i] * m01, v1m = v1[i] * m0, v0m = v0[i] * m01;
                    float og[4], ov[4];
#pragma unroll
                    for (int m = 0; m < 4; ++m) {
                        const float xg = acc[ai][0][m][n][i], xv = acc[ai][1][m][n][i];
                        const float pg = (m == 0) ? xb[0][n][i] : acc[ai][0][m - 1][n][i], pv = (m == 0) ? xb[1][n][i] : acc[ai][1][m - 1][n][i];
                        float a = gb[i] + g2[i] * xg; a += g1[i] * dpp0<0x111>(xg); a += g0[i] * dpp0<0x112>(xg); a += g1m * dpp0<0x121>(pg); a += g0m * dpp0<0x122>(pg);
                        float b = vb[i] + v2[i] * xv; b += v1[i] * dpp0<0x111>(xv); b += v0[i] * dpp0<0x112>(xv); b += v1m * dpp0<0x121>(pv); b += v0m * dpp0<0x122>(pv);
                        og[m] = a; ov[m] = b;
                    }
#pragma unroll
                    for (int m = 0; m < 4; ++m) og[m] = gelu_tanh(og[m]) * ov[m];
                    if (i & 1) {
#pragma unroll
                        for (int m = 0; m < 4; ++m) pk[m][n * 2 + (i >> 1)] = cvt_pk_bf16(__uint_as_float(pk[m][n * 2 + (i >> 1)]), og[m]);
                    } else {
#pragma unroll
                        for (int m = 0; m < 4; ++m) pk[m][n * 2 + (i >> 1)] = __float_as_uint(og[m]);
                    }
                }
            }
#pragma unroll
            for (int m = 0; m < 4; ++m) {
                u32x4 w; w.x = pk[m][0]; w.y = pk[m][1]; w.z = pk[m][2]; w.w = pk[m][3];
                *(u32x4*)(act + (size_t)(u.pm * BM + ai * HALF + wr * 64 + m * 16 + fr) * 2816 + j0) = w;
            }
        }
    }
};

#ifndef STAGGER_PCT
#define STAGGER_PCT 100
#endif
template <class Epi, class Sched, bool ALIGN_EPI = false, bool SP2 = false>
__device__ __forceinline__ void gemm_phase(PG8_LAS unsigned char* lds, const Gemm g, const Sched& S, const Epi& E, const int stagger_ticks = 0) {
    if (stagger_ticks > 0) {
        const unsigned long long target = __builtin_amdgcn_s_memrealtime() + (unsigned long long)((stagger_ticks * STAGGER_PCT / 100) * (int)((blockIdx.x >> 3) & 7));
        while (__builtin_amdgcn_s_memrealtime() < target) __builtin_amdgcn_s_sleep(8);
    }
    const int tid = threadIdx.x, wid = __builtin_amdgcn_readfirstlane(tid >> 6), lane = tid & 63, wr = wid >> 2, wc = wid & 3, fr = lane & 15, fq = lane >> 4;
    const int K = g.K, nt = K / BK;
    unsigned voffA[2], voffB[2];
#pragma unroll
    for (int i = 0; i < 2; ++i) { int R, C; stage_rc(tid * 16 + i * 8192, R, C); const int Rb = Epi::PERM ? ((R & ~31) + perm32(R & 31)) : R;
        voffA[i] = (unsigned)(R * K + C) * 2u; voffB[i] = (unsigned)(Rb * K + C) * 2u; }
    const size_t kstep = (size_t)(BK * 2);
    const size_t hstep = (size_t)HALF * K * 2;
    const size_t tstep = 2 * hstep;
    const unsigned ldsw = (unsigned)wid * 1024u;
    const int aoff = lds_byte(wr * 64 + fr, fq * 8), boff = lds_byte(wc * 32 + fr, fq * 8);
#define PG8_SA(b, h) (((b) * 2 + (h)) * HTB)
#define PG8_SB(b, h) ((4 + (b) * 2 + (h)) * HTB)
#define PG8_STAGE(bufoff, gbase, voff) do { _Pragma("unroll") for (int _i = 0; _i < 2; ++_i) \
        __builtin_amdgcn_global_load_lds((const unsigned*)((const char*)(gbase) + (voff)[_i]), (PG8_LAS unsigned*)(lds + (bufoff) + ldsw + _i * 8192), 16, 0, 0); } while (0)
#define PG8_LDA(dst, b, h) do { _Pragma("unroll") for (int m = 0; m < 4; ++m) _Pragma("unroll") for (int k = 0; k < 2; ++k) dst[m][k] = *(const PG8_LAS bf16x8*)(lds + PG8_SA(b, h) + aoff + m * 2048 + k * 1024); } while (0)
#define PG8_LDB(dst, b, h) do { _Pragma("unroll") for (int n = 0; n < 2; ++n) _Pragma("unroll") for (int k = 0; k < 2; ++k) dst[n][k] = *(const PG8_LAS bf16x8*)(lds + PG8_SB(b, h) + boff + n * 2048 + k * 1024); } while (0)
#define PG8_MMA(ai, bj, At, Bt) do { __builtin_amdgcn_s_setprio(1); _Pragma("unroll") for (int m = 0; m < 4; ++m) _Pragma("unroll") for (int n = 0; n < 2; ++n) _Pragma("unroll") for (int k = 0; k < 2; ++k) \
        acc[ai][bj][m][n] = __builtin_amdgcn_mfma_f32_16x16x32_bf16(Bt[n][k], At[m][k], acc[ai][bj][m][n], 0, 0, 0); __builtin_amdgcn_s_setprio(0); } while (0)
#define PG8_WAIT_V(n) asm volatile("s_waitcnt vmcnt(" #n ")" ::: "memory")
#define PG8_WAIT_L(n) asm volatile("s_waitcnt lgkmcnt(" #n ")" ::: "memory")
#define PG8_BAR __builtin_amdgcn_s_barrier()
#define PG8_SCHED __builtin_amdgcn_sched_barrier(0)
    Unit cur, nxt; int ui = 0;
    if (!S.next(0, cur)) return;
    f32x4 acc[2][2][4][2];
#pragma unroll
    for (int a = 0; a < 2; ++a)
#pragma unroll
        for (int b = 0; b < 2; ++b)
#pragma unroll
            for (int m = 0; m < 4; ++m)
#pragma unroll
                for (int n = 0; n < 2; ++n) acc[a][b][m][n] = (f32x4){0.f, 0.f, 0.f, 0.f};
    bf16x8 At[4][2], B0[2][2], B1[2][2];
    const char* cA = (const char*)g.A + (size_t)cur.pm * tstep; const char* cB = (const char*)g.Bt + (size_t)cur.pn * tstep;
    S.a_ready(cur);
    if constexpr (SP2) {
        PG8_STAGE(PG8_SB(0, 0), cB, voffB); PG8_STAGE(PG8_SB(0, 1), cB + hstep, voffB); PG8_STAGE(PG8_SA(0, 0), cA, voffA); PG8_STAGE(PG8_SA(0, 1), cA + hstep, voffA);
        if (wr == 1) PG8_BAR;
        PG8_WAIT_V(2); PG8_BAR;
        PG8_STAGE(PG8_SB(1, 0), cB + kstep, voffB); PG8_STAGE(PG8_SA(1, 0), cA + kstep, voffA); PG8_STAGE(PG8_SB(1, 1), cB + hstep + kstep, voffB);
        PG8_WAIT_V(6); PG8_BAR;
    } else {
        PG8_STAGE(PG8_SB(0, 0), cB, voffB); PG8_STAGE(PG8_SA(0, 0), cA, voffA); PG8_STAGE(PG8_SB(0, 1), cB + hstep, voffB); PG8_STAGE(PG8_SA(0, 1), cA + hstep, voffA);
        if (wr == 1) PG8_BAR;
        PG8_WAIT_V(4); PG8_BAR;
        PG8_STAGE(PG8_SB(1, 0), cB + kstep, voffB); PG8_STAGE(PG8_SA(1, 0), cA + kstep, voffA); PG8_STAGE(PG8_SB(1, 1), cB + hstep + kstep, voffB);
        PG8_WAIT_V(6); PG8_BAR;
    }
    for (;;) {
        const bool has_next = S.next(ui + 1, nxt);
        const char* nA = has_next ? (const char*)g.A + (size_t)nxt.pm * tstep : cA; const char* nB = has_next ? (const char*)g.Bt + (size_t)nxt.pn * tstep : cB;
        for (int t = 0; t < nt; t += 2) {
            const bool last = (t == nt - 2);
            const char* a1 = cA + (size_t)(t + 1) * kstep;
            const char* a2 = last ? nA : cA + (size_t)(t + 2) * kstep; const char* b2 = last ? nB : cB + (size_t)(t + 2) * kstep;
            const char* a3 = a2 + kstep; const char* b3 = b2 + kstep;
            if (last && has_next) S.a_ready(nxt);
            if constexpr (Epi::HOOK_T > 0) { if (t == Epi::HOOK_T) E.hook(acc, cur, wr, wc, fr, fq); }
            if constexpr (SP2) {
            PG8_LDB(B0, 0, 0); PG8_LDB(B1, 0, 1); PG8_SCHED; PG8_LDA(At, 0, 0); PG8_STAGE(PG8_SA(1, 1), a1 + hstep, voffA);
            PG8_WAIT_V(8); PG8_WAIT_L(0); PG8_BAR; PG8_MMA(0, 0, At, B0); PG8_MMA(0, 1, At, B1); PG8_BAR; PG8_SCHED;
            PG8_LDA(At, 0, 1); PG8_STAGE(PG8_SB(0, 0), b2, voffB); PG8_STAGE(PG8_SB(0, 1), b2 + hstep, voffB); PG8_STAGE(PG8_SA(0, 0), a2, voffA);
            PG8_WAIT_V(8); PG8_WAIT_L(0); PG8_BAR; PG8_MMA(1, 0, At, B0); PG8_MMA(1, 1, At, B1); PG8_BAR; PG8_SCHED;
            PG8_LDB(B0, 1, 0); PG8_LDB(B1, 1, 1); PG8_SCHED; PG8_LDA(At, 1, 0); PG8_STAGE(PG8_SA(0, 1), a2 + hstep, voffA);
            PG8_WAIT_V(8); PG8_WAIT_L(0); PG8_BAR; PG8_MMA(0, 0, At, B0); PG8_MMA(0, 1, At, B1); PG8_BAR; PG8_SCHED;
            PG8_LDA(At, 1, 1); PG8_STAGE(PG8_SB(1, 0), b3, voffB); PG8_STAGE(PG8_SB(1, 1), b3 + hstep, voffB); PG8_STAGE(PG8_SA(1, 0), a3, voffA);
            PG8_WAIT_V(8); PG8_WAIT_L(0); PG8_BAR; PG8_MMA(1, 0, At, B0); PG8_MMA(1, 1, At, B1); PG8_BAR; PG8_SCHED;
            } else {
            PG8_LDB(B0, 0, 0); PG8_SCHED; PG8_LDA(At, 0, 0); PG8_STAGE(PG8_SA(1, 1), a1 + hstep, voffA);
            PG8_WAIT_L(8); PG8_BAR; PG8_WAIT_L(0); PG8_MMA(0, 0, At, B0); PG8_BAR; PG8_SCHED;
            PG8_LDB(B1, 0, 1); PG8_STAGE(PG8_SB(0, 0), b2, voffB);
            PG8_BAR; PG8_WAIT_L(0); PG8_MMA(0, 1, At, B1); PG8_BAR;
            PG8_LDA(At, 0, 1); PG8_STAGE(PG8_SA(0, 0), a2, voffA);
            PG8_BAR; PG8_WAIT_L(0); PG8_MMA(1, 0, At, B0); PG8_BAR; PG8_SCHED;
            PG8_STAGE(PG8_SB(0, 1), b2 + hstep, voffB);
            PG8_WAIT_V(6); PG8_BAR; PG8_MMA(1, 1, At, B1); PG8_BAR;
            PG8_LDB(B0, 1, 0); PG8_SCHED; PG8_LDA(At, 1, 0); PG8_STAGE(PG8_SA(0, 1), a2 + hstep, voffA);
            PG8_WAIT_L(8); PG8_BAR; PG8_WAIT_L(0); PG8_MMA(0, 0, At, B0); PG8_BAR; PG8_SCHED;
            PG8_LDB(B1, 1, 1); PG8_STAGE(PG8_SB(1, 0), b3, voffB);
            PG8_BAR; PG8_WAIT_L(0); PG8_MMA(0, 1, At, B1); PG8_BAR;
            PG8_LDA(At, 1, 1); PG8_STAGE(PG8_SA(1, 0), a3, voffA);
            PG8_BAR; PG8_WAIT_L(0); PG8_MMA(1, 0, At, B0); PG8_BAR; PG8_SCHED;
            PG8_STAGE(PG8_SB(1, 1), b3 + hstep, voffB);
            PG8_WAIT_V(6); PG8_BAR; PG8_MMA(1, 1, At, B1); PG8_BAR;
            }
        }
        if constexpr (ALIGN_EPI) { if (wr == 0) PG8_BAR; }
        if constexpr (!Epi::AFTER_DRAIN) { E(acc, cur, wr, wc, fr, fq); if constexpr (Epi::IDEM && PROBE_PH == 300) E(acc, cur, wr, wc, fr, fq); S.done(cur); }
        if (!has_next) break;
#pragma unroll
        for (int a = 0; a < 2; ++a)
#pragma unroll
            for (int b = 0; b < 2; ++b)
#pragma unroll
                for (int m = 0; m < 4; ++m)
#pragma unroll
                    for (int n = 0; n < 2; ++n) acc[a][b][m][n] = (f32x4){0.f, 0.f, 0.f, 0.f};
        cur = nxt; cA = nA; cB = nB; ++ui;
        if constexpr (ALIGN_EPI) { if (wr == 1) PG8_BAR; }
    }
    PG8_WAIT_V(0);
    if constexpr (!ALIGN_EPI) { if (wr == 0) PG8_BAR; }
    PG8_BAR;
#undef PG8_SA
#undef PG8_SB
#undef PG8_STAGE
#undef PG8_LDA
#undef PG8_LDB
#undef PG8_MMA
#undef PG8_WAIT_V
#undef PG8_WAIT_L
#undef PG8_BAR
#undef PG8_SCHED
}
}

constexpr int NWAVES = 8;
constexpr int BATCH = 32, T = 2048, D = 1024, M = BATCH * T;
constexpr int RWH = 8, RWN = 64, RWW = 512, RW_COLS = 1792;
constexpr int RTH = 8, RDK = 64, RDV = 128, RET_COLS = 3072, RCH = 128;
constexpr int IN_COLS = 6912, DFF = 2816;
constexpr float RMS_EPS = 1e-6f, RW_GN_EPS = 64e-5f, RET_GN_EPS = 1e-5f;
constexpr int N_PHASES = 10;

constexpr size_t MiB = 1u << 20;
constexpr size_t WS_CTL = 0, CTL_ZERO_BYTES = 1 * MiB;
constexpr size_t WS_WIN = 2 * MiB, WS_WRW = 16 * MiB, WS_WRET = 17 * MiB, WS_WOUT = 19 * MiB, WS_WUP = 21 * MiB, WS_WDN = 32 * MiB;
constexpr size_t WS_ROPE = 38 * MiB, WS_PART = 54 * MiB, WS_PART2 = 58 * MiB, WS_HALO = 62 * MiB, WS_RWW = 84 * MiB;
constexpr size_t WS_PRW = 88 * MiB, WS_PRET = 312 * MiB, WS_G = 696 * MiB, WS_END = 952 * MiB;
constexpr size_t WS_MERGED = WS_PRW, WS_Z = WS_PRET, WS_XN2 = WS_G, WS_H1 = WS_G + 128 * MiB, WS_ACT = WS_PRET, WS_F = WS_PRW;
static_assert(WS_WIN + (size_t)IN_COLS * D * 2 <= WS_WRW && WS_WUP + (size_t)2 * DFF * D * 2 <= WS_WDN && WS_WDN + (size_t)D * DFF * 2 <= WS_ROPE, "ws map: weights");
static_assert(WS_ROPE + (size_t)M * 32 * 8 <= WS_PART && WS_HALO + (size_t)256 * 4 * 5632 * 4 <= WS_RWW && WS_RWW + 4 * MiB <= WS_PRW, "ws map: tables");
static_assert(WS_PRW + (size_t)M * RW_COLS * 2 <= WS_PRET && WS_PRET + (size_t)M * RET_COLS * 2 <= WS_G && WS_G + (size_t)M * 2048 * 2 <= WS_END, "ws map: activations");
static_assert(WS_ACT + (size_t)M * DFF * 2 <= WS_G, "ws map: act");
constexpr int CW_BAR = 4096;
constexpr size_t OUT_XN = 0, OUT_Y = 0;
constexpr int LDY = 1536;

constexpr int RING_OFF = 0, RING_BYTES = 131072;
constexpr int XCH_OFF = RING_BYTES, XCH_BYTES = 16384;
constexpr int LDSCTL_OFF = 160 * 1024 - 512, MISC_OFF = LDSCTL_OFF + 320;
constexpr int LDS_BYTES = 160 * 1024;
static_assert(MISC_OFF + 128 <= LDS_BYTES, "LDS map");

#define GAS __attribute__((address_space(1)))
#define LAS __attribute__((address_space(3)))
typedef unsigned short bf16;
typedef unsigned v4u __attribute__((ext_vector_type(4)));
typedef unsigned v2u __attribute__((ext_vector_type(2)));
typedef float f32x4 __attribute__((ext_vector_type(4)));
typedef float f32x2 __attribute__((ext_vector_type(2)));
typedef short bf16x8 __attribute__((ext_vector_type(8)));
typedef GAS unsigned gu32;
#define RLX_AGENT __ATOMIC_RELAXED, __HIP_MEMORY_SCOPE_AGENT
#define LDS_WAIT() asm volatile("s_waitcnt lgkmcnt(0)" ::: "memory")
#define VM_WAIT() asm volatile("s_waitcnt vmcnt(0)" ::: "memory")
__device__ __forceinline__ unsigned f2bf(float f) { unsigned u = __builtin_bit_cast(unsigned, f); return (u + 0x7fffu + ((u >> 16) & 1u)) >> 16; }
__device__ __forceinline__ unsigned pk2(float lo, float hi) { return pg8::cvt_pk_native(lo, hi); }
__device__ __forceinline__ float bflo(unsigned w) { return __uint_as_float(w << 16); }
__device__ __forceinline__ float bfhi(unsigned w) { return __uint_as_float(w & 0xffff0000u); }
__device__ __forceinline__ float bf1(bf16 v) { return __uint_as_float((unsigned)v << 16); }

#define XB_TMO      128
#define XB_XCNT(j)  (256  + 64 * (j))
#define XB_XSUB(j)  (1280 + 64 * (j))
#define XB_XGEN(j)  (2304 + 64 * (j))
#define XB_TOP      3328
#define XB_TOPGEN   3392
#define XCD_BAR_WORDS 3456
#define XB_SPIN_CAP (1u << 20)

__device__ __forceinline__ unsigned xb_ld(unsigned* p)              { return __hip_atomic_load(p, __ATOMIC_RELAXED, __HIP_MEMORY_SCOPE_AGENT); }
__device__ __forceinline__ unsigned xb_add(unsigned* p, unsigned v) { return __hip_atomic_fetch_add(p, v, __ATOMIC_RELAXED, __HIP_MEMORY_SCOPE_AGENT); }
__device__ __forceinline__ unsigned xb_xcc_id() { return (unsigned)__builtin_amdgcn_s_getreg((3 << 11) | 20) & 0xFu; }
#define XB_SPIN(cond, bar) do { unsigned _sp = 0; while (cond) { __builtin_amdgcn_s_sleep(1); \
    if ((++_sp & 255u) == 0u) { if (xb_ld(&(bar)[XB_TMO])) break; if (_sp > XB_SPIN_CAP) { atomicAdd(&(bar)[XB_TMO], 1u); break; } } } } while (0)

struct XcdBarrier { unsigned* bar; unsigned x; volatile LAS unsigned* st; };

__device__ __forceinline__ XcdBarrier xcd_barrier_post(unsigned* bar, volatile LAS unsigned* st) {
    XcdBarrier b; b.bar = bar; b.x = xb_xcc_id(); b.st = st;
    if (threadIdx.x == 0) (void)xb_add(&bar[XB_XCNT(b.x)], 1u);
    return b;
}
__device__ __forceinline__ void xcd_barrier_complete(unsigned* bar, unsigned x, unsigned& nloc, unsigned& nx) {
    const unsigned G = gridDim.x * gridDim.y * gridDim.z;
    unsigned sum, cnt, mine, sp = 0u;
    for (;;) {
        sum = 0u; cnt = 0u; mine = 0u;
#pragma unroll
        for (unsigned j = 0; j < 16; ++j) { const unsigned c = xb_ld(&bar[XB_XCNT(j)]); sum += c; cnt += (c > 0u) ? 1u : 0u; mine = (j == x) ? c : mine; }
        if (sum == G) break;
        __builtin_amdgcn_s_sleep(1);
        if ((++sp & 255u) == 0u) { if (xb_ld(&bar[XB_TMO])) break; if (sp > XB_SPIN_CAP) { atomicAdd(&bar[XB_TMO], 1u); break; } }
    }
    nloc = mine > 0u ? mine : 1u; nx = cnt > 0u ? cnt : 1u;
}
__device__ __forceinline__ void xcd_barrier(const XcdBarrier& b) {
    asm volatile("s_waitcnt vmcnt(0)" ::: "memory");
    __syncthreads();
    if (threadIdx.x == 0) {
        unsigned* bar = b.bar;
        __builtin_amdgcn_s_waitcnt(0);
        unsigned nloc = b.st[0], nx = b.st[1];
        if (nloc == 0u) { xcd_barrier_complete(bar, b.x, nloc, nx); b.st[0] = nloc; b.st[1] = nx; }
        const unsigned old = xb_add(&bar[XB_XSUB(b.x)], 1u);
        const unsigned gen = old / nloc;
        if (old + 1u == (gen + 1u) * nloc) {
            __builtin_amdgcn_fence(__ATOMIC_RELEASE, "agent");
            asm volatile("s_waitcnt vmcnt(0)" ::: "memory");
            const unsigned og = xb_add(&bar[XB_TOP], 1u);
            const unsigned tg = og / nx;
            if (og + 1u == (tg + 1u) * nx) xb_add(&bar[XB_TOPGEN], 1u);
            else XB_SPIN(xb_ld(&bar[XB_TOPGEN]) == tg, bar);
            __builtin_amdgcn_fence(__ATOMIC_ACQUIRE, "agent");
            xb_add(&bar[XB_XGEN(b.x)], 1u);
            asm volatile("s_waitcnt vmcnt(0)" ::: "memory");
        } else {
            XB_SPIN(xb_ld(&bar[XB_XGEN(b.x)]) == gen, bar);
            __builtin_amdgcn_fence(__ATOMIC_ACQUIRE, "agent");
            asm volatile("s_waitcnt vmcnt(0)" ::: "memory");
        }
    }
    __syncthreads();
}

struct Frame {
    LAS unsigned char* lds;
    volatile LAS unsigned* MISC;
    gu32* ctl;
    int tid, wave;
    int vcu, G;
    const float* in[25]; float* out; unsigned char* ws;
};

template <int CTRL> __device__ __forceinline__ float dppx(float x) {
    return __builtin_bit_cast(float, __builtin_amdgcn_mov_dpp(__builtin_bit_cast(int, x), CTRL, 0xf, 0xf, true));
}
#define DPP_GUARD1(a) asm volatile("s_nop 4" : "+v"(a))
#define DPP_GUARD4(a, b, c, d) asm volatile("s_nop 4" : "+v"(a), "+v"(b), "+v"(c), "+v"(d))
template <int CTRL> __device__ __forceinline__ float dpp_add(float v) { DPP_GUARD1(v); return v + dppx<CTRL>(v); }
__device__ __forceinline__ float row16_sum(float v) {
    v = dpp_add<0xB1>(v); v = dpp_add<0x4E>(v); v = dpp_add<0x141>(v); v = dpp_add<0x128>(v); return v;
}
template <int CTRL> __device__ __forceinline__ void dpp_add4(float (&v)[4]) {
    DPP_GUARD4(v[0], v[1], v[2], v[3]);
    const float t0 = dppx<CTRL>(v[0]), t1 = dppx<CTRL>(v[1]), t2 = dppx<CTRL>(v[2]), t3 = dppx<CTRL>(v[3]);
    v[0] += t0; v[1] += t1; v[2] += t2; v[3] += t3;
}
#define DPP_STEP2(ctrl) "v_add_f32_dpp %0, %0, %0 " ctrl " row_mask:0xf bank_mask:0xf bound_ctrl:1\n\tv_add_f32_dpp %1, %1, %1 " ctrl " row_mask:0xf bank_mask:0xf bound_ctrl:1\n\t"
#define DPP_CHAIN2(a, b, steps) asm volatile("s_nop 1\n\t" steps : "+v"(a), "+v"(b))
__device__ __forceinline__ void row16_sum4(float (&v)[4]) { dpp_add4<0xB1>(v); dpp_add4<0x4E>(v); dpp_add4<0x141>(v); dpp_add4<0x128>(v); }
__device__ __forceinline__ float wave_sum(float v) {
    v = row16_sum(v);
    const float s0 = __builtin_bit_cast(float, __builtin_amdgcn_readlane(__builtin_bit_cast(int, v), 0)), s1 = __builtin_bit_cast(float, __builtin_amdgcn_readlane(__builtin_bit_cast(int, v), 16));
    const float s2 = __builtin_bit_cast(float, __builtin_amdgcn_readlane(__builtin_bit_cast(int, v), 32)), s3 = __builtin_bit_cast(float, __builtin_amdgcn_readlane(__builtin_bit_cast(int, v), 48));
    return (s0 + s1) + (s2 + s3);
}

__device__ __forceinline__ void p0_transpose_item(const float* W, int N, bf16* WT, int ldw, int k0, int n0, int drow0, const float* kscale, LAS float* scr, int lane) {
    {
        const int kr = lane >> 3, c4 = 4 * (lane & 7);
        f32x4 v[8];
#pragma unroll
        for (int i = 0; i < 8; ++i) v[i] = __builtin_nontemporal_load((const f32x4*)(W + (size_t)(k0 + kr + 8 * i) * N + n0 + c4));
#pragma unroll
        for (int i = 0; i < 8; ++i) { const int kk = kr + 8 * i; f32x4 t = v[i]; if (kscale) t = t * kscale[k0 + kk];
            LAS float* d = scr + kk * 33 + c4; d[0] = t.x; d[1] = t.y; d[2] = t.z; d[3] = t.w; }
    }
    LDS_WAIT(); asm volatile("" ::: "memory");
    const int c = lane & 7;
#pragma unroll
    for (int j = 0; j < 4; ++j) { const int n = (lane >> 3) + 8 * j; const LAS float* s = scr + (8 * c) * 33 + n;
        v4u o; o.x = pk2(s[0 * 33], s[1 * 33]); o.y = pk2(s[2 * 33], s[3 * 33]); o.z = pk2(s[4 * 33], s[5 * 33]); o.w = pk2(s[6 * 33], s[7 * 33]);
        *(GAS v4u*)(WT + (size_t)(drow0 + n) * ldw + k0 + 8 * c) = o; }
    LDS_WAIT(); asm volatile("" ::: "memory");
}
__device__ __forceinline__ void p0_prologue(Frame& F) {
    LAS float* scr = (LAS float*)(F.lds + RING_OFF + F.wave * 16384);
    const int gw = F.vcu * NWAVES + F.wave, NGW = F.G * NWAVES;
    unsigned char* ws = F.ws;
    constexpr int I_IN = (D / 64) * (IN_COLS / 32), I_RW = (RWW / 64) * (D / 32), I_RET = (D / 64) * (D / 32), I_OUT = I_RET, I_UP = (D / 64) * (2 * DFF / 32), I_DN = (DFF / 64) * (D / 32);
    constexpr int I_W2 = (64 / 64) * (RWW / 32), I_G2 = (128 / 64) * (RWW / 32);
    constexpr int NITEMS = I_IN + I_RW + I_RET + I_OUT + I_UP + I_DN + 2 * I_W2 + I_G2;
    for (int it = gw; it < NITEMS; it += NGW) {
        int r = it;
        if (r < I_IN) { const int nb = IN_COLS / 32, kb = r / nb, n0 = 32 * (r % nb); p0_transpose_item(F.in[6], IN_COLS, (bf16*)(ws + WS_WIN), D, 64 * kb, n0, n0, F.in[2], scr, ((int)(threadIdx.x & 63))); continue; } r -= I_IN;
        if (r < I_RW) { const int nb = D / 32, kb = r / nb, n0 = 32 * (r % nb); p0_transpose_item(F.in[18], D, (bf16*)(ws + WS_WRW), RWW + D, 64 * kb, n0, n0, nullptr, scr, ((int)(threadIdx.x & 63))); continue; } r -= I_RW;
        if (r < I_RET) { const int nb = D / 32, kb = r / nb, n0 = 32 * (r % nb); p0_transpose_item(F.in[19], D, (bf16*)(ws + WS_WRW) + RWW, RWW + D, 64 * kb, n0, n0, nullptr, scr, ((int)(threadIdx.x & 63))); continue; } r -= I_RET;
        if (r < I_OUT) { const int nb = D / 32, kb = r / nb, n0 = 32 * (r % nb); p0_transpose_item(F.in[20], D, (bf16*)(ws + WS_WOUT), D, 64 * kb, n0, n0, nullptr, scr, ((int)(threadIdx.x & 63))); continue; } r -= I_OUT;
        if (r < I_UP) { const int nb = 2 * DFF / 32, kb = r / nb, n0 = 32 * (r % nb);
            const int j = (n0 < DFF) ? n0 : n0 - DFF, drow = (j / 128) * 256 + (j % 128) + ((n0 < DFF) ? 0 : 128);
            p0_transpose_item(F.in[21], 2 * DFF, (bf16*)(ws + WS_WUP), D, 64 * kb, n0, drow, F.in[4], scr, ((int)(threadIdx.x & 63))); continue; } r -= I_UP;
        if (r < I_DN) { const int nb = D / 32, kb = r / nb, n0 = 32 * (r % nb); p0_transpose_item(F.in[24], D, (bf16*)(ws + WS_WDN), DFF, 64 * kb, n0, n0, nullptr, scr, ((int)(threadIdx.x & 63))); continue; } r -= I_DN;
        if (r < I_W2) { const int n0 = 32 * r; p0_transpose_item(F.in[9], RWW, (bf16*)(ws + WS_RWW), 64, 0, n0, n0, nullptr, scr, ((int)(threadIdx.x & 63))); continue; } r -= I_W2;
        if (r < I_W2) { const int n0 = 32 * r; p0_transpose_item(F.in[11], RWW, (bf16*)(ws + WS_RWW + 65536), 64, 0, n0, n0, nullptr, scr, ((int)(threadIdx.x & 63))); continue; } r -= I_W2;
        { const int nb = RWW / 32, kb = r / nb, n0 = 32 * (r % nb); p0_transpose_item(F.in[12], RWW, (bf16*)(ws + WS_RWW + 131072), 128, 64 * kb, n0, n0, nullptr, scr, ((int)(threadIdx.x & 63))); }
    }
    const float* x = F.in[0]; bf16* XN = (bf16*)((unsigned char*)F.out + OUT_XN);
    {
        constexpr int PD = 2;
        f32x4 buf[PD][4];
        const int lane = ((int)(threadIdx.x & 63));
#pragma unroll
        for (int k = 0; k < PD; ++k) { const int mm = min(gw + k * NGW, M - 1); const GAS f32x4* xr = (const GAS f32x4*)(x + (size_t)mm * D) + lane;
#pragma unroll
            for (int j = 0; j < 4; ++j) buf[k][j] = __builtin_nontemporal_load(&xr[64 * j]); }
        int m0 = gw;
        for (; m0 + (PD - 1) * NGW < M; m0 += PD * NGW) {
#pragma unroll
            for (int k = 0; k < PD; ++k) { const int m = m0 + k * NGW;
                f32x4 v[4]; float s = 0.f;
#pragma unroll
                for (int j = 0; j < 4; ++j) v[j] = buf[k][j];
                { const int mn = min(m + PD * NGW, M - 1); const GAS f32x4* xr = (const GAS f32x4*)(x + (size_t)mn * D) + lane;
#pragma unroll
                    for (int j = 0; j < 4; ++j) buf[k][j] = __builtin_nontemporal_load(&xr[64 * j]); }
#pragma unroll
                for (int j = 0; j < 4; ++j) s += (v[j].x * v[j].x + v[j].y * v[j].y) + (v[j].z * v[j].z + v[j].w * v[j].w);
                const float rstd = __builtin_amdgcn_rsqf(wave_sum(s) * (1.f / D) + RMS_EPS);
                GAS v2u* o8 = (GAS v2u*)(XN + (size_t)m * D) + lane;
#pragma unroll
                for (int j = 0; j < 4; ++j) { v2u o; o.x = pk2(v[j].x * rstd, v[j].y * rstd); o.y = pk2(v[j].z * rstd, v[j].w * rstd); o8[64 * j] = o; }
            }
        }
        for (int m = m0; m < M; m += NGW) {
            const GAS f32x4* xr = (const GAS f32x4*)(x + (size_t)m * D) + lane; f32x4 v[4]; float s = 0.f;
#pragma unroll
            for (int j = 0; j < 4; ++j) { v[j] = xr[64 * j]; s += (v[j].x * v[j].x + v[j].y * v[j].y) + (v[j].z * v[j].z + v[j].w * v[j].w); }
            const float rstd = __builtin_amdgcn_rsqf(wave_sum(s) * (1.f / D) + RMS_EPS);
            GAS v2u* o8 = (GAS v2u*)(XN + (size_t)m * D) + lane;
#pragma unroll
            for (int j = 0; j < 4; ++j) { v2u o; o.x = pk2(v[j].x * rstd, v[j].y * rstd); o.y = pk2(v[j].z * rstd, v[j].w * rstd); o8[64 * j] = o; }
        }
    }
    {
        const int* pos = (const int*)F.in[1]; f32x2* rope = (f32x2*)(ws + WS_ROPE);
        const int gt = (F.vcu * NWAVES + F.wave) * 64 + ((int)(threadIdx.x & 63)), NT = F.G * NWAVES * 64;
        const int j = gt & 31;
        const double inv = exp2(-(double)j * (13.287712379549449 / 32.0));
        for (int e = gt; e < M * 32; e += NT) {
            const int row = e >> 5;
            double a = (double)pos[row] * inv; a -= 6.283185307179586 * rint(a * 0.15915494309189535);
            float sn, cs; sincosf((float)a, &sn, &cs);
            rope[e] = (f32x2){cs, sn};
        }
    }
}

constexpr int RW_TC = 32;
constexpr int RWL_STEP = 0, RWL_YP = 49152, RWL_GATE = 81920, RWL_BV = 90112, RWL_AW = 98304, RWL_AA = 102912, RWL_AG = 107520, RWL_W2T = 116224, RWL_A2T = 125440, RWL_G2T = 134656, RWL_MU = 152064, RWL_BK = 153856, RWL_VT = 154112, RWL_END = 162304;
static_assert(RWL_END <= LDSCTL_OFF, "rwkv lds");
#define LBAR() do { asm volatile("s_waitcnt lgkmcnt(0)" ::: "memory"); __builtin_amdgcn_s_barrier(); asm volatile("" ::: "memory"); } while (0)
__device__ __forceinline__ float fexp2(float x) { return __builtin_amdgcn_exp2f(x); }
__device__ __forceinline__ float frcp(float x) { return __builtin_amdgcn_rcpf(x); }
__device__ __forceinline__ float fsig(float x) { return frcp(1.0f + fexp2(-1.44269504089f * x)); }
__device__ __forceinline__ float ftanh(float x) { return 1.0f - 2.0f * frcp(1.0f + fexp2(2.88539008178f * x)); }
__device__ __forceinline__ unsigned cvtpk(float lo, float hi) { return pg8::cvt_pk_native(lo, hi); }
template <int KIND> __device__ __forceinline__ bf16x8 frag_map(bf16x8 v) {
    v4u u = __builtin_bit_cast(v4u, v);
#pragma unroll
    for (int i = 0; i < 4; ++i) { const float lo = bflo(u[i]), hi = bfhi(u[i]); u[i] = (KIND == 1) ? cvtpk(ftanh(lo), ftanh(hi)) : cvtpk(fsig(lo), fsig(hi)); }
    return __builtin_bit_cast(bf16x8, u);
}

typedef short rw_s4 __attribute__((ext_vector_type(4)));
__device__ __forceinline__ void rwkv_phase(Frame& F) {
    LAS unsigned char* L = F.lds;
    LAS float* STEP = (LAS float*)(L + RWL_STEP);
    LAS float* YP = (LAS float*)(L + RWL_YP);
    LAS float* PEND = (LAS float*)(L + RWL_YP + 8192);
    LAS float* WTOT = (LAS float*)(L + RWL_YP + 8192 + 256);
    LAS unsigned* SBAR = (LAS unsigned*)(L + RWL_YP + 8192 + 4608);
    LAS float* CST = (LAS float*)(L + RWL_YP + 8192 + 2560);
    LAS unsigned* ZW = (LAS unsigned*)(L + RWL_YP + 24576);
    LAS unsigned* BBKX = (LAS unsigned*)(L + RWL_YP + 16384);
    LAS bf16* GATEB = (LAS bf16*)(L + RWL_GATE);
    LAS float* BV = (LAS float*)(L + RWL_BV);
    LAS float* VT = (LAS float*)(L + RWL_VT);
    LAS bf16* AW = (LAS bf16*)(L + RWL_AW);
    LAS bf16* AA = (LAS bf16*)(L + RWL_AA);
    LAS bf16* AG = (LAS bf16*)(L + RWL_AG);
    LAS bf16* W2T = (LAS bf16*)(L + RWL_W2T);
    LAS bf16* A2T = (LAS bf16*)(L + RWL_A2T);
    LAS bf16* G2T = (LAS bf16*)(L + RWL_G2T);
    LAS float* MU = (LAS float*)(L + RWL_MU);
    const int tid = F.tid, lane = ((int)(threadIdx.x & 63)), w = F.wave;
    const int pt = tid & 255;
    const bf16* PRW = (const bf16*)(F.ws + WS_PRW);
    bf16* Yrw = (bf16*)((unsigned char*)F.out + OUT_Y);
    const float* mu = F.in[7]; const float* w0 = F.in[8]; const float* a0 = F.in[10]; const float* k_k = F.in[13]; const float* k_a = F.in[14]; const float* r_k = F.in[15];
    const float* lnw = F.in[16]; const float* lnb = F.in[17];
    int tid_o = tid; asm volatile("" : "+v"(tid_o));
    const int tt2 = tid_o >> 4, c4 = 4 * (tid_o & 15);
    constexpr int NC = T / RW_TC;
    for (int unit = F.vcu; unit < BATCH * RWH; unit += F.G) {
        const int b = unit >> 3, h = unit & 7;
        __syncthreads();
        {
            const bf16* w2g = (const bf16*)(F.ws + WS_RWW) + (size_t)h * 64 * 64; const bf16* a2g = (const bf16*)(F.ws + WS_RWW + 65536) + (size_t)h * 64 * 64; const bf16* g2g = (const bf16*)(F.ws + WS_RWW + 131072) + (size_t)h * 64 * 128;
            { const int n = tid >> 3, c = tid & 7; *(LAS v4u*)(W2T + n * 72 + 8 * c) = *(const v4u*)(w2g + n * 64 + 8 * c); *(LAS v4u*)(A2T + n * 72 + 8 * c) = *(const v4u*)(a2g + n * 64 + 8 * c); }
#pragma unroll
            for (int q = 0; q < 2; ++q) { const int e = tid + 512 * q, n = e >> 4, c = e & 15; *(LAS v4u*)(G2T + n * 136 + 8 * c) = *(const v4u*)(g2g + n * 128 + 8 * c); }
            if (tid < 4) ZW[tid] = 0u;
            if (tid == 0) *SBAR = 0u;
            if (tid < 64) { const int gi = h * 64 + tid; CST[tid] = w0[gi]; CST[64 + tid] = a0[gi]; CST[128 + tid] = k_k[gi]; CST[192 + tid] = k_a[gi]; CST[256 + tid] = r_k[gi]; CST[320 + tid] = lnw[gi]; CST[384 + tid] = lnb[gi]; }
            if (tid < 448) { const int cc = tid >> 3; int gc; if (cc < 8) gc = h * 64 + 8 * cc; else if (cc < 16) gc = 512 + h * 64 + 8 * (cc - 8); else if (cc < 24) gc = 1024 + h * 64 + 8 * (cc - 16); else gc = 1536 + 8 * (cc - 24);
                MU[tid] = mu[gc + (tid & 7)]; }
        }
        unsigned ioa[3];
#pragma unroll
        for (int q = 0; q < 3; ++q) { const int it = pt + 256 * q, tq_ = it / 24, cq_ = it % 24; ioa[q] = (unsigned)(tq_ * RW_COLS + ((cq_ < 8) ? h * 64 + 8 * cq_ : (cq_ < 16) ? 512 + h * 64 + 8 * (cq_ - 8) : 1024 + h * 64 + 8 * (cq_ - 16))); }
        const unsigned iol = (unsigned)((pt >> 3) * RW_COLS + 1536 + 8 * (pt & 7));
        f32x4 SM[4]; v4u bS0 = (v4u){0u, 0u, 0u, 0u}, bS1 = bS0;
#pragma unroll
        for (int t = 0; t < 4; ++t) SM[t] = (f32x4){0.f, 0.f, 0.f, 0.f};
        LBAR();
        bf16x8 wfr[8];
        {
            const int fr_ = lane & 15, fq_ = lane >> 4;
            if (w < 4) { const LAS bf16* Bop_ = (w < 2) ? W2T : A2T;
#pragma unroll
                for (int ks = 0; ks < 2; ++ks)
#pragma unroll
                    for (int nb = 0; nb < 4; ++nb) wfr[ks * 4 + nb] = *(const LAS bf16x8*)(Bop_ + (nb * 16 + fr_) * 72 + ks * 32 + 8 * fq_);
            } else { const int nb0_ = ((w - 4) >> 1) * 2;
#pragma unroll
                for (int ks = 0; ks < 4; ++ks)
#pragma unroll
                    for (int q = 0; q < 2; ++q) wfr[ks * 2 + q] = *(const LAS bf16x8*)(G2T + ((nb0_ + q) * 16 + fr_) * 136 + ks * 32 + 8 * fq_);
            }
        }
#define RW_ITEMS() \
            int pt_o = pt; asm volatile("" : "+v"(pt_o)); int itt[7], icc[7], igc[7];        \
            _Pragma("unroll") for (int q = 0; q < 3; ++q) { const int it = pt_o + 256 * q; itt[q] = it / 24; icc[q] = it % 24; } \
            _Pragma("unroll") for (int q = 3; q < 7; ++q) { itt[q] = pt_o >> 3; icc[q] = 24 + 8 * (q - 3) + (pt_o & 7); }        \
            _Pragma("unroll") for (int q = 0; q < 7; ++q) { const int cc = icc[q]; igc[q] = (cc < 8) ? h * 64 + 8 * cc : (cc < 16) ? 512 + h * 64 + 8 * (cc - 8) : (cc < 24) ? 1024 + h * 64 + 8 * (cc - 16) : 1536 + 8 * (cc - 24); }
        v4u rc[7], rp[7];
#define RW_LOAD_A(cn) do { \
            const bf16* cb_ = PRW + ((size_t)b * T + (size_t)(cn) * RW_TC) * RW_COLS; \
            _Pragma("unroll") for (int q = 0; q < 7; ++q) { const unsigned o_ = (q < 3) ? ioa[q < 3 ? q : 0] : iol + 64u * (unsigned)(q - 3); rc[q] = *(const v4u*)(cb_ + o_); \
                rp[q] = ((cn) > 0 || o_ >= (unsigned)RW_COLS) ? *(const v4u*)((cb_ - RW_COLS) + o_) : (v4u){0u, 0u, 0u, 0u}; } \
            } while (0)
#define RW_STAGE_A(cn) do { \
            RW_ITEMS() \
            _Pragma("unroll") for (int q = 0; q < 7; ++q) { \
                const int tt = itt[q], cc = icc[q]; const v4u cw = rc[q], pw = rp[q]; \
                const f32x4 m0 = *(const LAS f32x4*)(MU + cc * 8), m1 = *(const LAS f32x4*)(MU + cc * 8 + 4); \
                float x[8]; \
                { const float c0 = bflo(cw.x), c1 = bfhi(cw.x), c2 = bflo(cw.y), c3 = bfhi(cw.y), c4_ = bflo(cw.z), c5 = bfhi(cw.z), c6 = bflo(cw.w), c7 = bfhi(cw.w); \
                  x[0] = c0 + (bflo(pw.x) - c0) * m0[0]; x[1] = c1 + (bfhi(pw.x) - c1) * m0[1]; x[2] = c2 + (bflo(pw.y) - c2) * m0[2]; x[3] = c3 + (bfhi(pw.y) - c3) * m0[3]; \
                  x[4] = c4_ + (bflo(pw.z) - c4_) * m1[0]; x[5] = c5 + (bfhi(pw.z) - c5) * m1[1]; x[6] = c6 + (bflo(pw.w) - c6) * m1[2]; x[7] = c7 + (bfhi(pw.w) - c7) * m1[3]; } \
                if (q < 3) { \
                    const int a_ = (cc < 8) ? 4 : (cc < 16) ? 3 : 5; const int c8 = 8 * (cc & 7); \
                    LAS f32x4* d = (LAS f32x4*)(STEP + (tt * 6 + a_) * 64 + c8); \
                    d[0] = (f32x4){x[0], x[1], x[2], x[3]}; d[1] = (f32x4){x[4], x[5], x[6], x[7]}; \
                } else {        \
                    if (q == 3) { _Pragma("unroll") for (int i = 0; i < 8; ++i) x[i] = ftanh(x[i]); } \
                    else if (q >= 5) { _Pragma("unroll") for (int i = 0; i < 8; ++i) x[i] = fsig(x[i]); } \
                    v4u o; o.x = cvtpk(x[0], x[1]); o.y = cvtpk(x[2], x[3]); o.z = cvtpk(x[4], x[5]); o.w = cvtpk(x[6], x[7]); \
                    LAS bf16* dst = (q == 3) ? AW + tt * 72 + 8 * (cc - 24) : (q == 4) ? AA + tt * 72 + 8 * (cc - 32) : AG + tt * 136 + 8 * (cc - 40); \
                    *(LAS v4u*)dst = o; \
                } \
            } \
            } while (0)
        if (w >= 4) { RW_LOAD_A(0); RW_STAGE_A(0); }
        LBAR();
        for (int c = -1; c < NC; ++c) {
            if (c >= 0) {
            if (w < 4) {
                const int fr = lane & 15, fq = lane >> 4;
                const LAS unsigned* bkb = BBKX + (4 * fq + (fr & 3)) * 4;
                const LAS float* vrb = VT + 16 * w + fr;
                const LAS bf16* kkt = (const LAS bf16*)(STEP + 128) + fq * 16 + ((fr & 1) ? 64 : 0);
                const LAS bf16* avb = kkt - ((fr & 1) ? 768 : 0);
                LAS float* ypw = YP + 16 * w + fr;
                bf16x8 xa0 = *(const LAS bf16x8*)(kkt), xa1 = *(const LAS bf16x8*)(kkt + 8), ya0, ya1;
                v4u xbk = *(const LAS v4u*)(bkb), ybk; float xv = vrb[0], yv;
#define RW_STEP(tt, A0, A1, BKc, Vc, NA0, NA1, NBK, NV) do { \
                    NA0 = *(const LAS bf16x8*)(avb + ((tt) + 1) * 768); NA1 = *(const LAS bf16x8*)(avb + ((tt) + 1) * 768 + 8); \
                    if ((tt) + 1 < RW_TC) { NBK = *(const LAS v4u*)(bkb + ((tt) + 1) * 64); NV = vrb[((tt) + 1) * 64]; } \
                    const f32x4 d2 = __builtin_amdgcn_mfma_f32_16x16x32_bf16(A0, __builtin_bit_cast(bf16x8, bS0), (f32x4){0.f, 0.f, 0.f, 0.f}, 0, 0, 0);        \
                    const f32x4 e2 = __builtin_amdgcn_mfma_f32_16x16x32_bf16(A1, __builtin_bit_cast(bf16x8, bS1), (f32x4){0.f, 0.f, 0.f, 0.f}, 0, 0, 0); \
                    if ((tt) > 0) ypw[((tt) - 1) * 64] = d2[1] + e2[1]; \
                    const unsigned pr2 = cvtpk(d2[0] + e2[0], Vc); const v2u be = (v2u){pr2, 0u}, bo = (v2u){0u, pr2}; const v2u alo = (v2u){BKc.x, BKc.y}, ahi = (v2u){BKc.z, BKc.w}; \
                    SM[0] = __builtin_amdgcn_mfma_f32_4x4x4bf16_1k(__builtin_bit_cast(rw_s4, alo), __builtin_bit_cast(rw_s4, be), SM[0], 0, 0, 0); \
                    SM[1] = __builtin_amdgcn_mfma_f32_4x4x4bf16_1k(__builtin_bit_cast(rw_s4, alo), __builtin_bit_cast(rw_s4, bo), SM[1], 0, 0, 0); \
                    SM[2] = __builtin_amdgcn_mfma_f32_4x4x4bf16_1k(__builtin_bit_cast(rw_s4, ahi), __builtin_bit_cast(rw_s4, be), SM[2], 0, 0, 0); \
                    SM[3] = __builtin_amdgcn_mfma_f32_4x4x4bf16_1k(__builtin_bit_cast(rw_s4, ahi), __builtin_bit_cast(rw_s4, bo), SM[3], 0, 0, 0); \
                    bS0.x = cvtpk(SM[0][0], SM[0][1]); bS0.y = cvtpk(SM[0][2], SM[0][3]); bS0.z = cvtpk(SM[1][0], SM[1][1]); bS0.w = cvtpk(SM[1][2], SM[1][3]); \
                    bS1.x = cvtpk(SM[2][0], SM[2][1]); bS1.y = cvtpk(SM[2][2], SM[2][3]); bS1.z = cvtpk(SM[3][0], SM[3][1]); bS1.w = cvtpk(SM[3][2], SM[3][3]); \
                } while (0)
#pragma unroll
                for (int tt = 0; tt < RW_TC; tt += 2) {
                    RW_STEP(tt, xa0, xa1, xbk, xv, ya0, ya1, ybk, yv);
                    RW_STEP(tt + 1, ya0, ya1, ybk, yv, xa0, xa1, xbk, xv);
                }
#undef RW_STEP
                const bf16x8 av0 = xa0, av1 = xa1;
                {
                    f32x4 d2 = __builtin_amdgcn_mfma_f32_16x16x32_bf16(av0, __builtin_bit_cast(bf16x8, bS0), (f32x4){0.f, 0.f, 0.f, 0.f}, 0, 0, 0);
                    d2 = __builtin_amdgcn_mfma_f32_16x16x32_bf16(av1, __builtin_bit_cast(bf16x8, bS1), d2, 0, 0, 0);
                    ypw[(RW_TC - 1) * 64] = d2[1];
                }
                {
                    const LAS f32x4* pe = (const LAS f32x4*)(PEND + fq * 16);
#pragma unroll
                    for (int t = 0; t < 4; ++t) SM[t] = SM[t] * pe[t];
                    bS0.x = cvtpk(SM[0][0], SM[0][1]); bS0.y = cvtpk(SM[0][2], SM[0][3]); bS0.z = cvtpk(SM[1][0], SM[1][1]); bS0.w = cvtpk(SM[1][2], SM[1][3]);
                    bS1.x = cvtpk(SM[2][0], SM[2][1]); bS1.y = cvtpk(SM[2][2], SM[2][3]); bS1.z = cvtpk(SM[3][0], SM[3][1]); bS1.w = cvtpk(SM[3][2], SM[3][3]);
                }
            }
            else {
                if (c + 1 < NC) RW_STAGE_A(c + 1);
                __builtin_amdgcn_fence(__ATOMIC_RELEASE, "workgroup");
                if (lane == 0) __hip_atomic_fetch_add((unsigned*)SBAR, 1u, __ATOMIC_RELAXED, __HIP_MEMORY_SCOPE_WORKGROUP);
            }
            {
                const unsigned tgt_ = 4u * (unsigned)(c + 1);
                while (__hip_atomic_load((unsigned*)SBAR, __ATOMIC_RELAXED, __HIP_MEMORY_SCOPE_WORKGROUP) < tgt_) __builtin_amdgcn_s_sleep(1);
                __builtin_amdgcn_fence(__ATOMIC_ACQUIRE, "workgroup");
            }
            }
            const bool prep = (c + 1 < NC);
            if (c + 1 < NC) {
                LAS bf16* GATEn = GATEB + ((c + 1) & 1) * (RW_TC * 64); const int vw = w;
            {
                const int fr = lane & 15, fq = lane >> 4;
                if (vw < 4) {
                    const bool isw = (vw < 2); const int mb = vw & 1;
                    LAS bf16* Aop = isw ? AW : AA;
                    f32x4 acc[4];
#pragma unroll
                    for (int nb = 0; nb < 4; ++nb) acc[nb] = (f32x4){0.f, 0.f, 0.f, 0.f};
#pragma unroll
                    for (int ks = 0; ks < 2; ++ks) { const bf16x8 af = *(const LAS bf16x8*)(Aop + (mb * 16 + fr) * 72 + ks * 32 + 8 * fq);
#pragma unroll
                        for (int nb = 0; nb < 4; ++nb) { const bf16x8 bfv = wfr[ks * 4 + nb];
                            acc[nb] = __builtin_amdgcn_mfma_f32_16x16x32_bf16(af, bfv, acc[nb], 0, 0, 0); } }
                    const int slot = isw ? 0 : 1;
#pragma unroll
                    for (int nb = 0; nb < 4; ++nb)
#pragma unroll
                        for (int rg4 = 0; rg4 < 4; ++rg4) STEP[((mb * 16 + 4 * fq + rg4) * 6 + slot) * 64 + ((nb * 16 + fr) ^ (16 * fq))] = acc[nb][rg4];
                } else {
                    const int mb = (vw - 4) & 1, nb0 = ((vw - 4) >> 1) * 2;
                    f32x4 acc[2]; acc[0] = (f32x4){0.f, 0.f, 0.f, 0.f}; acc[1] = acc[0];
#pragma unroll
                    for (int ks = 0; ks < 4; ++ks) { const bf16x8 af = *(const LAS bf16x8*)(AG + (mb * 16 + fr) * 136 + ks * 32 + 8 * fq);
#pragma unroll
                        for (int q = 0; q < 2; ++q) { const bf16x8 bfv = wfr[ks * 2 + q];
                            acc[q] = __builtin_amdgcn_mfma_f32_16x16x32_bf16(af, bfv, acc[q], 0, 0, 0); } }
#pragma unroll
                    for (int q = 0; q < 2; ++q)
#pragma unroll
                        for (int rg4 = 0; rg4 < 4; ++rg4) GATEn[(mb * 16 + 4 * fq + rg4) * 64 + (nb0 + q) * 16 + fr] = (bf16)(cvtpk(acc[q][rg4], 0.f) & 0xffffu);
                }
            }
            }
            LBAR();
            if (w >= 4 && c + 2 < NC) RW_LOAD_A(c + 2);
            if (c >= 0) {
                float y[4];
#pragma unroll
                for (int r = 0; r < 4; ++r) y[r] = YP[tt2 * 64 + c4 + r];
                const float mean = row16_sum((y[0] + y[1]) + (y[2] + y[3])) * (1.f / 64.f);
                const f32x4 dlt = (f32x4){y[0] - mean, y[1] - mean, y[2] - mean, y[3] - mean};
                const float var = row16_sum((dlt[0] * dlt[0] + dlt[1] * dlt[1]) + (dlt[2] * dlt[2] + dlt[3] * dlt[3])) * (1.f / 64.f);
                const float rs = __builtin_amdgcn_rsqf(var + RW_GN_EPS);
                const f32x4 bv = *(const LAS f32x4*)(BV + tt2 * 64 + c4);
                const f32x4 lwv = *(const LAS f32x4*)(CST + 320 + c4), lbv = *(const LAS f32x4*)(CST + 384 + c4);
                const v2u gw = *(const LAS v2u*)(GATEB + (c & 1) * (RW_TC * 64) + tt2 * 64 + c4);
                const f32x4 gt = (f32x4){bflo(gw.x), bfhi(gw.x), bflo(gw.y), bfhi(gw.y)};
                const f32x4 o = (dlt * rs * lwv + lbv + bv) * gt;
                v2u pw; pw.x = cvtpk(o[0], o[1]); pw.y = cvtpk(o[2], o[3]);
                *(v2u*)(Yrw + ((size_t)b * T + (size_t)c * RW_TC + tt2) * LDY + h * 64 + c4) = pw;
            }
            if (prep) {
                LAS float* spt = STEP + tt2 * 384 + c4;
                const f32x4 w0v = *(const LAS f32x4*)(CST + c4), a0v = *(const LAS f32x4*)(CST + 64 + c4), kkv = *(const LAS f32x4*)(CST + 128 + c4), kav = *(const LAS f32x4*)(CST + 192 + c4), rkv = *(const LAS f32x4*)(CST + 256 + c4);
                const int sw0_ = c4 ^ (16 * ((tt2 >> 2) & 3));
                const f32x4 wl = *(const LAS f32x4*)(spt - c4 + sw0_), al = *(const LAS f32x4*)(spt - c4 + 64 + sw0_), xk = *(const LAS f32x4*)(spt + 192), rr = *(const LAS f32x4*)(spt + 256), vv = *(const LAS f32x4*)(spt + 320);
                constexpr float KD = -0.60653065971f * 1.44269504089f;
                f32x4 ld, a, kkr;
#pragma unroll
                for (int i = 0; i < 4; ++i) { ld[i] = KD * fsig(w0v[i] + wl[i]); a[i] = fsig(a0v[i] + al[i]); kkr[i] = xk[i] * kkv[i]; }
                const float n2 = row16_sum((kkr[0] * kkr[0] + kkr[1] * kkr[1]) + (kkr[2] * kkr[2] + kkr[3] * kkr[3]));
                const float inv = fminf(__builtin_amdgcn_rsqf(n2), 1e12f);
                const f32x4 kk = kkr * inv;
                const f32x4 kx = xk * (1.0f + (a - 1.0f) * kav);
                const f32x4 rk = rr * kx * rkv;
                const float bonus = row16_sum((rk[0] + rk[1]) + (rk[2] + rk[3]));
                f32x4 pl = ld;
#pragma unroll
                for (int i = 0; i < 4; ++i) {
                    float pv_ = pl[i];
                    const float u1 = __shfl_up(pv_, 16); if (lane >= 16) pv_ += u1;
                    const float u2 = __shfl_up(pv_, 32); if (lane >= 32) pv_ += u2;
                    pl[i] = pv_;
                }
                if (lane >= 48) *(LAS f32x4*)(WTOT + w * 64 + c4) = pl;
                LBAR();
                f32x4 L_ = pl;
                for (int w2 = 0; w2 < w; ++w2) L_ = L_ + *(const LAS f32x4*)(WTOT + w2 * 64 + c4);
                f32x4 Pm1, Pt, Pi;
#pragma unroll
                for (int i = 0; i < 4; ++i) { Pm1[i] = fexp2(L_[i] - ld[i]); Pt[i] = fexp2(L_[i]); Pi[i] = fexp2(-L_[i]); }
                const int tq = c4 >> 4, fqk = (c4 >> 2) & 3;
                if (tt2 == RW_TC - 1) *(LAS f32x4*)(PEND + fqk * 16 + tq * 4) = Pt;
                LAS bf16* kr = (LAS bf16*)(STEP + tt2 * 384 + 128) + fqk * 16 + (tq >> 1) * 8 + (tq & 1) * 4;
                { const f32x4 k2 = -kk * Pm1, r2 = rr * Pt;
                  v2u o; o.x = cvtpk(k2[0], k2[1]); o.y = cvtpk(k2[2], k2[3]); *(LAS v2u*)kr = o; o.x = cvtpk(r2[0], r2[1]); o.y = cvtpk(r2[2], r2[3]); *(LAS v2u*)(kr + 64) = o; }
                const f32x4 bbv = kk * a * Pi, kxv = kx * Pi;
#pragma unroll
                for (int i = 0; i < 4; ++i) BBKX[tt2 * 64 + ((c4 & 15) + i) * 4 + tq] = cvtpk(bbv[i], kxv[i]);
                *(LAS f32x4*)(VT + tt2 * 64 + c4) = vv;
                *(LAS f32x4*)(BV + tt2 * 64 + c4) = bonus * vv;
            }
            LBAR();
        }
#undef RW_STAGE_A
#undef RW_LOAD_A
#undef RW_ITEMS
    }
}

constexpr int RTL_Q = 0, RTL_K1 = 18432, RTL_V = 36864, RTL_SP = 73728, RTL_RT = 106496, RTL_END = 124928;
static_assert(RTL_END <= LDSCTL_OFF, "retention lds");
typedef short s16x4 __attribute__((ext_vector_type(4)));
__device__ __forceinline__ bf16x8 tr_frag(const LAS bf16* p, int rows4) {
    const s16x4 lo = __builtin_amdgcn_ds_read_tr16_b64_v4i16((LAS s16x4*)p);
    const s16x4 hi = __builtin_amdgcn_ds_read_tr16_b64_v4i16((LAS s16x4*)(p + rows4));
    return (bf16x8){lo[0], lo[1], lo[2], lo[3], hi[0], hi[1], hi[2], hi[3]};
}
__device__ __forceinline__ void retention_phase(Frame& F) {
    LAS unsigned char* L = F.lds;
    LAS bf16* Q = (LAS bf16*)(L + RTL_Q);
    LAS bf16* K1 = (LAS bf16*)(L + RTL_K1);
    LAS bf16* V = (LAS bf16*)(L + RTL_V);
    LAS bf16* SP = (LAS bf16*)(L + RTL_SP);
    LAS bf16* RT = (LAS bf16*)(L + RTL_RT);
    const int tid = F.tid, lane = ((int)(threadIdx.x & 63)), w = F.wave, fr = lane & 15, fq = lane >> 4;
    const bf16* PRET = (const bf16*)(F.ws + WS_PRET);
    const f32x2* rope = (const f32x2*)(F.ws + WS_ROPE);
    bf16* Yret = (bf16*)((unsigned char*)F.out + OUT_Y) + RWW;
    const int si = tid >> 2, sjc = tid & 3;
    const int i0 = 16 * w;
    const int trq = fr >> 2, trp = fr & 3;
    for (int unit = F.vcu; unit < BATCH * RTH; unit += F.G) {
        const int b = unit >> 3, h = unit & 7;
        const float lg2 = log1pf(-exp2f(-5.0f - (float)h)) * 1.44269504089f;
        const float cdec = fexp2(128.0f * lg2);
        const float ksc = 0.125f * fexp2(-(float)(si + 1) * lg2);
        float qd[4];
#pragma unroll
        for (int rg4 = 0; rg4 < 4; ++rg4) qd[rg4] = fexp2((float)(i0 + 4 * fq + rg4 + 1) * lg2);
        __syncthreads();
        for (int e = tid; e < 128 * 72 / 8; e += 512) *(LAS v4u*)(RT + 8 * e) = (v4u){0u, 0u, 0u, 0u};
        f32x4 accR[4];
#pragma unroll
        for (int db = 0; db < 4; ++db) accR[db] = (f32x4){0.f, 0.f, 0.f, 0.f};
        v4u pq0, pq1, pk0, pk1, pv[4]; f32x4 pr[4];
        {
            const size_t row = (size_t)b * T + si;
            const bf16* pr_ = PRET + row * RET_COLS + h * 64 + 8 * sjc;
            pq0 = *(const v4u*)(pr_); pq1 = *(const v4u*)(pr_ + 32); pk0 = *(const v4u*)(pr_ + 512); pk1 = *(const v4u*)(pr_ + 512 + 32);
            const f32x4* rp = (const f32x4*)(rope + row * 32 + 8 * sjc); pr[0] = rp[0]; pr[1] = rp[1]; pr[2] = rp[2]; pr[3] = rp[3];
#pragma unroll
            for (int q4 = 0; q4 < 4; ++q4) { const int e = tid + 512 * q4, iv = e >> 4, vc = e & 15; pv[q4] = *(const v4u*)(PRET + ((size_t)b * T + iv) * RET_COLS + 1024 + h * 128 + 8 * vc); }
        }
        for (int ch = 0; ch < T / RCH; ++ch) {
            const size_t rowbase = (size_t)b * T + (size_t)ch * RCH;
            {
                const float cs[8] = {pr[0][0], pr[0][2], pr[1][0], pr[1][2], pr[2][0], pr[2][2], pr[3][0], pr[3][2]}, sn[8] = {pr[0][1], pr[0][3], pr[1][1], pr[1][3], pr[2][1], pr[2][3], pr[3][1], pr[3][3]};
                {
                    const float z1[8] = {bflo(pq0.x), bfhi(pq0.x), bflo(pq0.y), bfhi(pq0.y), bflo(pq0.z), bfhi(pq0.z), bflo(pq0.w), bfhi(pq0.w)}, z2[8] = {bflo(pq1.x), bfhi(pq1.x), bflo(pq1.y), bfhi(pq1.y), bflo(pq1.z), bfhi(pq1.z), bflo(pq1.w), bfhi(pq1.w)};
                    float o1[8], o2[8];
#pragma unroll
                    for (int q = 0; q < 8; ++q) { o1[q] = z1[q] * cs[q] - z2[q] * sn[q]; o2[q] = z1[q] * sn[q] + z2[q] * cs[q]; }
                    v4u p1, p2; p1.x = pk2(o1[0], o1[1]); p1.y = pk2(o1[2], o1[3]); p1.z = pk2(o1[4], o1[5]); p1.w = pk2(o1[6], o1[7]); p2.x = pk2(o2[0], o2[1]); p2.y = pk2(o2[2], o2[3]); p2.z = pk2(o2[4], o2[5]); p2.w = pk2(o2[6], o2[7]);
                    *(LAS v4u*)(Q + si * 72 + 8 * sjc) = p1; *(LAS v4u*)(Q + si * 72 + 32 + 8 * sjc) = p2;
                }
                {
                    const float z1[8] = {bflo(pk0.x), bfhi(pk0.x), bflo(pk0.y), bfhi(pk0.y), bflo(pk0.z), bfhi(pk0.z), bflo(pk0.w), bfhi(pk0.w)}, z2[8] = {bflo(pk1.x), bfhi(pk1.x), bflo(pk1.y), bfhi(pk1.y), bflo(pk1.z), bfhi(pk1.z), bflo(pk1.w), bfhi(pk1.w)};
                    float o1[8], o2[8];
#pragma unroll
                    for (int q = 0; q < 8; ++q) { o1[q] = (z1[q] * cs[q] - z2[q] * sn[q]) * ksc; o2[q] = (z1[q] * sn[q] + z2[q] * cs[q]) * ksc; }
                    v4u p1, p2; p1.x = pk2(o1[0], o1[1]); p1.y = pk2(o1[2], o1[3]); p1.z = pk2(o1[4], o1[5]); p1.w = pk2(o1[6], o1[7]); p2.x = pk2(o2[0], o2[1]); p2.y = pk2(o2[2], o2[3]); p2.z = pk2(o2[4], o2[5]); p2.w = pk2(o2[6], o2[7]);
                    *(LAS v4u*)(K1 + si * 72 + 8 * sjc) = p1; *(LAS v4u*)(K1 + si * 72 + 32 + 8 * sjc) = p2;
                }
#pragma unroll
                for (int q4 = 0; q4 < 4; ++q4) { const int e = tid + 512 * q4, iv = e >> 4, vc = e & 15; *(LAS v4u*)(V + iv * 144 + 8 * vc) = pv[q4]; }
            }
            if (ch + 1 < T / RCH) {
                const size_t row = rowbase + RCH + si;
                const bf16* pr_ = PRET + row * RET_COLS + h * 64 + 8 * sjc;
                pq0 = *(const v4u*)(pr_); pq1 = *(const v4u*)(pr_ + 32); pk0 = *(const v4u*)(pr_ + 512); pk1 = *(const v4u*)(pr_ + 512 + 32);
                const f32x4* rp = (const f32x4*)(rope + row * 32 + 8 * sjc); pr[0] = rp[0]; pr[1] = rp[1]; pr[2] = rp[2]; pr[3] = rp[3];
#pragma unroll
                for (int q4 = 0; q4 < 4; ++q4) { const int e = tid + 512 * q4, iv = e >> 4, vc = e & 15; pv[q4] = *(const v4u*)(PRET + (rowbase + RCH + iv) * RET_COLS + 1024 + h * 128 + 8 * vc); }
            }
            LBAR();
            v4u gvp[4];
#pragma unroll
            for (int q = 0; q < 4; ++q) gvp[q] = *(const v4u*)(PRET + (rowbase + i0 + fr) * RET_COLS + 2048 + h * 128 + 32 * q + 8 * fq);
            bf16x8 qf[2];
#pragma unroll
            for (int ks = 0; ks < 2; ++ks) qf[ks] = *(const LAS bf16x8*)(Q + (i0 + fr) * 72 + ks * 32 + 8 * fq);
            LAS bf16* SPw = SP + w * 2048;
#pragma unroll
            for (int nb = 0; nb < 8; ++nb) {
                if (nb <= (w | 1)) {
                    f32x4 s = (f32x4){0.f, 0.f, 0.f, 0.f};
                    if (nb <= w) {
#pragma unroll
                        for (int ks = 0; ks < 2; ++ks) { const bf16x8 kf = *(const LAS bf16x8*)(K1 + (nb * 16 + fr) * 72 + ks * 32 + 8 * fq); s = __builtin_amdgcn_mfma_f32_16x16x32_bf16(qf[ks], kf, s, 0, 0, 0); }
                    }
                    const int key = nb * 16 + fr, qi = i0 + 4 * fq;
                    v2u pw; pw.x = pk2(key <= qi ? s[0] : 0.f, key <= qi + 1 ? s[1] : 0.f); pw.y = pk2(key <= qi + 2 ? s[2] : 0.f, key <= qi + 3 ? s[3] : 0.f);
                    *(LAS v2u*)(SPw + key * 16 + 4 * fq) = pw;
                }
            }
            LDS_WAIT();
            f32x4 o[8];
#pragma unroll
            for (int nb = 0; nb < 8; ++nb) o[nb] = (f32x4){0.f, 0.f, 0.f, 0.f};
#pragma unroll
            for (int ks = 0; ks < 4; ++ks) if (2 * ks <= w) { const bf16x8 sf = tr_frag(SPw + (32 * ks + 8 * fq + trq) * 16 + 4 * trp, 4 * 16);
#pragma unroll
                for (int nb = 0; nb < 8; ++nb) { const bf16x8 vf = tr_frag(V + (32 * ks + 8 * fq + trq) * 144 + 16 * nb + 4 * trp, 4 * 144); o[nb] = __builtin_amdgcn_mfma_f32_16x16x32_bf16(sf, vf, o[nb], 0, 0, 0); } }
#pragma unroll
            for (int ks = 0; ks < 2; ++ks)
#pragma unroll
                for (int n4 = 0; n4 < 2; ++n4) {
                    bf16x8 rf[4];
#pragma unroll
                    for (int nb = 0; nb < 4; ++nb) rf[nb] = *(const LAS bf16x8*)(RT + ((4 * n4 + nb) * 16 + fr) * 72 + ks * 32 + 8 * fq);
                    __builtin_amdgcn_sched_barrier(0);
#pragma unroll
                    for (int nb = 0; nb < 4; ++nb) o[4 * n4 + nb] = __builtin_amdgcn_mfma_f32_16x16x32_bf16(qf[ks], rf[nb], o[4 * n4 + nb], 0, 0, 0);
                    __builtin_amdgcn_sched_barrier(0);
                }
#pragma unroll
            for (int ks = 0; ks < 4; ++ks) { const bf16x8 vf = tr_frag(V + (32 * ks + 8 * fq + trq) * 144 + 16 * w + 4 * trp, 4 * 144);
#pragma unroll
                for (int db = 0; db < 4; ++db) { const bf16x8 kf = tr_frag(K1 + (32 * ks + 8 * fq + trq) * 72 + 16 * db + 4 * trp, 4 * 72); accR[db] = __builtin_amdgcn_mfma_f32_16x16x32_bf16(vf, kf, accR[db], 0, 0, 0); } }
#pragma unroll
            for (int db = 0; db < 4; ++db) accR[db] = accR[db] * cdec;
#pragma unroll
            for (int rg4 = 0; rg4 < 4; ++rg4)
#pragma unroll
                for (int nb = 0; nb < 8; ++nb) o[nb][rg4] *= qd[rg4];
            {
                float s1[4], s2[4];
#pragma unroll
                for (int rg4 = 0; rg4 < 4; ++rg4) { s1[rg4] = 0.f;
#pragma unroll
                    for (int nb = 0; nb < 8; ++nb) s1[rg4] += o[nb][rg4]; }
                row16_sum4(s1);
#pragma unroll
                for (int rg4 = 0; rg4 < 4; ++rg4) { const float mean = s1[rg4] * (1.f / 128.f); s2[rg4] = 0.f;
#pragma unroll
                    for (int nb = 0; nb < 8; ++nb) { o[nb][rg4] -= mean; s2[rg4] += o[nb][rg4] * o[nb][rg4]; } }
                row16_sum4(s2);
#pragma unroll
                for (int rg4 = 0; rg4 < 4; ++rg4) { const float rs = __builtin_amdgcn_rsqf(s2[rg4] * (1.f / 128.f) + RET_GN_EPS);
#pragma unroll
                    for (int nb = 0; nb < 8; ++nb) o[nb][rg4] *= rs; }
            }
#pragma unroll
            for (int nb = 0; nb < 8; ++nb) { v2u pw; pw.x = pk2(o[nb][0], o[nb][1]); pw.y = pk2(o[nb][2], o[nb][3]); *(LAS v2u*)(SPw + (nb * 16 + fr) * 16 + 4 * fq) = pw; }
            LDS_WAIT();
#pragma unroll
            for (int q = 0; q < 4; ++q) {
                const int c8 = 32 * q + 8 * fq; const size_t row = rowbase + i0 + fr;
                const v4u ov = __builtin_bit_cast(v4u, tr_frag(SPw + (32 * q + 8 * fq + trq) * 16 + 4 * trp, 4 * 16)); const v4u gv = gvp[q];
                v4u r; r.x = pk2(bflo(ov.x) * bflo(gv.x), bfhi(ov.x) * bfhi(gv.x)); r.y = pk2(bflo(ov.y) * bflo(gv.y), bfhi(ov.y) * bfhi(gv.y));
                r.z = pk2(bflo(ov.z) * bflo(gv.z), bfhi(ov.z) * bfhi(gv.z)); r.w = pk2(bflo(ov.w) * bflo(gv.w), bfhi(ov.w) * bfhi(gv.w));
                *(v4u*)(Yret + row * LDY + h * 128 + c8) = r;
            }
            LBAR();
#pragma unroll
            for (int db = 0; db < 4; ++db)
#pragma unroll
                for (int rg4 = 0; rg4 < 4; ++rg4) RT[(w * 16 + 4 * fq + rg4) * 72 + db * 16 + fr] = (bf16)(pk2(accR[db][rg4], 0.f) & 0xffffu);
        }
    }
}

__device__ __forceinline__ void norm_mix_phase(Frame& F) {
    const int gw = F.vcu * NWAVES + F.wave, NGW = F.G * NWAVES;
    const bf16* Z = (const bf16*)(F.ws + WS_Z); const float* part = (const float*)(F.ws + WS_PART); const float* x = F.in[0]; const float* gpost = F.in[3];
    bf16* XN2 = (bf16*)(F.ws + WS_XN2);
    f32x4 g[4];
#pragma unroll
    for (int j = 0; j < 4; ++j) g[j] = ((const f32x4*)gpost)[((int)(threadIdx.x & 63)) + 64 * j];
    constexpr int PD = 2;
    f32x4 bx[PD][4]; v2u bz[PD][4]; float bp[PD];
    const int lane = ((int)(threadIdx.x & 63));
    int l15 = lane & 15; asm volatile("" : "+v"(l15));
#define P5_LOAD(k, mm) do { bp[k] = part[(size_t)(mm) * 16 + l15]; \
        const GAS f32x4* xr_ = (const GAS f32x4*)(x + (size_t)(mm) * D) + lane; const GAS v2u* zr_ = (const GAS v2u*)(Z + (size_t)(mm) * D) + lane; \
        _Pragma("unroll") for (int j = 0; j < 4; ++j) { bx[k][j] = __builtin_nontemporal_load(&xr_[64 * j]); bz[k][j] = __builtin_nontemporal_load(&zr_[64 * j]); } } while (0)
#define P5_ROW(m, pv, xv, zv) do { \
        const float rstd = __builtin_amdgcn_rsqf(row16_sum(pv) * (1.f / D) + RMS_EPS);        \
        f32x4 hv[4]; float s = 0.f; \
        _Pragma("unroll") for (int j = 0; j < 4; ++j) { const v2u zw = zv[j]; const f32x4 z = (f32x4){bflo(zw.x), bfhi(zw.x), bflo(zw.y), bfhi(zw.y)}; \
            hv[j] = xv[j] + z * rstd * g[j]; s += (hv[j].x * hv[j].x + hv[j].y * hv[j].y) + (hv[j].z * hv[j].z + hv[j].w * hv[j].w); } \
        const float rstd2 = __builtin_amdgcn_rsqf(wave_sum(s) * (1.f / D) + RMS_EPS); \
        GAS v2u* h8 = (GAS v2u*)((bf16*)(F.ws + WS_H1) + (size_t)(m) * D) + lane; GAS v2u* o8 = (GAS v2u*)(XN2 + (size_t)(m) * D) + lane; \
        _Pragma("unroll") for (int j = 0; j < 4; ++j) { v2u hb; hb.x = pk2(hv[j].x, hv[j].y); hb.y = pk2(hv[j].z, hv[j].w); __builtin_nontemporal_store(hb, &h8[64 * j]); v2u o; o.x = pk2(hv[j].x * rstd2, hv[j].y * rstd2); o.y = pk2(hv[j].z * rstd2, hv[j].w * rstd2); o8[64 * j] = o; } } while (0)
#pragma unroll
    for (int k = 0; k < PD; ++k) P5_LOAD(k, min(gw + k * NGW, M - 1));
    int m0 = gw;
    for (; m0 + (PD - 1) * NGW < M; m0 += PD * NGW) {
#pragma unroll
        for (int k = 0; k < PD; ++k) { const int m = m0 + k * NGW;
            const float pv = bp[k]; f32x4 xv[4]; v2u zv[4];
#pragma unroll
            for (int j = 0; j < 4; ++j) { xv[j] = bx[k][j]; zv[j] = bz[k][j]; }
            P5_LOAD(k, min(m + PD * NGW, M - 1));
            P5_ROW(m, pv, xv, zv);
        }
    }
    for (int m = m0; m < M; m += NGW) {
        P5_LOAD(0, m); const float pv = bp[0]; f32x4 xv[4]; v2u zv[4];
#pragma unroll
        for (int j = 0; j < 4; ++j) { xv[j] = bx[0][j]; zv[j] = bz[0][j]; }
        P5_ROW(m, pv, xv, zv);
    }
#undef P5_ROW
#undef P5_LOAD
}
__device__ __forceinline__ void norm_ffn_phase(Frame& F) {
    const int gw = F.vcu * NWAVES + F.wave, NGW = F.G * NWAVES;
    const bf16* Z = (const bf16*)(F.ws + WS_F); const float* part = (const float*)(F.ws + WS_PART2); const float* gpost = F.in[5];
    f32x4 g[4];
#pragma unroll
    for (int j = 0; j < 4; ++j) g[j] = ((const f32x4*)gpost)[((int)(threadIdx.x & 63)) + 64 * j];
    constexpr int PD = 2;
    v2u bz[PD][4], bh[PD][4]; float bp[PD];
    const int lane = ((int)(threadIdx.x & 63));
    int l15 = lane & 15; asm volatile("" : "+v"(l15));
#define P9_LOAD(k, mm) do { bp[k] = part[(size_t)(mm) * 16 + l15]; \
        const GAS v2u* zr_ = (const GAS v2u*)(Z + (size_t)(mm) * D) + lane; const GAS v2u* hr_ = (const GAS v2u*)((const bf16*)(F.ws + WS_H1) + (size_t)(mm) * D) + lane; \
        _Pragma("unroll") for (int j = 0; j < 4; ++j) { bz[k][j] = __builtin_nontemporal_load(&zr_[64 * j]); bh[k][j] = __builtin_nontemporal_load(&hr_[64 * j]); } } while (0)
#define P9_ROW(m, pv, zv, hv) do { \
        const float rstd = __builtin_amdgcn_rsqf(row16_sum(pv) * (1.f / D) + RMS_EPS); \
        GAS f32x4* orow = (GAS f32x4*)(F.out + (size_t)(m) * D) + lane; \
        _Pragma("unroll") for (int j = 0; j < 4; ++j) { const v2u zw = zv[j], hw = hv[j]; const f32x4 z = (f32x4){bflo(zw.x), bfhi(zw.x), bflo(zw.y), bfhi(zw.y)}, hh = (f32x4){bflo(hw.x), bfhi(hw.x), bflo(hw.y), bfhi(hw.y)}; \
            __builtin_nontemporal_store(hh + z * rstd * g[j], &orow[64 * j]); } } while (0)
#pragma unroll
    for (int k = 0; k < PD; ++k) P9_LOAD(k, min(gw + k * NGW, M - 1));
    int m0 = gw;
    for (; m0 + (PD - 1) * NGW < M; m0 += PD * NGW) {
#pragma unroll
        for (int k = 0; k < PD; ++k) { const int m = m0 + k * NGW;
            const float pv = bp[k]; v2u zv[4], hv[4];
#pragma unroll
            for (int j = 0; j < 4; ++j) { zv[j] = bz[k][j]; hv[j] = bh[k][j]; }
            P9_LOAD(k, min(m + PD * NGW, M - 1));
            P9_ROW(m, pv, zv, hv);
        }
    }
    for (int m = m0; m < M; m += NGW) {
        P9_LOAD(0, m); const float pv = bp[0]; v2u zv[4], hv[4];
#pragma unroll
        for (int j = 0; j < 4; ++j) { zv[j] = bz[0][j]; hv[j] = bh[0][j]; }
        P9_ROW(m, pv, zv, hv);
    }
#undef P9_ROW
#undef P9_LOAD
}
__device__ __forceinline__ void conv_fixup_phase(Frame& F) {
    const float* halo = (const float*)(F.ws + WS_HALO); const float* cw = F.in[22]; const float* cb = F.in[23]; bf16* act = (bf16*)(F.ws + WS_ACT);
    const int gt = (F.vcu * NWAVES + F.wave) * 64 + ((int)(threadIdx.x & 63)), NT = F.G * NWAVES * 64;
    for (int e = gt; e < 256 * DFF; e += NT) {
        const int pm = e / DFF, j = e % DFF; if ((pm & 7) == 0) continue;
        const int tg = (j >> 7) * 256 + (j & 127), tv = tg + 128;
        const float* hc = halo + (size_t)pm * 4 * 5632; const float* hp = halo + (size_t)(pm - 1) * 4 * 5632;
        const float g254 = hp[2 * 5632 + tg], g255 = hp[3 * 5632 + tg], g0 = hc[tg], g1 = hc[5632 + tg];
        const float v254 = hp[2 * 5632 + tv], v255 = hp[3 * 5632 + tv], v0 = hc[tv], v1 = hc[5632 + tv];
        const float cg0 = cw[j], cg1 = cw[5632 + j], cg2 = cw[2 * 5632 + j], cgb = cb[j];
        const float cv0 = cw[DFF + j], cv1 = cw[5632 + DFF + j], cv2 = cw[2 * 5632 + DFF + j], cvb = cb[DFF + j];
        const float og0 = cgb + cg0 * g254 + cg1 * g255 + cg2 * g0, og1 = cgb + cg0 * g255 + cg1 * g0 + cg2 * g1;
        const float ov0 = cvb + cv0 * v254 + cv1 * v255 + cv2 * v0, ov1 = cvb + cv0 * v255 + cv1 * v0 + cv2 * v1;
        act[(size_t)(pm * 256) * DFF + j] = (bf16)f2bf(pg8::gelu_tanh(og0) * ov0);
        act[(size_t)(pm * 256 + 1) * DFF + j] = (bf16)f2bf(pg8::gelu_tanh(og1) * ov1);
    }
}

struct Args { const float* in[25]; float* out; unsigned char* ws; int ph_lo, ph_hi, li, pad; };
__global__ void __launch_bounds__(NWAVES * 64, 2) hyb_fwd(Args args) {
    extern __shared__ __attribute__((aligned(16))) unsigned char lds[];
    Frame F;
    F.lds = (LAS unsigned char*)lds;
    F.MISC = (volatile LAS unsigned*)(F.lds + MISC_OFF);
    F.tid = threadIdx.x; F.wave = __builtin_amdgcn_readfirstlane(F.tid >> 6);
    F.G = gridDim.x; { const int bx = blockIdx.x; F.vcu = (F.G % 8 == 0) ? (bx % 8) * (F.G / 8) + bx / 8 : bx; }
    unsigned char* ws = args.ws; F.ws = ws; F.out = args.out;
#pragma unroll
    for (int i = 0; i < 25; ++i) F.in[i] = args.in[i];
    F.ctl = (gu32*)(ws + WS_CTL);
    for (int u = F.tid; u < (LDS_BYTES - LDSCTL_OFF) / 4; u += NWAVES * 64) ((LAS unsigned*)(F.lds + LDSCTL_OFF))[u] = 0u;
    __syncthreads();
    XcdBarrier bar; bar.bar = (unsigned*)(F.ctl + CW_BAR) + args.li * XCD_BAR_WORDS; bar.x = 0; bar.st = nullptr;
    if (MK_N_LAUNCHES == 1) bar = xcd_barrier_post((unsigned*)(F.ctl + CW_BAR) + args.li * XCD_BAR_WORDS, F.MISC + 8);
    const int lo = args.ph_lo, hi = args.ph_hi;
#define IN(k) (lo <= (k) && (k) < hi)
#define SEAM(k) do { if (IN(k) && IN((k) + 1)) xcd_barrier(bar); } while (0)
    using namespace pg8;
    bf16* XN = (bf16*)((unsigned char*)F.out + OUT_XN);

    if (IN(0)) { REP(0) p0_prologue(F); } SEAM(0);
    if (IN(1)) REP(1) {
        Gemm g{XN, (const bf16_t*)(ws + WS_WIN), M, IN_COLS, D}; StaticOrder S; S.init(M, IN_COLS, F.G, (int)blockIdx.x);
        EpiIn E{(bf16_t*)(ws + WS_PRW), (bf16_t*)(ws + WS_PRET), (bf16_t*)(ws + WS_G)};
        gemm_phase<EpiIn, StaticOrder, true, true>(F.lds + RING_OFF, g, S, E);
    } SEAM(1);
    if (IN(2)) { REP(20) rwkv_phase(F); __syncthreads(); REP(21) retention_phase(F); } SEAM(2);
    if (IN(3)) REP(3) {
        Gemm g{(const bf16_t*)((unsigned char*)F.out + OUT_Y), (const bf16_t*)(ws + WS_WRW), M, D, LDY}; StaticOrder S; S.init(M, D, F.G, (int)blockIdx.x);
        EpiMerge E{(bf16_t*)(ws + WS_MERGED), (const bf16_t*)(ws + WS_G)};
        gemm_phase<EpiMerge, StaticOrder, true, true>(F.lds + RING_OFF, g, S, E);
    } SEAM(3);
    if (IN(4)) REP(4) {
        Gemm g{(const bf16_t*)(ws + WS_MERGED), (const bf16_t*)(ws + WS_WOUT), M, D, D}; StaticOrder S; S.init(M, D, F.G, (int)blockIdx.x);
        EpiZ E{(bf16_t*)(ws + WS_Z), (float*)(ws + WS_PART), (PROBE_NOSTORE != 0) && args.li == 1 && lo == 4};
        gemm_phase<EpiZ, StaticOrder, true, true>(F.lds + RING_OFF, g, S, E);
    } SEAM(4);
    if (IN(5)) { REP(5) norm_mix_phase(F); } SEAM(5);
    if (IN(6)) REP(6) {
        Gemm g{(const bf16_t*)(ws + WS_XN2), (const bf16_t*)(ws + WS_WUP), M, 2 * DFF, D}; StaticOrder S; S.init(M, 2 * DFF, F.G, (int)blockIdx.x);
        EpiConv E{(bf16_t*)(ws + WS_ACT), F.in[22], F.in[23], (float*)(ws + WS_HALO), (PG8_LAS float*)(F.lds + XCH_OFF)};
        gemm_phase<EpiConv, StaticOrder, true, true>(F.lds + RING_OFF, g, S, E);
    } SEAM(6);
    if (IN(7)) { REP(7) conv_fixup_phase(F); } SEAM(7);
    if (IN(8)) REP(8) {
        Gemm g{(const bf16_t*)(ws + WS_ACT), (const bf16_t*)(ws + WS_WDN), M, D, DFF}; StaticOrder S; S.init(M, D, F.G, (int)blockIdx.x);
        EpiZ E{(bf16_t*)(ws + WS_F), (float*)(ws + WS_PART2)};
        gemm_phase<EpiZ, StaticOrder, true, true>(F.lds + RING_OFF, g, S, E);
    } SEAM(8);
    if (IN(9)) { REP(9) norm_ffn_phase(F); }
#undef IN
#undef SEAM
}

extern "C" void kernel_launch(void* const* d_in, const int* in_sizes, int n_in, void* d_out, int out_size, void* d_ws, size_t ws_size, hipStream_t stream) {
    static int grid = 0;
    if (grid == 0) {
        if (n_in != 25 || in_sizes[0] != M * D || out_size != M * D || ws_size < WS_END) { fprintf(stderr, "kernel_launch: unexpected shapes (n_in %d, in0 %d, out %d, ws %zu); nothing launched\n", n_in, n_in > 0 ? in_sizes[0] : -1, out_size, ws_size); grid = -1; return; }
        int dev = 0, cus = 0, per_cu = 0;
        if (hipGetDevice(&dev) != hipSuccess || hipDeviceGetAttribute(&cus, hipDeviceAttributeMultiprocessorCount, dev) != hipSuccess) { grid = -1; return; }
        if (hipFuncSetAttribute((const void*)hyb_fwd, hipFuncAttributeMaxDynamicSharedMemorySize, LDS_BYTES) != hipSuccess) { fprintf(stderr, "kernel_launch: hipFuncSetAttribute failed\n"); grid = -1; return; }
        if (hipOccupancyMaxActiveBlocksPerMultiprocessor(&per_cu, (const void*)hyb_fwd, NWAVES * 64, LDS_BYTES) != hipSuccess || per_cu < 1) { fprintf(stderr, "kernel_launch: occupancy query reports %d workgroups per CU\n", per_cu); (void)hipGetLastError(); grid = -1; return; }
        (void)hipGetLastError();
        grid = cus;
    }
    if (grid < 0) return;
    if (hipMemsetAsync((char*)d_ws + WS_CTL, 0, CTL_ZERO_BYTES, stream) != hipSuccess) return;
    Args a{};
    for (int i = 0; i < 25; ++i) a.in[i] = (const float*)d_in[i];
    a.out = (float*)d_out; a.ws = (unsigned char*)d_ws;
#if MK_N_LAUNCHES == 1
    if (PROBE_SPLIT >= 0) {
        a.ph_lo = 0; a.ph_hi = PROBE_SPLIT + 1; a.li = 0; hipLaunchKernelGGL(hyb_fwd, dim3(grid), dim3(NWAVES * 64), LDS_BYTES, stream, a);
        a.ph_lo = PROBE_SPLIT; a.ph_hi = N_PHASES; a.li = 1; hipLaunchKernelGGL(hyb_fwd, dim3(grid), dim3(NWAVES * 64), LDS_BYTES, stream, a);
        return;
    }
    a.ph_lo = 0; a.ph_hi = N_PHASES; a.li = 0;
    hipLaunchKernelGGL(hyb_fwd, dim3(grid), dim3(NWAVES * 64), LDS_BYTES, stream, a);
#else
    for (int li = 0; li < N_PHASES; ++li) { a.ph_lo = li; a.ph_hi = li + 1; a.li = 0; hipLaunchKernelGGL(hyb_fwd, dim3(grid), dim3(NWAVES * 64), LDS_BYTES, stream, a); }
#endif
}
```
